# Optimizing an MI355X kernel written in HIP

```python
import jax, jax.numpy as jnp
from jax import lax
import numpy as np

D_MODEL = 1024
BATCH = 8
SEQ = 4096
DEPTH = 1

MIX_WIDTH = D_MODEL
CONV_WIDTH = MIX_WIDTH // 2
CONV_GROUPS = 8
CONV_K = 3
GMLP_WIDTH = MIX_WIDTH - CONV_WIDTH
GMLP_HEADS = 8
GMLP_HEAD_DIM = GMLP_WIDTH // GMLP_HEADS
CHUNK = 128
IN_COLS = 3 * CONV_WIDTH + 2 * GMLP_WIDTH
MEM_LEN = 256
XA_HEADS = 4
XA_HEAD_DIM = D_MODEL // XA_HEADS
N_GROUPS = 4
EXPERTS_PER_GROUP = 8
N_EXPERTS = N_GROUPS * EXPERTS_PER_GROUP
TOP_K = 2
D_EXPERT = D_MODEL // 2
MOE_BLOCK = 128
EPS = 1e-6

kernel_name = "hymba_conv_gmlp_hmoe_layer"


def rmsnorm(x, g):
    xf = x.astype(jnp.float32)
    y = xf * lax.rsqrt(jnp.mean(xf * xf, axis=-1, keepdims=True) + EPS)
    return (y * g.astype(jnp.float32)).astype(x.dtype)


def hybrid_mixer(h, w_in, conv_w, g_v, w_s, b_s, g_out_conv, g_out_gmlp, w_out):
    B_, S_, _ = h.shape
    proj = h @ w_in
    gate_b, gate_c, xc, u, v = jnp.split(
        proj, [CONV_WIDTH, 2 * CONV_WIDTH, 3 * CONV_WIDTH, 3 * CONV_WIDTH + GMLP_WIDTH], axis=-1)

    z = gate_c * xc
    zc = lax.conv_general_dilated(
        z, conv_w[:, None, :].astype(z.dtype), window_strides=(1,),
        padding=[(CONV_K - 1, 0)], dimension_numbers=('NWC', 'WIO', 'NWC'),
        feature_group_count=CONV_WIDTH)
    y_a = gate_b * zc

    u = jax.nn.gelu(u)
    v = jax.nn.gelu(v).reshape(B_, S_, GMLP_HEADS, GMLP_HEAD_DIM)
    v = rmsnorm(v, g_v.reshape(GMLP_HEADS, GMLP_HEAD_DIM))
    v = v.reshape(B_, S_ // CHUNK, CHUNK, GMLP_HEADS, GMLP_HEAD_DIM)
    causal = jnp.tril(jnp.ones((CHUNK, CHUNK), dtype=bool))
    ws = jnp.where(causal[None], w_s, 0.0).astype(v.dtype)
    s = jnp.einsum('hts,bcshd->bcthd', ws, v) + b_s.T.astype(v.dtype)[:, :, None]
    y_b = u * s.reshape(B_, S_, GMLP_WIDTH)

    y = jnp.concatenate([rmsnorm(y_a, g_out_conv), rmsnorm(y_b, g_out_gmlp)], axis=-1)
    return y @ w_out


def memory_cross_attention(h, mem_n, w_q, w_k, w_v, w_o):
    B_, S_, _ = h.shape
    M_ = mem_n.shape[1]
    q = (h @ w_q).reshape(B_, S_, XA_HEADS, XA_HEAD_DIM)
    k = (mem_n @ w_k).reshape(B_, M_, XA_HEADS, XA_HEAD_DIM)
    v = (mem_n @ w_v).reshape(B_, M_, XA_HEADS, XA_HEAD_DIM)
    scores = jnp.einsum('bshd,bmhd->bhsm', q, k).astype(jnp.float32) * (XA_HEAD_DIM ** -0.5)
    p = jax.nn.softmax(scores, axis=-1).astype(v.dtype)
    o = jnp.einsum('bhsm,bmhd->bshd', p, v).reshape(B_, S_, D_MODEL)
    return o @ w_o


def hierarchical_moe(h, w_grp, b_grp, w_rt, b_rt, w_gate, w_up, w_down):
    B_, S_, D_ = h.shape
    T = B_ * S_
    xt = h.reshape(T, D_)
    grp_prob = jax.nn.softmax((xt @ w_grp).astype(jnp.float32) + b_grp.astype(jnp.float32), axis=-1)
    grp_p, grp_idx = lax.top_k(grp_prob, 1)
    exp_logits = ((xt @ w_rt).astype(jnp.float32) + b_rt.astype(jnp.float32)).reshape(
        T, N_GROUPS, EXPERTS_PER_GROUP)
    in_grp = jnp.take_along_axis(exp_logits, grp_idx[:, :, None], axis=1)[:, 0]
    top_logit, top_local = lax.top_k(in_grp, TOP_K)
    gates = jax.nn.softmax(top_logit, axis=-1) * grp_p
    expert = grp_idx * EXPERTS_PER_GROUP + top_local

    A = T * TOP_K
    e_flat = expert.reshape(A)
    g_flat = gates.reshape(A)
    tok = jnp.repeat(jnp.arange(T, dtype=jnp.int32), TOP_K)
    order = jnp.argsort(e_flat)
    e_sorted = e_flat[order]
    tok_sorted = tok[order]
    g_sorted = g_flat[order]
    counts = jnp.bincount(e_flat, length=N_EXPERTS)
    starts = jnp.cumsum(counts) - counts
    padded = ((counts + MOE_BLOCK - 1) // MOE_BLOCK) * MOE_BLOCK
    pad_ends = jnp.cumsum(padded)
    pad_starts = pad_ends - padded
    dest = pad_starts[e_sorted] + jnp.arange(A, dtype=jnp.int32) - starts[e_sorted]
    n_blocks = (A + MOE_BLOCK - 1) // MOE_BLOCK + N_EXPERTS
    cap = n_blocks * MOE_BLOCK
    buf = jnp.zeros((cap, D_), xt.dtype).at[dest].set(xt[tok_sorted])
    block_start = jnp.arange(n_blocks, dtype=jnp.int32) * MOE_BLOCK
    block_expert = jnp.minimum(jnp.searchsorted(pad_ends, block_start, side='right'), N_EXPERTS - 1)

    def expert_block(args):
        xb, e = args
        return (jax.nn.silu(xb @ w_gate[e]) * (xb @ w_up[e])) @ w_down[e]

    y_buf = lax.map(expert_block, (buf.reshape(n_blocks, MOE_BLOCK, D_), block_expert)).reshape(cap, D_)
    y_assign = y_buf[dest] * g_sorted[:, None].astype(y_buf.dtype)
    out = jnp.zeros((T, D_), y_buf.dtype).at[tok_sorted].add(y_assign)
    return out.reshape(B_, S_, D_)


def setup_inputs(seed: int = 0) -> dict:
    key = jax.random.key(seed)
    ks = jax.random.split(key, 32)
    f32 = jnp.float32

    def nrm(k, shape, fan_in):
        return jax.random.normal(k, shape, f32) * (fan_in ** -0.5)

    def gain(k, shape):
        return 1.0 + 0.01 * jax.random.normal(k, shape, f32)

    L = DEPTH
    return {
        "x": jax.random.normal(ks[0], (BATCH, SEQ, D_MODEL), f32),
        "mem": jax.random.normal(ks[1], (BATCH, MEM_LEN, D_MODEL), f32),
        "g_mix": gain(ks[2], (L, D_MODEL)),
        "w_in": nrm(ks[3], (L, D_MODEL, IN_COLS), D_MODEL),
        "conv_w": nrm(ks[4], (L, CONV_K, CONV_WIDTH), CONV_K),
        "g_v": gain(ks[5], (L, GMLP_WIDTH)),
        "w_s": nrm(ks[6], (L, GMLP_HEADS, CHUNK, CHUNK), CHUNK),
        "b_s": gain(ks[7], (L, GMLP_HEADS, CHUNK)),
        "g_out_conv": gain(ks[8], (L, CONV_WIDTH)),
        "g_out_gmlp": gain(ks[9], (L, GMLP_WIDTH)),
        "w_out": nrm(ks[10], (L, MIX_WIDTH, D_MODEL), MIX_WIDTH),
        "g_xattn": gain(ks[11], (L, D_MODEL)),
        "g_mem": gain(ks[12], (L, D_MODEL)),
        "w_q": nrm(ks[13], (L, D_MODEL, D_MODEL), D_MODEL),
        "w_k": nrm(ks[14], (L, D_MODEL, D_MODEL), D_MODEL),
        "w_v": nrm(ks[15], (L, D_MODEL, D_MODEL), D_MODEL),
        "w_o": nrm(ks[16], (L, D_MODEL, D_MODEL), D_MODEL),
        "g_ffn": gain(ks[17], (L, D_MODEL)),
        "w_grp": nrm(ks[18], (L, D_MODEL, N_GROUPS), D_MODEL),
        "b_grp": 0.01 * jax.random.normal(ks[19], (L, N_GROUPS), f32),
        "w_rt": nrm(ks[20], (L, D_MODEL, N_EXPERTS), D_MODEL),
        "b_rt": 0.01 * jax.random.normal(ks[21], (L, N_EXPERTS), f32),
        "w_gate": nrm(ks[22], (L, N_EXPERTS, D_MODEL, D_EXPERT), D_MODEL),
        "w_up": nrm(ks[23], (L, N_EXPERTS, D_MODEL, D_EXPERT), D_MODEL),
        "w_down": nrm(ks[24], (L, N_EXPERTS, D_EXPERT, D_MODEL), D_EXPERT),
        "g_final": gain(ks[25], (D_MODEL,)),
    }


def reference(x, mem, g_mix, w_in, conv_w, g_v, w_s, b_s, g_out_conv, g_out_gmlp, w_out,
              g_xattn, g_mem, w_q, w_k, w_v, w_o, g_ffn, w_grp, b_grp, w_rt, b_rt,
              w_gate, w_up, w_down, g_final):
    for l in range(DEPTH):
        x = x + hybrid_mixer(rmsnorm(x, g_mix[l]), w_in[l], conv_w[l], g_v[l], w_s[l], b_s[l],
                             g_out_conv[l], g_out_gmlp[l], w_out[l])
        x = x + memory_cross_attention(rmsnorm(x, g_xattn[l]), rmsnorm(mem, g_mem[l]),
                                       w_q[l], w_k[l], w_v[l], w_o[l])
        x = x + hierarchical_moe(rmsnorm(x, g_ffn[l]), w_grp[l], b_grp[l], w_rt[l], b_rt[l],
                                 w_gate[l], w_up[l], w_down[l])
    return rmsnorm(x, g_final)
```

```cpp
#include <hip/hip_runtime.h>
#include <cstdint>
#include <cstdio>

namespace cfg {
constexpr int D = 1024, B = 8, S = 4096, T = B * S;
constexpr int CW = 512, GW = 512, NH = 8, HD = 64, CHUNK = 128, INC = 2560;
constexpr int ML = 256, XH = 4, XD = 256;
constexpr int NG = 4, EPG = 8, NE = 32, DE = 512;
constexpr float EPS = 1e-6f;
}
constexpr size_t MiB = 1u << 20;
using namespace cfg;

#define LAS __attribute__((address_space(3)))
#define GAS __attribute__((address_space(1)))
typedef unsigned short bf16_t;
typedef short bf16x8 __attribute__((ext_vector_type(8)));
typedef short s16x4 __attribute__((ext_vector_type(4)));
typedef float f32x4 __attribute__((ext_vector_type(4)));
typedef float f32x2 __attribute__((ext_vector_type(2)));
typedef unsigned u32x4 __attribute__((ext_vector_type(4)));
typedef unsigned u32x2 __attribute__((ext_vector_type(2)));

constexpr int NWAVES = 8, NTHREADS = 512;
constexpr int S_TILES = cfg::S / 256;
constexpr int LDS_BYTES = 147456;
constexpr int LDS_STAGE = 131072;
constexpr int LDS_EXCH = 131072;
constexpr int LDS_MISC = LDS_BYTES - 256;

constexpr size_t WS_CTL = 0;
constexpr size_t WS_WIN_T = 1 * MiB;
constexpr size_t WS_WOUT_T = 6 * MiB;
constexpr size_t WS_WQ_NAT = 8 * MiB;
constexpr size_t WS_WO_T = 10 * MiB;
constexpr size_t WS_WKV_T = 12 * MiB;
constexpr size_t WS_WS_BF = 16 * MiB;
constexpr size_t WS_MEMN = 17 * MiB;
constexpr size_t WS_KV = 21 * MiB;
constexpr size_t WS_WQK_T = 29 * MiB;
constexpr size_t WS_VW_T = 45 * MiB;
constexpr size_t WS_WGU_T = 61 * MiB;
constexpr size_t WS_WD_T = 125 * MiB;
constexpr size_t WS_WR = 157 * MiB;
constexpr size_t WS_SSQ1 = 158 * MiB;
constexpr size_t WS_ROUTE = 160 * MiB;
constexpr size_t WS_ACT0 = 164 * MiB;
constexpr size_t WS_ACT1 = 228 * MiB;
constexpr size_t WS_GB = WS_ACT1, WS_Z = WS_ACT1 + 32 * MiB, WS_UG = WS_ACT1 + 64 * MiB, WS_VG = WS_ACT1 + 96 * MiB;
constexpr size_t WS_X2B = WS_ACT1 + 64 * MiB;
constexpr size_t WS_HID = WS_ACT0;
constexpr size_t WS_YSLOT = 356 * MiB;
constexpr size_t RT_TOK_E = WS_ROUTE, RT_TOK_G = WS_ROUTE + 256 * 1024, RT_RS2 = WS_ROUTE + 512 * 1024, RT_TOK_R = WS_ROUTE + 640 * 1024, RT_HIST = WS_ROUTE + 896 * 1024,
                 RT_SLOT_OF = WS_ROUTE + 1024 * 1024, RT_GATE_SLOT = WS_ROUTE + 1536 * 1024, RT_TILE_E = WS_ROUTE + 2048 * 1024,
                 RT_TOK_OF_SLOT = WS_ROUTE + 2304 * 1024, RT_RS_SLOT = WS_ROUTE + 2816 * 1024;
constexpr int MAX_TILES = 288;
constexpr size_t WS_HB = WS_ACT0, WS_Y = WS_ACT0, WS_P = WS_ACT0, WS_X1B = WS_ACT1;

__device__ __forceinline__ unsigned f2bf(float f) { unsigned u = __builtin_bit_cast(unsigned, f); return (u + 0x7fffu + ((u >> 16) & 1u)) >> 16; }
__device__ __forceinline__ unsigned pk2(float lo, float hi) { return f2bf(lo) | (f2bf(hi) << 16); }
__device__ __forceinline__ unsigned cvt_pk_bf16(float lo, float hi) { unsigned r; asm volatile("v_cvt_pk_bf16_f32 %0, %1, %2" : "=v"(r) : "v"(lo), "v"(hi)); return r; }
__device__ __forceinline__ float bf_lo(unsigned w) { return __uint_as_float(w << 16); }
__device__ __forceinline__ float bf_hi(unsigned w) { return __uint_as_float(w & 0xffff0000u); }
__device__ __forceinline__ float wave_sum(float v) {
#pragma unroll
    for (int o = 1; o < 64; o <<= 1) v += __shfl_xor(v, o);
    return v;
}
__device__ __forceinline__ float gelu_fast(float x) {
    const float t = x * (1.0f + 0.044715f * x * x) * 2.302208198f;
    return x * __builtin_amdgcn_rcpf(1.0f + __builtin_amdgcn_exp2f(-t));
}
__device__ __forceinline__ int lane_id_fresh() { int l; asm volatile("v_mbcnt_lo_u32_b32 %0, -1, 0\n\tv_mbcnt_hi_u32_b32 %0, -1, %0" : "=v"(l)); return l; }
#define LDS_WAIT() asm volatile("s_waitcnt lgkmcnt(0)" ::: "memory")
#define VM_WAIT() asm volatile("s_waitcnt vmcnt(0)" ::: "memory")

namespace pg8 {
constexpr int BM = 256, BK = 64, HALF = 128, HTB = HALF * BK * 2, STAGE_BYTES = 8 * HTB, NXCD = 8, WGM = 8;
__host__ __device__ __forceinline__ int lds_byte(int r, int c) { const int st = (r >> 4) * 2 + (c >> 5), rr = r & 15, cc = c & 31, ob = rr * 64 + cc * 2; return st * 1024 + (ob ^ (((ob >> 9) & 1) << 5)); }
__host__ __device__ __forceinline__ void stage_rc(int b, int& R, int& C) { const int st = b / 1024, sb = b % 1024, swz = sb ^ (((sb >> 9) & 1) << 5); R = (st >> 1) * 16 + swz / 64; C = (st & 1) * 32 + (swz % 64) / 2; }
__host__ __device__ __forceinline__ int perm32(int rho) { const int n = rho >> 4, i = rho & 15; return 8 * (i >> 2) + 4 * n + (i & 3); }

__device__ __forceinline__ const char* uni(const char* p) { const unsigned long long v = (unsigned long long)p;
    const unsigned lo = __builtin_amdgcn_readfirstlane((unsigned)v), hi = __builtin_amdgcn_readfirstlane((unsigned)(v >> 32)); return (const char*)(((unsigned long long)hi << 32) | lo); }
struct Unit { int pm, pn, aux; const char* a; const char* b; };

typedef f32x4 Acc[2][2][4][2];

template <int lda, int ldb, int K, bool GATHER = false, class Epi, class Sched>
__device__ __forceinline__ void gemm_phase(LAS unsigned char* lds, const int wid, const Sched& S, const Epi& E, const int* gidx = nullptr) {
    const int lane = lane_id_fresh(), tid = wid * 64 + lane, wr = wid >> 2, wc = wid & 3, fr = lane & 15, fq = lane >> 4;
    constexpr int nt = K / BK;
    unsigned voffA, voffB;
    { int R, C; stage_rc(tid * 16, R, C); const int Rb = (R & ~31) + perm32(R & 31); voffA = (unsigned)(R * lda + C) * 2u; voffB = (unsigned)(Rb * ldb + C) * 2u; }
    constexpr size_t pstepA = (size_t)64 * lda * 2, pstepB = (size_t)64 * ldb * 2;
    constexpr size_t kstep = (size_t)(BK * 2);
    constexpr size_t hstepA = (size_t)HALF * lda * 2, hstepB = (size_t)HALF * ldb * 2;
    const unsigned ldsw = (unsigned)wid * 1024u;
    const int aoff = lds_byte(wr * 64 + fr, fq * 8), boff = lds_byte(wc * 32 + fr, fq * 8);
#define PG8_SA(b, h) (((b) * 2 + (h)) * HTB)
#define PG8_SB(b, h) ((4 + (b) * 2 + (h)) * HTB)
#define PG8_STAGE(bufoff, gbase, X) do { _Pragma("unroll") for (int _i = 0; _i < 2; ++_i) \
        __builtin_amdgcn_global_load_lds((const unsigned*)(uni((const char*)(gbase) + (size_t)_i * pstep##X) + voff##X), (LAS unsigned*)(lds + (bufoff) + ldsw + _i * 8192), 16, 0, 0); } while (0)
#define PG8_STAGE_A(bufoff, kp, h, OFF) do { _Pragma("unroll") for (int _i = 0; _i < 2; ++_i) { \
        if constexpr (GATHER) __builtin_amdgcn_global_load_lds((const unsigned*)(uni((const char*)(kp)) + OFF[h][_i]), (LAS unsigned*)(lds + (bufoff) + ldsw + _i * 8192), 16, 0, 0); \
        else __builtin_amdgcn_global_load_lds((const unsigned*)(uni((const char*)(kp) + (size_t)(h) * hstepA + (size_t)_i * pstepA) + voffA), (LAS unsigned*)(lds + (bufoff) + ldsw + _i * 8192), 16, 0, 0); } } while (0)
#define PG8_LDA(dst, b, h) do { _Pragma("unroll") for (int m = 0; m < 4; ++m) _Pragma("unroll") for (int k = 0; k < 2; ++k) dst[m][k] = *(const LAS bf16x8*)(lds + PG8_SA(b, h) + aoff + m * 2048 + k * 1024); } while (0)
#define PG8_LDB(dst, b, h) do { _Pragma("unroll") for (int n = 0; n < 2; ++n) _Pragma("unroll") for (int k = 0; k < 2; ++k) dst[n][k] = *(const LAS bf16x8*)(lds + PG8_SB(b, h) + boff + n * 2048 + k * 1024); } while (0)
#define PG8_MMA(ai, bj, At, Bt) do { __builtin_amdgcn_s_setprio(1); _Pragma("unroll") for (int m = 0; m < 4; ++m) _Pragma("unroll") for (int n = 0; n < 2; ++n) _Pragma("unroll") for (int k = 0; k < 2; ++k) \
        acc[ai][bj][m][n] = __builtin_amdgcn_mfma_f32_16x16x32_bf16(Bt[n][k], At[m][k], acc[ai][bj][m][n], 0, 0, 0); __builtin_amdgcn_s_setprio(0); } while (0)
#define PG8_WAIT_V(n) asm volatile("s_waitcnt vmcnt(" #n ")" ::: "memory")
#define PG8_WAIT_L(n) asm volatile("s_waitcnt lgkmcnt(" #n ")" ::: "memory")
#define PG8_BAR __builtin_amdgcn_s_barrier()
#define PG8_SCHED __builtin_amdgcn_sched_barrier(0)
    Unit cur, nxt; int ui = 0;
    if (!S.next(0, cur)) return;
    Acc acc;
#pragma unroll
    for (int a = 0; a < 2; ++a)
#pragma unroll
        for (int b = 0; b < 2; ++b)
#pragma unroll
            for (int m = 0; m < 4; ++m)
#pragma unroll
                for (int n = 0; n < 2; ++n) acc[a][b][m][n] = (f32x4){0.f, 0.f, 0.f, 0.f};
    bf16x8 At[4][2], B0[2][2], B1[2][2];
    const char* cA = cur.a; const char* cB = cur.b;
    unsigned go[2][2], gn[2][2];
    LAS const unsigned* lidx = (LAS const unsigned*)(lds + STAGE_BYTES);
    if constexpr (GATHER) {
        { Unit uu; for (int i = 0; S.next(i, uu); ++i) if (tid < 256) ((LAS unsigned*)lidx)[i * 256 + tid] = (unsigned)gidx[uu.pm * 256 + tid] * (unsigned)(lda * 2); }
        asm volatile("s_waitcnt vmcnt(0) lgkmcnt(0)" ::: "memory"); PG8_BAR; asm volatile("" ::: "memory");
        int R, C; stage_rc(tid * 16, R, C);
#pragma unroll
        for (int h = 0; h < 2; ++h)
#pragma unroll
            for (int i = 0; i < 2; ++i) { go[h][i] = lidx[h * 128 + i * 64 + R] + (unsigned)(C * 2); gn[h][i] = go[h][i]; }
    }
    PG8_STAGE(PG8_SB(0, 0), cB, B); PG8_STAGE(PG8_SB(0, 1), cB + hstepB, B); PG8_STAGE_A(PG8_SA(0, 0), cA, 0, go); PG8_STAGE_A(PG8_SA(0, 1), cA, 1, go);
    if (wr == 1) PG8_BAR;
    PG8_WAIT_V(2); PG8_BAR;
    PG8_STAGE(PG8_SB(1, 0), cB + kstep, B); PG8_STAGE_A(PG8_SA(1, 0), cA + kstep, 0, go); PG8_STAGE(PG8_SB(1, 1), cB + hstepB + kstep, B);
    PG8_WAIT_V(6); PG8_BAR;
    for (;;) {
        const bool has_next = S.next(ui + 1, nxt);
        const char* nA = has_next ? nxt.a : cA; const char* nB = has_next ? nxt.b : cB;
        for (int t = 0; t < nt; t += 2) {
            const bool last = (t == nt - 2);
            const char* a1 = cA + (size_t)(t + 1) * kstep;
            const char* a2 = last ? nA : cA + (size_t)(t + 2) * kstep; const char* b2 = last ? nB : cB + (size_t)(t + 2) * kstep;
            const char* a3 = a2 + kstep; const char* b3 = b2 + kstep;
            if constexpr (GATHER) { if (last && has_next) { int R, C; stage_rc(tid * 16, R, C);
#pragma unroll
                for (int h = 0; h < 2; ++h)
#pragma unroll
                    for (int i = 0; i < 2; ++i) gn[h][i] = lidx[(ui + 1) * 256 + h * 128 + i * 64 + R] + (unsigned)(C * 2); } }
            unsigned gx[2][2];
#pragma unroll
            for (int h = 0; h < 2; ++h)
#pragma unroll
                for (int i = 0; i < 2; ++i) gx[h][i] = GATHER ? (last ? gn[h][i] : go[h][i]) : 0u;
            PG8_LDB(B0, 0, 0); PG8_LDB(B1, 0, 1); PG8_SCHED; PG8_LDA(At, 0, 0); PG8_STAGE_A(PG8_SA(1, 1), a1, 1, go);
            PG8_WAIT_V(8); PG8_WAIT_L(0); PG8_BAR; PG8_MMA(0, 0, At, B0); PG8_MMA(0, 1, At, B1); PG8_BAR; PG8_SCHED;
            PG8_LDA(At, 0, 1); PG8_STAGE(PG8_SB(0, 0), b2, B); PG8_STAGE(PG8_SB(0, 1), b2 + hstepB, B); PG8_STAGE_A(PG8_SA(0, 0), a2, 0, gx);
            PG8_WAIT_V(8); PG8_WAIT_L(0); PG8_BAR; PG8_MMA(1, 0, At, B0); PG8_MMA(1, 1, At, B1); PG8_BAR; PG8_SCHED;
            PG8_LDB(B0, 1, 0); PG8_LDB(B1, 1, 1); PG8_SCHED; PG8_LDA(At, 1, 0); PG8_STAGE_A(PG8_SA(0, 1), a2, 1, gx);
            PG8_WAIT_V(8); PG8_WAIT_L(0); PG8_BAR; PG8_MMA(0, 0, At, B0); PG8_MMA(0, 1, At, B1); PG8_BAR; PG8_SCHED;
            PG8_LDA(At, 1, 1); PG8_STAGE(PG8_SB(1, 0), b3, B); PG8_STAGE(PG8_SB(1, 1), b3 + hstepB, B); PG8_STAGE_A(PG8_SA(1, 0), a3, 0, gx);
            PG8_WAIT_V(8); PG8_WAIT_L(0); PG8_BAR; PG8_MMA(1, 0, At, B0); PG8_MMA(1, 1, At, B1); PG8_BAR; PG8_SCHED;
            if constexpr (GATHER) { if (last) {
#pragma unroll
                for (int h = 0; h < 2; ++h)
#pragma unroll
                    for (int i = 0; i < 2; ++i) go[h][i] = gn[h][i]; } }
        }
        if (wr == 0) PG8_BAR;
        { const int le = lane_id_fresh();
          E(acc, cur, wr, wc, le & 15, le >> 4, lds + STAGE_BYTES, wid, le); }
        if (!has_next) break;
#pragma unroll
        for (int a = 0; a < 2; ++a)
#pragma unroll
            for (int b = 0; b < 2; ++b)
#pragma unroll
                for (int m = 0; m < 4; ++m)
#pragma unroll
                    for (int n = 0; n < 2; ++n) acc[a][b][m][n] = (f32x4){0.f, 0.f, 0.f, 0.f};
        cur = nxt; cA = nA; cB = nB; ++ui;
        if (wr == 1) PG8_BAR;
    }
    PG8_WAIT_V(0);
    PG8_BAR;
#undef PG8_SA
#undef PG8_SB
#undef PG8_STAGE
#undef PG8_STAGE_A
#undef PG8_LDA
#undef PG8_LDB
#undef PG8_MMA
#undef PG8_WAIT_V
#undef PG8_WAIT_L
#undef PG8_BAR
#undef PG8_SCHED
}

struct DenseOrder {
    int nM, nN, nwg, G, c; const char* A; const char* Bt; size_t tA, tB; int bdiv; size_t bstride;
    __device__ __forceinline__ void init(int M, int N, int G_, int c_, const void* A_, int lda, const void* Bt_, int ldb, int bdiv_ = 0, size_t bstride_ = 0) {
        nM = M / BM; nN = N / BM; nwg = nM * nN; G = G_; c = c_; A = (const char*)A_; Bt = (const char*)Bt_; tA = (size_t)BM * lda * 2; tB = (size_t)BM * ldb * 2; bdiv = bdiv_; bstride = bstride_; }
    __device__ __forceinline__ bool next(int i, Unit& u) const {
        const long L = (long)i * G + c; if (L >= nwg) return false;
        int wgid = (int)L; { const int q = nwg / NXCD, r = nwg % NXCD, xcd = wgid % NXCD, off = wgid / NXCD; wgid = (xcd < r ? xcd * (q + 1) : r * (q + 1) + (xcd - r) * q) + off; }
        const int nig = WGM * nN, gid = wgid / nig, fm = gid * WGM, gsz = (nM - fm) < WGM ? (nM - fm) : WGM;
        u.pm = fm + ((wgid % nig) % gsz); u.pn = (wgid % nig) / gsz; u.aux = 0;
        u.a = A + (size_t)u.pm * tA; u.b = Bt + (size_t)u.pn * tB + (bdiv ? (size_t)(u.pm / bdiv) * bstride : 0);
        return true;
    }
};
}

using pg8::Acc; using pg8::Unit;
#define EPI_ARGS Acc& acc, const Unit& u, int wr, int wc, int fr, int fq, LAS unsigned char* ldsx, int wid, int lane
struct EpiBf16 {
    bf16_t* O; int ldc;
    __device__ __forceinline__ void operator()(EPI_ARGS) const {
        bf16_t* base = O + (size_t)(u.pm * 256 + wr * 64 + fr) * ldc + u.pn * 256 + wc * 32 + 8 * fq;
#pragma unroll
        for (int ai = 0; ai < 2; ++ai)
#pragma unroll
            for (int m = 0; m < 4; ++m)
#pragma unroll
                for (int bj = 0; bj < 2; ++bj) { const f32x4 v0 = acc[ai][bj][m][0], v1 = acc[ai][bj][m][1]; u32x4 w;
                    w.x = cvt_pk_bf16(v0[0], v0[1]); w.y = cvt_pk_bf16(v0[2], v0[3]); w.z = cvt_pk_bf16(v1[0], v1[1]); w.w = cvt_pk_bf16(v1[2], v1[3]);
                    *(u32x4*)(base + (size_t)(ai * 128 + m * 16) * ldc + bj * 128) = w; }
    }
};
struct EpiBf16Aux {
    bf16_t* O; int ldc;
    __device__ __forceinline__ void operator()(EPI_ARGS) const {
        bf16_t* base = O + (size_t)(unsigned)u.aux + (size_t)(wr * 64 + fr) * ldc + wc * 32 + 8 * fq;
#pragma unroll
        for (int ai = 0; ai < 2; ++ai)
#pragma unroll
            for (int m = 0; m < 4; ++m)
#pragma unroll
                for (int bj = 0; bj < 2; ++bj) { const f32x4 v0 = acc[ai][bj][m][0], v1 = acc[ai][bj][m][1]; u32x4 w;
                    w.x = cvt_pk_bf16(v0[0], v0[1]); w.y = cvt_pk_bf16(v0[2], v0[3]); w.z = cvt_pk_bf16(v1[0], v1[1]); w.w = cvt_pk_bf16(v1[2], v1[3]);
                    *(u32x4*)(base + (size_t)(ai * 128 + m * 16) * ldc + bj * 128) = w; }
    }
};
struct EpiInProj {
    bf16_t *GB, *Z, *UG, *VG;
    __device__ __forceinline__ void operator()(EPI_ARGS) const {
        const int pn = u.pn; const size_t row0 = (size_t)(u.pm * 256 + wr * 64 + fr); const int cl = wc * 32 + 8 * fq;
        if (pn >= 2 && pn < 6) {
            bf16_t* base = Z + row0 * 512 + (pn - 2) * 128 + cl;
#pragma unroll
            for (int ai = 0; ai < 2; ++ai)
#pragma unroll
                for (int m = 0; m < 4; ++m) { const f32x4 z0 = acc[ai][0][m][0] * acc[ai][1][m][0], z1 = acc[ai][0][m][1] * acc[ai][1][m][1]; u32x4 w;
                    w.x = cvt_pk_bf16(z0[0], z0[1]); w.y = cvt_pk_bf16(z0[2], z0[3]); w.z = cvt_pk_bf16(z1[0], z1[1]); w.w = cvt_pk_bf16(z1[2], z1[3]);
                    *(u32x4*)(base + (size_t)(ai * 128 + m * 16) * 512) = w; }
        } else {
            const bool act = pn >= 6;
            const int sel = pn < 2 ? 0 : (pn < 8 ? 2 : 3), ct = pn < 2 ? pn : (pn < 8 ? pn - 6 : pn - 8);
            bf16_t* base = GB + (size_t)sel * (16u << 20) + row0 * 512 + ct * 256 + cl;
#pragma unroll
            for (int ai = 0; ai < 2; ++ai)
#pragma unroll
                for (int m = 0; m < 4; ++m)
#pragma unroll
                    for (int bj = 0; bj < 2; ++bj) { f32x4 v0 = acc[ai][bj][m][0], v1 = acc[ai][bj][m][1];
                        if (act) {
#pragma unroll
                            for (int i = 0; i < 4; ++i) { v0[i] = gelu_fast(v0[i]); v1[i] = gelu_fast(v1[i]); } }
                        u32x4 w; w.x = cvt_pk_bf16(v0[0], v0[1]); w.y = cvt_pk_bf16(v0[2], v0[3]); w.z = cvt_pk_bf16(v1[0], v1[1]); w.w = cvt_pk_bf16(v1[2], v1[3]);
                        *(u32x4*)(base + (size_t)(ai * 128 + m * 16) * 512 + bj * 128) = w; }
        }
    }
};
struct EpiResidA {
    const float* R; bf16_t* XB; float* SSQ;
    __device__ __forceinline__ void operator()(EPI_ARGS) const {
        const size_t row0 = (size_t)(u.pm * 256 + wr * 64 + fr); const int col0 = u.pn * 256 + wc * 32 + 8 * fq;
#pragma unroll
        for (int ai = 0; ai < 2; ++ai)
#pragma unroll
            for (int m = 0; m < 4; ++m) { const size_t off = (row0 + ai * 128 + m * 16) * 1024 + col0; float sq = 0.f;
#pragma unroll
                for (int bj = 0; bj < 2; ++bj) { const f32x4 r0 = *(const f32x4*)(R + off + bj * 128), r1 = *(const f32x4*)(R + off + bj * 128 + 4);
                    const f32x4 v0 = r0 + acc[ai][bj][m][0], v1 = r1 + acc[ai][bj][m][1];
                    u32x4 w; w.x = cvt_pk_bf16(v0[0], v0[1]); w.y = cvt_pk_bf16(v0[2], v0[3]); w.z = cvt_pk_bf16(v1[0], v1[1]); w.w = cvt_pk_bf16(v1[2], v1[3]); *(u32x4*)(XB + off + bj * 128) = w;
                    sq += (v0[0] * v0[0] + v0[1] * v0[1]) + (v0[2] * v0[2] + v0[3] * v0[3]) + (v1[0] * v1[0] + v1[1] * v1[1]) + (v1[2] * v1[2] + v1[3] * v1[3]); }
                sq += __shfl_xor(sq, 16); sq += __shfl_xor(sq, 32); if (fq == 0) SSQ[(row0 + ai * 128 + m * 16) * 16 + u.pn * 4 + wc] = sq;
                if (m & 1) asm volatile("" ::: "memory"); }
    }
};
struct EpiResidB {
    const bf16_t* RB; bf16_t* XB;
    __device__ __forceinline__ void operator()(EPI_ARGS) const {
        const size_t row0 = (size_t)(u.pm * 256 + wr * 64 + fr); const int col0 = u.pn * 256 + wc * 32 + 8 * fq;
#pragma unroll
        for (int ai = 0; ai < 2; ++ai)
#pragma unroll
            for (int m = 0; m < 4; ++m) { const size_t off = (row0 + ai * 128 + m * 16) * 1024 + col0;
#pragma unroll
                for (int bj = 0; bj < 2; ++bj) { const u32x4 r = *(const u32x4*)(RB + off + bj * 128);
                    const f32x4 v0 = (f32x4){bf_lo(r.x), bf_hi(r.x), bf_lo(r.y), bf_hi(r.y)} + acc[ai][bj][m][0], v1 = (f32x4){bf_lo(r.z), bf_hi(r.z), bf_lo(r.w), bf_hi(r.w)} + acc[ai][bj][m][1];
                    u32x4 w; w.x = cvt_pk_bf16(v0[0], v0[1]); w.y = cvt_pk_bf16(v0[2], v0[3]); w.z = cvt_pk_bf16(v1[0], v1[1]); w.w = cvt_pk_bf16(v1[2], v1[3]); *(u32x4*)(XB + off + bj * 128) = w; }
                if (m & 1) asm volatile("" ::: "memory"); }
    }
};
struct EpiSoftmax {
    const float* SSQ; bf16_t* P;
    __device__ __forceinline__ void operator()(EPI_ARGS) const {
        const size_t row0 = (size_t)(u.pm * 256 + wr * 64 + fr);
        LAS f32x2* ex = (LAS f32x2*)ldsx;
        float mw[2][4];
#pragma unroll
        for (int ai = 0; ai < 2; ++ai)
#pragma unroll
            for (int m = 0; m < 4; ++m) {
                const f32x4* q = (const f32x4*)(SSQ + (row0 + ai * 128 + m * 16) * 16);
                const f32x4 q0 = q[0], q1 = q[1], q2 = q[2], q3 = q[3];
                const float ss = ((q0[0] + q0[1]) + (q0[2] + q0[3])) + ((q1[0] + q1[1]) + (q1[2] + q1[3])) + ((q2[0] + q2[1]) + (q2[2] + q2[3])) + ((q3[0] + q3[1]) + (q3[2] + q3[3]));
                const float rs = rsqrtf(ss * (1.f / 1024.f) + EPS);
                float mx = -3.0e38f;
#pragma unroll
                for (int bj = 0; bj < 2; ++bj)
#pragma unroll
                    for (int n = 0; n < 2; ++n) { f32x4 v = acc[ai][bj][m][n] * rs; acc[ai][bj][m][n] = v; mx = fmaxf(fmaxf(mx, fmaxf(v[0], v[1])), fmaxf(v[2], v[3])); }
                mx = fmaxf(mx, __shfl_xor(mx, 16)); mx = fmaxf(mx, __shfl_xor(mx, 32));
                float sum = 0.f;
#pragma unroll
                for (int bj = 0; bj < 2; ++bj)
#pragma unroll
                    for (int n = 0; n < 2; ++n) { f32x4 v = acc[ai][bj][m][n];
#pragma unroll
                        for (int i = 0; i < 4; ++i) v[i] = __builtin_amdgcn_exp2f(v[i] - mx);
                        acc[ai][bj][m][n] = v; sum += (v[0] + v[1]) + (v[2] + v[3]); }
                sum += __shfl_xor(sum, 16); sum += __shfl_xor(sum, 32);
                mw[ai][m] = mx;
                if (fq == 0) ex[(ai * 128 + wr * 64 + m * 16 + fr) * 4 + wc] = (f32x2){mx, sum};
            }
        asm volatile("s_waitcnt lgkmcnt(0)" ::: "memory"); __builtin_amdgcn_s_barrier(); asm volatile("" ::: "memory");
        bf16_t* base = P + row0 * 1024 + u.pn * 256 + wc * 32 + 8 * fq;
#pragma unroll
        for (int ai = 0; ai < 2; ++ai)
#pragma unroll
            for (int m = 0; m < 4; ++m) {
                const LAS f32x2* e4 = ex + (ai * 128 + wr * 64 + m * 16 + fr) * 4;
                const f32x2 e0 = e4[0], e1 = e4[1], e2 = e4[2], e3 = e4[3];
                const float M = fmaxf(fmaxf(e0.x, e1.x), fmaxf(e2.x, e3.x));
                const float L = e0.y * __builtin_amdgcn_exp2f(e0.x - M) + e1.y * __builtin_amdgcn_exp2f(e1.x - M) + e2.y * __builtin_amdgcn_exp2f(e2.x - M) + e3.y * __builtin_amdgcn_exp2f(e3.x - M);
                const float f = __builtin_amdgcn_exp2f(mw[ai][m] - M) / L;
#pragma unroll
                for (int bj = 0; bj < 2; ++bj) { const f32x4 v0 = acc[ai][bj][m][0] * f, v1 = acc[ai][bj][m][1] * f; u32x4 w;
                    w.x = cvt_pk_bf16(v0[0], v0[1]); w.y = cvt_pk_bf16(v0[2], v0[3]); w.z = cvt_pk_bf16(v1[0], v1[1]); w.w = cvt_pk_bf16(v1[2], v1[3]);
                    *(u32x4*)(base + (size_t)(ai * 128 + m * 16) * 1024 + bj * 128) = w; }
            }
    }
};
struct WqkOrder {
    int G, c; const char* KV; const char* WQ;
    __device__ __forceinline__ bool next(int i, Unit& u) const {
        const int L = i * G + c; if (L >= 128) return false;
        const int b = L >> 4, h = (L >> 2) & 3, pn = L & 3;
        u.pm = 0; u.pn = pn; u.a = KV + ((size_t)(b * 256) * 2048 + h * 256) * 2; u.b = WQ + ((size_t)(pn * 256) * 1024 + h * 256) * 2;
        u.aux = b * (1024 * 1024) + (h * 256) * 1024 + pn * 256; return true; }
};
struct VwOrder {
    int G, c; const char* KV; const char* WO;
    __device__ __forceinline__ bool next(int i, Unit& u) const {
        const int L = i * G + c; if (L >= 128) return false;
        const int b = L >> 4, h = (L >> 2) & 3, pm = L & 3;
        u.pm = pm; u.pn = 0; u.a = WO + ((size_t)(pm * 256) * 1024 + h * 256) * 2; u.b = KV + ((size_t)(b * 256) * 2048 + 1024 + h * 256) * 2;
        u.aux = b * (1024 * 1024) + (pm * 256) * 1024 + h * 256; return true; }
};

struct EpiSwiGLU {
    bf16_t* H; const float* rs_slot;
    __device__ __forceinline__ void operator()(EPI_ARGS) const {
        const size_t row0 = (size_t)(u.pm * 256 + wr * 64 + fr);
        bf16_t* base = H + row0 * 512 + u.pn * 128 + wc * 32 + 8 * fq;
#pragma unroll
        for (int ai = 0; ai < 2; ++ai)
#pragma unroll
            for (int m = 0; m < 4; ++m) { const float rs = rs_slot[row0 + ai * 128 + m * 16]; f32x4 h0, h1;
#pragma unroll
                for (int i = 0; i < 4; ++i) { const float g0 = acc[ai][0][m][0][i] * rs, g1 = acc[ai][0][m][1][i] * rs;
                    h0[i] = g0 * __builtin_amdgcn_rcpf(1.0f + __builtin_amdgcn_exp2f(-1.4426950408889634f * g0)) * (acc[ai][1][m][0][i] * rs);
                    h1[i] = g1 * __builtin_amdgcn_rcpf(1.0f + __builtin_amdgcn_exp2f(-1.4426950408889634f * g1)) * (acc[ai][1][m][1][i] * rs); }
                u32x4 w; w.x = cvt_pk_bf16(h0[0], h0[1]); w.y = cvt_pk_bf16(h0[2], h0[3]); w.z = cvt_pk_bf16(h1[0], h1[1]); w.w = cvt_pk_bf16(h1[2], h1[3]);
                *(u32x4*)(base + (size_t)(ai * 128 + m * 16) * 512) = w; }
    }
};
struct EpiDown {
    bf16_t* Y; const float* gate;
    __device__ __forceinline__ void operator()(EPI_ARGS) const {
        const size_t row0 = (size_t)(u.pm * 256 + wr * 64 + fr);
        bf16_t* base = Y + row0 * 1024 + u.pn * 256 + wc * 32 + 8 * fq;
#pragma unroll
        for (int ai = 0; ai < 2; ++ai)
#pragma unroll
            for (int m = 0; m < 4; ++m) { const float g = gate[row0 + ai * 128 + m * 16];
#pragma unroll
                for (int bj = 0; bj < 2; ++bj) { const f32x4 v0 = acc[ai][bj][m][0] * g, v1 = acc[ai][bj][m][1] * g; u32x4 w;
                    w.x = cvt_pk_bf16(v0[0], v0[1]); w.y = cvt_pk_bf16(v0[2], v0[3]); w.z = cvt_pk_bf16(v1[0], v1[1]); w.w = cvt_pk_bf16(v1[2], v1[3]);
                    *(u32x4*)(base + (size_t)(ai * 128 + m * 16) * 1024 + bj * 128) = w; } }
    }
};
struct GroupedOrder {
    int G, c, nunits; const int* tile_e; const char* A; const char* W; size_t tA, wE, tB;
    __device__ __forceinline__ void init(int G_, int c_, const int* tbl, const void* A_, int lda, const void* W_, int ldb, size_t expert_bytes, bool gather = false) {
        G = G_; c = c_; tile_e = tbl + 16; nunits = 4 * __builtin_amdgcn_readfirstlane(__hip_atomic_load(tbl, __ATOMIC_RELAXED, __HIP_MEMORY_SCOPE_AGENT)); A = (const char*)A_; W = (const char*)W_; tA = gather ? 0 : (size_t)256 * lda * 2; tB = (size_t)256 * ldb * 2; wE = expert_bytes; }
    __device__ __forceinline__ bool next(int i, Unit& u) const {
        const int L = i * G + c; if (L >= nunits) return false;
        int wgid = L; { const int q = nunits / 8, r = nunits % 8, xcd = wgid % 8, off = wgid / 8; wgid = (xcd < r ? xcd * (q + 1) : r * (q + 1) + (xcd - r) * q) + off; }
        const int tile = wgid >> 2, pn = wgid & 3, e = __builtin_amdgcn_readfirstlane(__hip_atomic_load(tile_e + tile, __ATOMIC_RELAXED, __HIP_MEMORY_SCOPE_AGENT));
        u.pm = tile; u.pn = pn; u.aux = e; u.a = A + (size_t)tile * tA; u.b = W + (size_t)e * wE + (size_t)pn * tB; return true; }
};

struct Args {
    const float* in[26]; float* out; unsigned char* ws; int ph_lo, ph_hi;
};
struct Frame {
    LAS unsigned char* lds; int wave, vcu, G; unsigned char* ws; float* out;
};
#define IN_X 0
#define IN_MEM 1
#define IN_G_MIX 2
#define IN_W_IN 3
#define IN_CONV_W 4
#define IN_G_V 5
#define IN_W_S 6
#define IN_B_S 7
#define IN_G_OUT_CONV 8
#define IN_G_OUT_GMLP 9
#define IN_W_OUT 10
#define IN_G_XATTN 11
#define IN_G_MEM 12
#define IN_W_Q 13
#define IN_W_K 14
#define IN_W_V 15
#define IN_W_O 16
#define IN_G_FFN 17
#define IN_W_GRP 18
#define IN_B_GRP 19
#define IN_W_RT 20
#define IN_B_RT 21
#define IN_W_GATE 22
#define IN_W_UP 23
#define IN_W_DOWN 24
#define IN_G_FINAL 25

struct TrItem { const float* src; bf16_t* dst; const float* gk; int ldw, K; };
__device__ __forceinline__ void tr_load(const TrItem& t, float (&v)[32], int lane) {
    const float* p = t.src + (size_t)(lane >> 5) * t.ldw + (lane & 31);
#pragma unroll
    for (int i = 0; i < 32; ++i) v[i] = p[(size_t)(2 * i) * t.ldw];
}
__device__ __forceinline__ void tr_finish(const TrItem& t, const float (&v)[32], LAS float* scr, int lane) {
    float g8[8];
    if (t.gk) { const f32x4 ga = *(const f32x4*)(t.gk + 8 * (lane & 7)), gb = *(const f32x4*)(t.gk + 8 * (lane & 7) + 4); g8[0] = ga[0]; g8[1] = ga[1]; g8[2] = ga[2]; g8[3] = ga[3]; g8[4] = gb[0]; g8[5] = gb[1]; g8[6] = gb[2]; g8[7] = gb[3]; }
    else {
#pragma unroll
        for (int j = 0; j < 8; ++j) g8[j] = 1.f; }
#pragma unroll
    for (int i = 0; i < 32; ++i) scr[(2 * i + (lane >> 5)) * 33 + (lane & 31)] = v[i];
    LDS_WAIT(); asm volatile("" ::: "memory");
    const int c = lane & 7;
#pragma unroll
    for (int j = 0; j < 4; ++j) { const int n = (lane >> 3) + 8 * j; const LAS float* s = scr + (8 * c) * 33 + n;
        u32x4 o; o.x = pk2(s[0 * 33] * g8[0], s[1 * 33] * g8[1]); o.y = pk2(s[2 * 33] * g8[2], s[3 * 33] * g8[3]); o.z = pk2(s[4 * 33] * g8[4], s[5 * 33] * g8[5]); o.w = pk2(s[6 * 33] * g8[6], s[7 * 33] * g8[7]);
        *(u32x4*)(t.dst + (size_t)n * t.K + 8 * c) = o; }
    LDS_WAIT(); asm volatile("" ::: "memory");
}
__device__ __forceinline__ TrItem tr_make(const float* W, int ldw, int K, bf16_t* WT, int dst_row0, int src_col0, int k0, const float* gk = nullptr) {
    TrItem t; t.src = W + (size_t)k0 * ldw + src_col0; t.dst = WT + (size_t)dst_row0 * K + k0; t.gk = gk ? gk + k0 : nullptr; t.ldw = ldw; t.K = K; return t; }
__device__ __forceinline__ int in_map(int n0) {
    if (n0 < 512 || n0 >= 1536) return n0;
    const int j = (n0 - 512) >> 8, r = (n0 - 512) & 255;
    return r < 128 ? 512 + 128 * j + r : 1024 + 128 * j + (r - 128);
}
__device__ __forceinline__ void norm_row_bf16(const float* xrow, const float* g, bf16_t* orow, int lane) {
    const f32x4* xr = (const f32x4*)xrow + lane; const f32x4* gr = (const f32x4*)g + lane;
    f32x4 v[4]; float s = 0.f;
#pragma unroll
    for (int j = 0; j < 4; ++j) { v[j] = xr[64 * j]; s += (v[j].x * v[j].x + v[j].y * v[j].y) + (v[j].z * v[j].z + v[j].w * v[j].w); }
    const float rs = rsqrtf(wave_sum(s) * (1.f / 1024.f) + EPS);
    u32x2* o8 = (u32x2*)orow + lane;
#pragma unroll
    for (int j = 0; j < 4; ++j) { const f32x4 gg = gr[64 * j]; u32x2 w; w.x = pk2(v[j].x * rs * gg.x, v[j].y * rs * gg.y); w.y = pk2(v[j].z * rs * gg.z, v[j].w * rs * gg.w); o8[64 * j] = w; }
}
__device__ __forceinline__ void norm_rows4_bf16(const float* X, const float* g, bf16_t* O, int m, int stride, int M, int lane) {
    f32x4 v[4][4]; float s[4]; const f32x4* gr = (const f32x4*)g + lane;
#pragma unroll
    for (int r = 0; r < 4; ++r) { const int mr = (m + r * stride < M) ? m + r * stride : m; const f32x4* xr = (const f32x4*)(X + (size_t)mr * 1024) + lane;
#pragma unroll
        for (int j = 0; j < 4; ++j) v[r][j] = xr[64 * j]; }
#pragma unroll
    for (int r = 0; r < 4; ++r) { s[r] = 0.f;
#pragma unroll
        for (int j = 0; j < 4; ++j) s[r] += (v[r][j].x * v[r][j].x + v[r][j].y * v[r][j].y) + (v[r][j].z * v[r][j].z + v[r][j].w * v[r][j].w); }
#pragma unroll
    for (int r = 0; r < 4; ++r) { if (m + r * stride >= M) break; const float rs = rsqrtf(wave_sum(s[r]) * (1.f / 1024.f) + EPS); u32x2* o8 = (u32x2*)(O + (size_t)(m + r * stride) * 1024) + lane;
#pragma unroll
        for (int j = 0; j < 4; ++j) { const f32x4 gg = gr[64 * j]; u32x2 w; w.x = pk2(v[r][j].x * rs * gg.x, v[r][j].y * rs * gg.y); w.y = pk2(v[r][j].z * rs * gg.z, v[r][j].w * rs * gg.w); o8[64 * j] = w; } }
}
constexpr int PRO_I_IN = 16 * 80, PRO_I_SQ = 16 * 32, PRO_I_G = 16 * 16, PRO_I_D = 8 * 32, PRO_NITEMS = PRO_I_IN + 4 * PRO_I_SQ + NE * (2 * PRO_I_G + PRO_I_D);
__device__ __forceinline__ TrItem pro_item(const Args& a, unsigned char* ws, int it) {
    int r = it;
    if (r < PRO_I_IN) { const int kb = r / 80, nb = r % 80; return tr_make(a.in[IN_W_IN], INC, D, (bf16_t*)(ws + WS_WIN_T), 32 * nb, in_map(32 * nb), 64 * kb); } r -= PRO_I_IN;
    if (r < 4 * PRO_I_SQ) { const int q = r / PRO_I_SQ; r -= q * PRO_I_SQ; const int kb = r / 32, nb = r % 32;
        const float* W = a.in[q == 0 ? IN_W_OUT : (q == 1 ? IN_W_O : (q == 2 ? IN_W_K : IN_W_V))];
        bf16_t* WT = (bf16_t*)(ws + (q == 0 ? WS_WOUT_T : (q == 1 ? WS_WO_T : WS_WKV_T)));
        return tr_make(W, D, D, WT, (q == 3 ? 1024 : 0) + 32 * nb, 32 * nb, 64 * kb); }
    r -= 4 * PRO_I_SQ;
    const int e = r / (2 * PRO_I_G + PRO_I_D); r -= e * (2 * PRO_I_G + PRO_I_D);
    if (r < 2 * PRO_I_G) { const int up = r >= PRO_I_G; if (up) r -= PRO_I_G; const int kb = r / 16, nb = r % 16, n0 = 32 * nb;
        const int dst = 256 * (n0 >> 7) + (up ? 128 : 0) + (n0 & 127);
        return tr_make(a.in[up ? IN_W_UP : IN_W_GATE] + (size_t)e * D * DE, DE, D, (bf16_t*)(ws + WS_WGU_T) + (size_t)e * 1024 * 1024, dst, n0, 64 * kb, a.in[IN_G_FFN]); }
    r -= 2 * PRO_I_G;
    const int kb = r / 32, nb = r % 32;
    return tr_make(a.in[IN_W_DOWN] + (size_t)e * DE * D, D, DE, (bf16_t*)(ws + WS_WD_T) + (size_t)e * 1024 * 512, 32 * nb, 32 * nb, 64 * kb);
}
__device__ __forceinline__ void p0_prologue(const Frame& F, const Args& a) {
    LAS float* scr = (LAS float*)(F.lds + F.wave * 16384);
    const int lane = lane_id_fresh(), tid = F.wave * 64 + lane;
    unsigned char* ws = F.ws;
    const int gw = F.vcu * NWAVES + F.wave, NGW = F.G * NWAVES;
    {
        float va[32], vb[32]; TrItem ta, tb;
        int it = gw;
        if (it < PRO_NITEMS) { ta = pro_item(a, ws, it); tr_load(ta, va, lane); }
        while (it < PRO_NITEMS) {
            const int i1 = it + NGW; const bool h1 = i1 < PRO_NITEMS;
            if (h1) { tb = pro_item(a, ws, i1); tr_load(tb, vb, lane); }
            tr_finish(ta, va, scr, lane);
            if (!h1) break;
            const int i2 = i1 + NGW; const bool h2 = i2 < PRO_NITEMS;
            if (h2) { ta = pro_item(a, ws, i2); tr_load(ta, va, lane); }
            tr_finish(tb, vb, scr, lane);
            it = i2;
        }
    }
    for (int m = gw; m < T; m += 4 * NGW) norm_rows4_bf16(a.in[IN_X], a.in[IN_G_MIX], (bf16_t*)(ws + WS_HB), m, NGW, T, lane);
    for (int m = gw; m < B * ML; m += NGW) norm_row_bf16(a.in[IN_MEM] + (size_t)m * D, a.in[IN_G_MEM], (bf16_t*)(ws + WS_MEMN) + (size_t)m * D, lane);
    const int gt = F.vcu * NTHREADS + tid, NGT = F.G * NTHREADS;
    { const float* wq = a.in[IN_W_Q]; const float* gx = a.in[IN_G_XATTN]; bf16_t* o = (bf16_t*)(ws + WS_WQ_NAT);
      for (int i = gt; i < D * D / 2; i += NGT) { const int k = (2 * i) >> 10; const float sc = gx[k] * (1.4426950408889634f * 0.0625f); const f32x2 v = *(const f32x2*)(wq + 2 * i); *(unsigned*)(o + 2 * i) = pk2(v.x * sc, v.y * sc); } }
    { const float* w = a.in[IN_W_S]; bf16_t* o = (bf16_t*)(ws + WS_WS_BF);
      for (int i = gt; i < NH * CHUNK * CHUNK; i += NGT) { const int s = i & 127, t = (i >> 7) & 127; o[i] = (bf16_t)f2bf(s <= t ? w[i] : 0.f); } }
    { const float* wg = a.in[IN_W_GRP]; const float* wr = a.in[IN_W_RT]; const float* gf = a.in[IN_G_FFN]; bf16_t* o = (bf16_t*)(ws + WS_WR);
      for (int i = gt; i < 48 * 1024; i += NGT) { const int n = i >> 10, k = i & 1023; float v = 0.f;
          if (n < 4) v = wg[(size_t)k * NG + n] * gf[k]; else if (n < 36) v = wr[(size_t)k * NE + (n - 4)] * gf[k];
          const unsigned hi = f2bf(v); const float lo = v - __uint_as_float(hi << 16); o[i] = (bf16_t)hi; o[48 * 1024 + i] = (bf16_t)f2bf(lo); } }
}

__device__ __forceinline__ void unpack8(const u32x4 w, float (&f)[8]) { f[0] = bf_lo(w.x); f[1] = bf_hi(w.x); f[2] = bf_lo(w.y); f[3] = bf_hi(w.y); f[4] = bf_lo(w.z); f[5] = bf_hi(w.z); f[6] = bf_lo(w.w); f[7] = bf_hi(w.w); }
constexpr int VT_PITCH = 136, VT_HEAD = 128 * VT_PITCH, MIX_EXCH = 8 * VT_HEAD;
__device__ __forceinline__ void mixer_unit(const Frame& F, const Args& a, int ch) {
    const int t0 = ch * 128, w = F.wave, l = lane_id_fresh();
    unsigned char* ws = F.ws;
    const bf16_t* GBp = (const bf16_t*)(ws + WS_GB); const bf16_t* Zp = (const bf16_t*)(ws + WS_Z); const bf16_t* UGp = (const bf16_t*)(ws + WS_UG); const bf16_t* VGp = (const bf16_t*)(ws + WS_VG);
    bf16_t* Y = (bf16_t*)(ws + WS_Y);
    __syncthreads();
    const int h = w;
    u32x4 vraw[16], uraw[16];
    { const int d8 = 8 * (l & 7);
#pragma unroll
      for (int it = 0; it < 16; ++it) vraw[it] = *(const u32x4*)(VGp + (size_t)(t0 + 8 * it + (l >> 3)) * 512 + h * 64 + d8);
#pragma unroll
      for (int it = 0; it < 16; ++it) uraw[it] = *(const u32x4*)(UGp + (size_t)(t0 + 8 * it + (l >> 3)) * 512 + h * 64 + d8); }
    asm volatile("" ::: "memory");
    {
        const int c = 8 * l;
        float w0[8], w1[8], w2[8], ga[8], zp1[8], zp2[8];
        const float* cw = a.in[IN_CONV_W]; const float* gc = a.in[IN_G_OUT_CONV];
#pragma unroll
        for (int j = 0; j < 8; ++j) { w0[j] = cw[c + j]; w1[j] = cw[CW + c + j]; w2[j] = cw[2 * CW + c + j]; ga[j] = gc[c + j]; }
        const int r0 = 16 * w, pos0 = (t0 & (S - 1)) + r0;
        if (pos0 >= 2) { unpack8(*(const u32x4*)(Zp + (size_t)(t0 + r0 - 1) * 512 + c), zp1); unpack8(*(const u32x4*)(Zp + (size_t)(t0 + r0 - 2) * 512 + c), zp2); }
        else {
#pragma unroll
            for (int j = 0; j < 8; ++j) { zp1[j] = 0.f; zp2[j] = 0.f; } }
#pragma unroll 8
        for (int r = 0; r < 16; ++r) {
            const size_t t = (size_t)(t0 + r0 + r);
            float gb[8], z[8], ya[8]; unpack8(*(const u32x4*)(GBp + t * 512 + c), gb); unpack8(*(const u32x4*)(Zp + t * 512 + c), z);
            float sq = 0.f;
#pragma unroll
            for (int j = 0; j < 8; ++j) { ya[j] = gb[j] * (w2[j] * z[j] + w1[j] * zp1[j] + w0[j] * zp2[j]); sq += ya[j] * ya[j]; zp2[j] = zp1[j]; zp1[j] = z[j]; }
            const float rs = rsqrtf(wave_sum(sq) * (1.f / 512.f) + EPS);
            u32x4 o; o.x = pk2(ya[0] * rs * ga[0], ya[1] * rs * ga[1]); o.y = pk2(ya[2] * rs * ga[2], ya[3] * rs * ga[3]); o.z = pk2(ya[4] * rs * ga[4], ya[5] * rs * ga[5]); o.w = pk2(ya[6] * rs * ga[6], ya[7] * rs * ga[7]);
            *(u32x4*)(Y + t * 1024 + c) = o;
        }
    }
    asm volatile("" ::: "memory");
    LAS unsigned char* vt = F.lds + h * VT_HEAD;
    {
        const int d8 = 8 * (l & 7); float gv[8];
#pragma unroll
        for (int j = 0; j < 8; ++j) gv[j] = a.in[IN_G_V][h * 64 + d8 + j];
#pragma unroll
        for (int it = 0; it < 16; ++it) { const int s = 8 * it + (l >> 3); float v[8]; unpack8(vraw[it], v);
            float sq = 0.f;
#pragma unroll
            for (int j = 0; j < 8; ++j) sq += v[j] * v[j];
            sq += __shfl_xor(sq, 1); sq += __shfl_xor(sq, 2); sq += __shfl_xor(sq, 4);
            const float rs = rsqrtf(sq * (1.f / 64.f) + EPS);
            u32x2 lo, hi; lo.x = pk2(v[0] * rs * gv[0], v[1] * rs * gv[1]); lo.y = pk2(v[2] * rs * gv[2], v[3] * rs * gv[3]); hi.x = pk2(v[4] * rs * gv[4], v[5] * rs * gv[5]); hi.y = pk2(v[6] * rs * gv[6], v[7] * rs * gv[7]);
            *(LAS u32x2*)(vt + s * VT_PITCH + d8 * 2) = lo; *(LAS u32x2*)(vt + s * VT_PITCH + d8 * 2 + 8) = hi; }
    }
    __syncthreads();
    const int fr = l & 15, fq = l >> 4, trq = (l & 15) >> 2, trp = l & 3;
    const bf16_t* wsb = (const bf16_t*)(ws + WS_WS_BF) + (size_t)h * CHUNK * CHUNK;
    const unsigned wloff = (unsigned)(fr * CHUNK + 8 * fq);
    const float* bsp = a.in[IN_B_S] + h * CHUNK;
#pragma unroll 1
    for (int half = 0; half < 2; ++half) {
        f32x4 acc[8][2];
#pragma unroll
        for (int m = 0; m < 8; ++m)
#pragma unroll
            for (int n = 0; n < 2; ++n) acc[m][n] = (f32x4){0.f, 0.f, 0.f, 0.f};
#pragma unroll
        for (int ks = 0; ks < 4; ++ks) {
            unsigned wl = wloff; asm volatile("" : "+v"(wl));
            bf16x8 af[2];
#pragma unroll
            for (int n = 0; n < 2; ++n) { const int dc = 32 * half + 16 * n + 4 * trp;
                const s16x4 lo = __builtin_bit_cast(s16x4, __builtin_amdgcn_ds_read_tr16_b64_v4i16((LAS s16x4*)(vt + (32 * ks + 8 * fq + trq) * VT_PITCH + dc * 2)));
                const s16x4 hi = __builtin_bit_cast(s16x4, __builtin_amdgcn_ds_read_tr16_b64_v4i16((LAS s16x4*)(vt + (32 * ks + 8 * fq + 4 + trq) * VT_PITCH + dc * 2)));
                af[n] = (bf16x8){lo[0], lo[1], lo[2], lo[3], hi[0], hi[1], hi[2], hi[3]}; }
#pragma unroll
            for (int m = 2 * ks; m < 8; ++m) {
                const bf16x8 bfr = *(const bf16x8*)(wsb + (16 * m * CHUNK + 32 * ks) + wl);
#pragma unroll
                for (int n = 0; n < 2; ++n) acc[m][n] = __builtin_amdgcn_mfma_f32_16x16x32_bf16(af[n], bfr, acc[m][n], 0, 0, 0);
            }
        }
#pragma unroll
        for (int m = 0; m < 8; ++m) { const float bs = bsp[16 * m + fr];
#pragma unroll
            for (int n = 0; n < 2; ++n) { const int dc = 32 * half + 16 * n + 4 * fq;
                u32x2 o; o.x = pk2(acc[m][n][0] + bs, acc[m][n][1] + bs); o.y = pk2(acc[m][n][2] + bs, acc[m][n][3] + bs);
                *(LAS u32x2*)(vt + (16 * m + fr) * VT_PITCH + dc * 2) = o; } }
    }
    asm volatile("s_waitcnt lgkmcnt(0)" ::: "memory");
    LAS float* exch = (LAS float*)(F.lds + MIX_EXCH);
    {
        const int d8 = 8 * (l & 7);
#pragma unroll
        for (int it = 0; it < 16; ++it) { const int sidx = 8 * it + (l >> 3);
            const u32x2 lo = *(const LAS u32x2*)(vt + sidx * VT_PITCH + d8 * 2), hi = *(const LAS u32x2*)(vt + sidx * VT_PITCH + d8 * 2 + 8);
            float uf[8]; unpack8(uraw[it], uf);
            const float y0 = uf[0] * bf_lo(lo.x), y1 = uf[1] * bf_hi(lo.x), y2 = uf[2] * bf_lo(lo.y), y3 = uf[3] * bf_hi(lo.y), y4 = uf[4] * bf_lo(hi.x), y5 = uf[5] * bf_hi(hi.x), y6 = uf[6] * bf_lo(hi.y), y7 = uf[7] * bf_hi(hi.y);
            float sq = ((y0 * y0 + y1 * y1) + (y2 * y2 + y3 * y3)) + ((y4 * y4 + y5 * y5) + (y6 * y6 + y7 * y7));
            sq += __shfl_xor(sq, 1); sq += __shfl_xor(sq, 2); sq += __shfl_xor(sq, 4);
            if ((l & 7) == 0) exch[h * CHUNK + sidx] = sq;
            uraw[it] = (u32x4){pk2(y0, y1), pk2(y2, y3), pk2(y4, y5), pk2(y6, y7)}; }
    }
    __syncthreads();
    {
        const int d8 = 8 * (l & 7); float gg[8];
#pragma unroll
        for (int j = 0; j < 8; ++j) gg[j] = a.in[IN_G_OUT_GMLP][h * 64 + d8 + j];
#pragma unroll
        for (int it = 0; it < 16; ++it) { const int sidx = 8 * it + (l >> 3); float tot = 0.f;
#pragma unroll
            for (int hh = 0; hh < 8; ++hh) tot += exch[hh * CHUNK + sidx];
            const float rs = rsqrtf(tot * (1.f / 512.f) + EPS);
            float yf[8]; unpack8(uraw[it], yf);
            u32x4 o; o.x = pk2(yf[0] * rs * gg[0], yf[1] * rs * gg[1]); o.y = pk2(yf[2] * rs * gg[2], yf[3] * rs * gg[3]); o.z = pk2(yf[4] * rs * gg[4], yf[5] * rs * gg[5]); o.w = pk2(yf[6] * rs * gg[6], yf[7] * rs * gg[7]);
            *(u32x4*)(Y + (size_t)(t0 + sidx) * 1024 + 512 + h * 64 + d8) = o; }
    }
}

constexpr int RT_XS_PITCH = 272;
constexpr int RT_XS_WAVE = 16 * RT_XS_PITCH;
constexpr int RT_SLAB_OFF = 8 * RT_XS_WAVE;
constexpr int RT_LG_OFF = RT_SLAB_OFF + 2 * 24576;
__device__ __forceinline__ void router_block(const Frame& F, const Args& a, int blk) {
    const int l = lane_id_fresh(), w = F.wave, fr = l & 15, fq = l >> 4, tid = w * 64 + l;
    unsigned char* ws = F.ws;
    LAS unsigned char* xs = F.lds + w * RT_XS_WAVE;
    LAS float* slab = (LAS float*)(F.lds + RT_SLAB_OFF);
    LAS float* lg = (LAS float*)(F.lds + RT_LG_OFF);
    LAS float* biasl = lg + 128 * 48;
    LAS int* histl = (LAS int*)(biasl + 64);
    __syncthreads();
    if (tid < 32) histl[tid] = 0;
    if (tid >= 64 && tid < 64 + 36) { const int n = tid - 64; biasl[n] = n < 4 ? a.in[IN_B_GRP][n] : a.in[IN_B_RT][n - 4]; }
    bf16x8 bh[4][3], bl[4][3];
    { const bf16_t* wh = (const bf16_t*)(ws + WS_WR) + (size_t)fr * 1024 + 128 * w + 8 * fq; const bf16_t* wl = wh + 48 * 1024;
#pragma unroll
      for (int ks = 0; ks < 4; ++ks)
#pragma unroll
          for (int nt = 0; nt < 3; ++nt) { bh[ks][nt] = *(const bf16x8*)(wh + (size_t)nt * 16 * 1024 + 32 * ks); bl[ks][nt] = *(const bf16x8*)(wl + (size_t)nt * 16 * 1024 + 32 * ks); } }
    const bf16_t* xg = (const bf16_t*)(ws + WS_X2B) + (size_t)(blk * 128 + fq) * D + 128 * w + 8 * fr;
    u32x4 bufA[4], bufB[4];
#define RT_LOAD(buf, tg) do { _Pragma("unroll") for (int j = 0; j < 4; ++j) buf[j] = *(const u32x4*)(xg + (size_t)(16 * (tg) + 4 * j) * D); } while (0)
#define RT_GROUP(buf, tg) do { \
        float sq[4]; \
        _Pragma("unroll") for (int j = 0; j < 4; ++j) { const u32x4 v = buf[j]; float f[8]; unpack8(v, f); \
            sq[j] = ((f[0] * f[0] + f[1] * f[1]) + (f[2] * f[2] + f[3] * f[3])) + ((f[4] * f[4] + f[5] * f[5]) + (f[6] * f[6] + f[7] * f[7])); \
            *(LAS u32x4*)(xs + (4 * j + fq) * RT_XS_PITCH + 16 * fr) = v; } \
        asm volatile("s_waitcnt lgkmcnt(0)" ::: "memory"); \
        f32x4 acc[3] = {(f32x4){0.f, 0.f, 0.f, 0.f}, (f32x4){0.f, 0.f, 0.f, 0.f}, (f32x4){0.f, 0.f, 0.f, 0.f}}; \
        _Pragma("unroll") for (int ks = 0; ks < 4; ++ks) { \
            const bf16x8 ah = *(const LAS bf16x8*)(xs + fr * RT_XS_PITCH + (32 * ks + 8 * fq) * 2); \
            _Pragma("unroll") for (int nt = 0; nt < 3; ++nt) { \
                acc[nt] = __builtin_amdgcn_mfma_f32_16x16x32_bf16(ah, bh[ks][nt], acc[nt], 0, 0, 0); \
                acc[nt] = __builtin_amdgcn_mfma_f32_16x16x32_bf16(ah, bl[ks][nt], acc[nt], 0, 0, 0); } } \
        LAS float* sl = slab + ((tg) & 1) * 6144 + w * 768;                    \
        _Pragma("unroll") for (int nt = 0; nt < 3; ++nt) { if (nt < 2 || fr < 4) { _Pragma("unroll") for (int r = 0; r < 4; ++r) sl[(4 * fq + r) * 48 + 16 * nt + fr] = acc[nt][r]; } } \
        _Pragma("unroll") for (int j = 0; j < 4; ++j) { float v = sq[j]; \
            _Pragma("unroll") for (int o = 1; o < 16; o <<= 1) v += __shfl_xor(v, o); \
            if (fr == 0) sl[(4 * j + fq) * 48 + 36] = v; } \
        asm volatile("s_waitcnt lgkmcnt(0)" ::: "memory"); __builtin_amdgcn_s_barrier(); asm volatile("" ::: "memory"); \
        for (int o = tid; o < 16 * 37; o += NTHREADS) { const int tk = o / 37, c = o - tk * 37; const LAS float* sp = slab + ((tg) & 1) * 6144 + tk * 48 + c; \
            float s8 = 0.f; _Pragma("unroll") for (int ww = 0; ww < 8; ++ww) s8 += sp[ww * 768]; lg[(16 * (tg) + tk) * 48 + c] = s8; } \
    } while (0)
    RT_LOAD(bufA, 0);
#pragma unroll 1
    for (int tg = 0; tg < 8; tg += 2) {
        RT_LOAD(bufB, tg + 1);
        RT_GROUP(bufA, tg);
        if (tg + 2 < 8) RT_LOAD(bufA, tg + 2);
        RT_GROUP(bufB, tg + 1);
    }
#undef RT_LOAD
#undef RT_GROUP
    __syncthreads();
    if (tid < 128) {
        const int tl = tid, t = blk * 128 + tl; const LAS float* L = lg + tl * 48; const float rs = rsqrtf(L[36] * (1.f / 1024.f) + EPS);
        float g4[4];
#pragma unroll
        for (int i = 0; i < 4; ++i) g4[i] = L[i] * rs + biasl[i];
        int g = 0; float mx = g4[0];
#pragma unroll
        for (int i = 1; i < 4; ++i) if (g4[i] > mx) { mx = g4[i]; g = i; }
        float den = 0.f;
#pragma unroll
        for (int i = 0; i < 4; ++i) den += __expf(g4[i] - mx);
        const float gp = 1.f / den;
        float e8[8];
#pragma unroll
        for (int i = 0; i < 8; ++i) e8[i] = L[4 + g * 8 + i] * rs + biasl[4 + g * 8 + i];
        int i0 = 0; float v0 = e8[0];
#pragma unroll
        for (int i = 1; i < 8; ++i) if (e8[i] > v0) { v0 = e8[i]; i0 = i; }
        int i1 = -1; float v1 = -3.0e38f;
#pragma unroll
        for (int i = 0; i < 8; ++i) if (i != i0 && e8[i] > v1) { v1 = e8[i]; i1 = i; }
        const float ex = __expf(v1 - v0);
        const float g0 = gp / (1.f + ex), g1 = gp * ex / (1.f + ex);
        const int ex0 = g * 8 + i0, ex1 = g * 8 + i1;
        const int r0 = __hip_atomic_fetch_add((int*)(histl + ex0), 1, __ATOMIC_RELAXED, __HIP_MEMORY_SCOPE_WORKGROUP), r1 = __hip_atomic_fetch_add((int*)(histl + ex1), 1, __ATOMIC_RELAXED, __HIP_MEMORY_SCOPE_WORKGROUP);
        *(int2*)((int*)(ws + RT_TOK_E) + 2 * t) = make_int2(ex0, ex1); *(float2*)((float*)(ws + RT_TOK_G) + 2 * t) = make_float2(g0, g1);
        *(int2*)((int*)(ws + RT_TOK_R) + 2 * t) = make_int2(r0, r1); ((float*)(ws + RT_RS2))[t] = rs;
    }
    __syncthreads();
    if (tid < 32) ((int*)(ws + RT_HIST))[blk * 32 + tid] = histl[tid];
}
__device__ __forceinline__ void assign_block(const Frame& F, const Args& a, int blk) {
    const int l = lane_id_fresh(), w = F.wave, tid = w * 64 + l;
    unsigned char* ws = F.ws;
    LAS int* ptot = (LAS int*)F.lds;
    LAS int* ppre = ptot + 512;
    LAS int* base = ppre + 512;
    LAS int* ebase = base + 32;
    __syncthreads();
    { const int e = tid & 31, part = tid >> 5; const int* H = (const int*)(ws + RT_HIST); int st = 0, sp = 0; int hv[16];
#pragma unroll
      for (int i = 0; i < 16; ++i) hv[i] = H[(part * 16 + i) * 32 + e];
#pragma unroll
      for (int i = 0; i < 16; ++i) { st += hv[i]; sp += (part * 16 + i < blk) ? hv[i] : 0; }
      ptot[part * 32 + e] = st; ppre[part * 32 + e] = sp; }
    __syncthreads();
    if (tid < 32) { int st = 0, sp = 0; for (int p = 0; p < 16; ++p) { st += ptot[p * 32 + tid]; sp += ppre[p * 32 + tid]; } ptot[tid] = st; ppre[tid] = sp; }
    __syncthreads();
    if (tid == 0) { int run = 0;
        for (int e = 0; e < 32; ++e) { base[e] = run * 256 + ppre[e]; ebase[e] = run * 256 + ptot[e]; ebase[64 + e] = run; run += (ptot[e] + 255) >> 8; ebase[32 + e] = run * 256; }
        if (blk == 0) ((int*)(ws + RT_TILE_E))[0] = run; }
    __syncthreads();
    if (blk == 0 && tid < 32) { int* te = (int*)(ws + RT_TILE_E); const int r0 = ebase[64 + tid], nt = (ebase[32 + tid] >> 8) - r0; for (int i = 0; i < nt; ++i) te[16 + r0 + i] = tid; }
    int* tos = (int*)(ws + RT_TOK_OF_SLOT); float* rss = (float*)(ws + RT_RS_SLOT); float* gts = (float*)(ws + RT_GATE_SLOT);
    if (tid < 256) { const int t = blk * 128 + (tid >> 1), k = tid & 1;
        const int e = ((const int*)(ws + RT_TOK_E))[2 * t + k], r = ((const int*)(ws + RT_TOK_R))[2 * t + k];
        const int slot = base[e] + r;
        ((int*)(ws + RT_SLOT_OF))[2 * t + k] = slot; tos[slot] = t; rss[slot] = ((const float*)(ws + RT_RS2))[t]; gts[slot] = ((const float*)(ws + RT_TOK_G))[2 * t + k]; }
    if (blk < 32) {
        for (int sl = ebase[blk] + tid; sl < ebase[32 + blk]; sl += NTHREADS) { tos[sl] = 0; rss[sl] = 0.f; gts[sl] = 0.f; } }
}
__device__ __forceinline__ void combine_rows(const Frame& F, const Args& a, float* outp) {
    const int l = lane_id_fresh();
    unsigned char* ws = F.ws;
    const int gw = F.vcu * NWAVES + F.wave, NGW = F.G * NWAVES;
    const f32x4* gfin = (const f32x4*)a.in[IN_G_FINAL] + l;
    f32x4 gf4[4];
#pragma unroll
    for (int j = 0; j < 4; ++j) gf4[j] = gfin[64 * j];
    const int* slot_of = (const int*)(ws + RT_SLOT_OF); const bf16_t* Y = (const bf16_t*)(ws + WS_YSLOT); const bf16_t* XB = (const bf16_t*)(ws + WS_X2B);
    for (int t = gw; t < T; t += 2 * NGW) {
        const int tb = t + NGW; const bool hb = tb < T; const int t2 = hb ? tb : t;
        const int2 sa = *(const int2*)(slot_of + 2 * t), sb = *(const int2*)(slot_of + 2 * t2);
        const u32x2* xa = (const u32x2*)(XB + (size_t)t * D) + l; const u32x2* xb = (const u32x2*)(XB + (size_t)t2 * D) + l;
        const u32x2* ya0 = (const u32x2*)(Y + (size_t)sa.x * D) + l; const u32x2* ya1 = (const u32x2*)(Y + (size_t)sa.y * D) + l;
        const u32x2* yb0 = (const u32x2*)(Y + (size_t)sb.x * D) + l; const u32x2* yb1 = (const u32x2*)(Y + (size_t)sb.y * D) + l;
        f32x4 va[4], vb[4]; u32x2 ra[4], pa[4], qa[4], rb[4], pb[4], qb[4];
#pragma unroll
        for (int j = 0; j < 4; ++j) { ra[j] = xa[64 * j]; pa[j] = ya0[64 * j]; qa[j] = ya1[64 * j]; rb[j] = xb[64 * j]; pb[j] = yb0[64 * j]; qb[j] = yb1[64 * j]; }
        float sqa = 0.f, sqb = 0.f;
#pragma unroll
        for (int j = 0; j < 4; ++j) {
            va[j].x = bf_lo(ra[j].x) + bf_lo(pa[j].x) + bf_lo(qa[j].x); va[j].y = bf_hi(ra[j].x) + bf_hi(pa[j].x) + bf_hi(qa[j].x); va[j].z = bf_lo(ra[j].y) + bf_lo(pa[j].y) + bf_lo(qa[j].y); va[j].w = bf_hi(ra[j].y) + bf_hi(pa[j].y) + bf_hi(qa[j].y);
            vb[j].x = bf_lo(rb[j].x) + bf_lo(pb[j].x) + bf_lo(qb[j].x); vb[j].y = bf_hi(rb[j].x) + bf_hi(pb[j].x) + bf_hi(qb[j].x); vb[j].z = bf_lo(rb[j].y) + bf_lo(pb[j].y) + bf_lo(qb[j].y); vb[j].w = bf_hi(rb[j].y) + bf_hi(pb[j].y) + bf_hi(qb[j].y);
            sqa += (va[j].x * va[j].x + va[j].y * va[j].y) + (va[j].z * va[j].z + va[j].w * va[j].w); sqb += (vb[j].x * vb[j].x + vb[j].y * vb[j].y) + (vb[j].z * vb[j].z + vb[j].w * vb[j].w); }
        const float rsa = rsqrtf(wave_sum(sqa) * (1.f / 1024.f) + EPS), rsb = rsqrtf(wave_sum(sqb) * (1.f / 1024.f) + EPS);
        f32x4* oa = (f32x4*)(outp + (size_t)t * D) + l; f32x4* ob = (f32x4*)(outp + (size_t)t2 * D) + l;
#pragma unroll
        for (int j = 0; j < 4; ++j) { oa[64 * j] = va[j] * rsa * gf4[j]; if (hb) ob[64 * j] = vb[j] * rsb * gf4[j]; }
    }
}

#define XB_TMO      128
#define XB_XCNT(j)  (256  + 64 * (j))
#define XB_XSUB(j)  (1280 + 64 * (j))
#define XB_XGEN(j)  (2304 + 64 * (j))
#define XB_TOP      3328
#define XB_TOPGEN   3392
#define XCD_BAR_WORDS 3456
#define XB_SPIN_CAP (1u << 20)
__device__ __forceinline__ unsigned xb_ld(unsigned* p)              { return __hip_atomic_load(p, __ATOMIC_RELAXED, __HIP_MEMORY_SCOPE_AGENT); }
__device__ __forceinline__ unsigned xb_add(unsigned* p, unsigned v) { return __hip_atomic_fetch_add(p, v, __ATOMIC_RELAXED, __HIP_MEMORY_SCOPE_AGENT); }
__device__ __forceinline__ unsigned xb_xcc_id() { return (unsigned)__builtin_amdgcn_s_getreg((3 << 11) | 20) & 0xFu; }
#define XB_SPIN(cond, bar) do { unsigned _sp = 0; while (cond) { __builtin_amdgcn_s_sleep(1); \
    if ((++_sp & 255u) == 0u) { if (xb_ld(&(bar)[XB_TMO])) break; if (_sp > XB_SPIN_CAP) { atomicAdd(&(bar)[XB_TMO], 1u); break; } } } } while (0)
struct XcdBarrier { unsigned* bar; unsigned x; volatile LAS unsigned* st; };
__device__ __forceinline__ XcdBarrier xcd_barrier_post(unsigned* bar, volatile LAS unsigned* st) {
    XcdBarrier b; b.bar = bar; b.x = xb_xcc_id(); b.st = st;
    if (threadIdx.x == 0) (void)xb_add(&bar[XB_XCNT(b.x)], 1u);
    return b;
}
__device__ __forceinline__ void xcd_barrier_complete(unsigned* bar, unsigned x, unsigned& nloc, unsigned& nx) {
    const unsigned G = gridDim.x * gridDim.y * gridDim.z;
    unsigned sum, cnt, mine, sp = 0u;
    for (;;) {
        sum = 0u; cnt = 0u; mine = 0u;
#pragma unroll
        for (unsigned j = 0; j < 16; ++j) { const unsigned c = xb_ld(&bar[XB_XCNT(j)]); sum += c; cnt += (c > 0u) ? 1u : 0u; mine = (j == x) ? c : mine; }
        if (sum == G) break;
        __builtin_amdgcn_s_sleep(1);
        if ((++sp & 255u) == 0u) { if (xb_ld(&bar[XB_TMO])) break; if (sp > XB_SPIN_CAP) { atomicAdd(&bar[XB_TMO], 1u); break; } }
    }
    nloc = mine > 0u ? mine : 1u; nx = cnt > 0u ? cnt : 1u;
}
__device__ __forceinline__ void xcd_barrier(const XcdBarrier& b, const int wave) {
    asm volatile("s_waitcnt vmcnt(0)" ::: "memory");
    __syncthreads();
    if (wave == 0 && lane_id_fresh() == 0) {
        unsigned* bar = b.bar;
        __builtin_amdgcn_s_waitcnt(0);
        unsigned nloc = b.st[0], nx = b.st[1];
        if (nloc == 0u) { xcd_barrier_complete(bar, b.x, nloc, nx); b.st[0] = nloc; b.st[1] = nx; }
        const unsigned old = xb_add(&bar[XB_XSUB(b.x)], 1u);
        const unsigned gen = old / nloc;
        if (old + 1u == (gen + 1u) * nloc) {
            __builtin_amdgcn_fence(__ATOMIC_RELEASE, "agent");
            asm volatile("s_waitcnt vmcnt(0)" ::: "memory");
            const unsigned og = xb_add(&bar[XB_TOP], 1u);
            const unsigned tg = og / nx;
            if (og + 1u == (tg + 1u) * nx) xb_add(&bar[XB_TOPGEN], 1u);
            else XB_SPIN(xb_ld(&bar[XB_TOPGEN]) == tg, bar);
            __builtin_amdgcn_fence(__ATOMIC_ACQUIRE, "agent");
            xb_add(&bar[XB_XGEN(b.x)], 1u);
            asm volatile("s_waitcnt vmcnt(0)" ::: "memory");
        } else {
            XB_SPIN(xb_ld(&bar[XB_XGEN(b.x)]) == gen, bar);
            __builtin_amdgcn_fence(__ATOMIC_ACQUIRE, "agent");
            asm volatile("s_waitcnt vmcnt(0)" ::: "memory");
        }
    }
    __syncthreads();
}

__global__ void __launch_bounds__(NTHREADS, 2) mk_fwd(Args args) {
    extern __shared__ __attribute__((aligned(16))) unsigned char lds_raw[];
    Frame F;
    F.lds = (LAS unsigned char*)lds_raw;
    F.wave = __builtin_amdgcn_readfirstlane((int)threadIdx.x >> 6);
    F.G = gridDim.x; { const int bx = blockIdx.x; F.vcu = (F.G % 8 == 0) ? (bx % 8) * (F.G / 8) + bx / 8 : bx; }
    F.ws = args.ws; F.out = args.out;
    unsigned char* ws = args.ws;
    const int lo = args.ph_lo, hi = args.ph_hi;
    if (threadIdx.x < 64) ((LAS unsigned*)(F.lds + LDS_MISC))[threadIdx.x] = 0u;
    __syncthreads();
    XcdBarrier xbar; xbar.bar = (unsigned*)(ws + WS_CTL) + 4096; xbar.x = 0; xbar.st = nullptr;
    if (hi - lo > 1) xbar = xcd_barrier_post((unsigned*)(ws + WS_CTL) + 4096, (volatile LAS unsigned*)(F.lds + LDS_MISC) + 8);
#define IN(k) (lo <= (k) && (k) < hi)
#define SEAM(k) do { if (IN(k) && IN((k) + 1)) xcd_barrier(xbar, F.wave); } while (0)
    if (IN(0)) p0_prologue(F, args);
    SEAM(0);
    if (IN(1)) {
        { pg8::DenseOrder S; S.init(T, INC, F.G, (int)blockIdx.x, ws + WS_HB, D, ws + WS_WIN_T, D);
          EpiInProj E{(bf16_t*)(ws + WS_GB), (bf16_t*)(ws + WS_Z), (bf16_t*)(ws + WS_UG), (bf16_t*)(ws + WS_VG)};
          pg8::gemm_phase<D, D, D>(F.lds, F.wave, S, E); }
        { pg8::DenseOrder S; S.init(B * ML, 2 * D, F.G, (int)blockIdx.x, ws + WS_MEMN, D, ws + WS_WKV_T, D);
          EpiBf16 E{(bf16_t*)(ws + WS_KV), 2 * D};
          pg8::gemm_phase<D, D, D>(F.lds, F.wave, S, E); }
    }
    SEAM(1);
    if (IN(2)) {
        for (int ch = F.vcu; ch < T / CHUNK; ch += F.G) mixer_unit(F, args, ch);
    }
    SEAM(2);
    if (IN(3)) {
        { WqkOrder S{F.G, (int)blockIdx.x, (const char*)(ws + WS_KV), (const char*)(ws + WS_WQ_NAT)}; EpiBf16Aux E{(bf16_t*)(ws + WS_WQK_T), 1024};
          pg8::gemm_phase<2 * D, D, XD>(F.lds, F.wave, S, E); }
        { VwOrder S{F.G, (int)((blockIdx.x + F.G / 2) % F.G), (const char*)(ws + WS_KV), (const char*)(ws + WS_WO_T)}; EpiBf16Aux E{(bf16_t*)(ws + WS_VW_T), 1024};
          pg8::gemm_phase<D, 2 * D, XD>(F.lds, F.wave, S, E); }
        pg8::DenseOrder S; S.init(T, D, F.G, (int)blockIdx.x, ws + WS_Y, D, ws + WS_WOUT_T, D);
        EpiResidA E{args.in[IN_X], (bf16_t*)(ws + WS_X1B), (float*)(ws + WS_SSQ1)};
        pg8::gemm_phase<D, D, D>(F.lds, F.wave, S, E);
    }
    SEAM(3);
    if (IN(4)) {
        pg8::DenseOrder S; S.init(T, D, F.G, (int)blockIdx.x, ws + WS_X1B, D, ws + WS_WQK_T, D, S_TILES, (size_t)D * D * 2);
        EpiSoftmax E{(const float*)(ws + WS_SSQ1), (bf16_t*)(ws + WS_P)};
        pg8::gemm_phase<D, D, D>(F.lds, F.wave, S, E);
    }
    SEAM(4);
    if (IN(5)) {
        pg8::DenseOrder S; S.init(T, D, F.G, (int)blockIdx.x, ws + WS_P, D, ws + WS_VW_T, D, S_TILES, (size_t)D * D * 2);
        EpiResidB E{(const bf16_t*)(ws + WS_X1B), (bf16_t*)(ws + WS_X2B)};
        pg8::gemm_phase<D, D, D>(F.lds, F.wave, S, E);
    }
    SEAM(5);
    if (IN(6)) { for (int blk = F.vcu; blk < T / 128; blk += F.G) router_block(F, args, blk); }
    SEAM(6);
    if (IN(7)) { for (int blk = F.vcu; blk < T / 128; blk += F.G) assign_block(F, args, blk); }
    SEAM(7);
    if (IN(8)) {
        GroupedOrder S; S.init(F.G, (int)blockIdx.x, (const int*)(ws + RT_TILE_E), ws + WS_X2B, D, ws + WS_WGU_T, D, (size_t)1024 * 1024 * 2, true);
        EpiSwiGLU E{(bf16_t*)(ws + WS_HID), (const float*)(ws + RT_RS_SLOT)};
        pg8::gemm_phase<D, D, D, true>(F.lds, F.wave, S, E, (const int*)(ws + RT_TOK_OF_SLOT));
    }
    SEAM(8);
    if (IN(9)) {
        GroupedOrder S; S.init(F.G, (int)blockIdx.x, (const int*)(ws + RT_TILE_E), ws + WS_HID, DE, ws + WS_WD_T, DE, (size_t)1024 * 512 * 2);
        EpiDown E{(bf16_t*)(ws + WS_YSLOT), (const float*)(ws + RT_GATE_SLOT)};
        pg8::gemm_phase<DE, DE, DE>(F.lds, F.wave, S, E);
    }
    SEAM(9);
    if (IN(10)) { combine_rows(F, args, F.out); }
#undef IN
#undef SEAM
}
extern "C" void kernel_launch(void* const* d_in, const int* in_sizes, int n_in, void* d_out, int out_size, void* d_ws, size_t ws_size, hipStream_t stream) {
    if (n_in != 26 || out_size != T * D || ws_size < 500 * MiB) { fprintf(stderr, "kernel_launch: unexpected shapes n_in %d out %d ws %zu\n", n_in, out_size, ws_size); return; }
    float* xres = (float*)d_out;
    static int grid = 0;
    if (grid == 0) {
        int dev = 0, cus = 0, per_cu = 0;
        if (hipGetDevice(&dev) != hipSuccess || hipDeviceGetAttribute(&cus, hipDeviceAttributeMultiprocessorCount, dev) != hipSuccess) { fprintf(stderr, "kernel_launch: device query failed\n"); grid = -1; return; }
        if (hipFuncSetAttribute((const void*)mk_fwd, hipFuncAttributeMaxDynamicSharedMemorySize, LDS_BYTES) != hipSuccess) { fprintf(stderr, "kernel_launch: hipFuncSetAttribute failed\n"); grid = -1; return; }
        if (hipOccupancyMaxActiveBlocksPerMultiprocessor(&per_cu, (const void*)mk_fwd, NTHREADS, LDS_BYTES) != hipSuccess || per_cu < 1) { fprintf(stderr, "kernel_launch: occupancy query says %d blocks per CU\n", per_cu); (void)hipGetLastError(); grid = -1; return; }
        grid = cus;
        if (grid != 256) fprintf(stderr, "kernel_launch: note: %d CUs (built and tuned for 256)\n", grid);
    }
    if (grid < 0) return;
    Args a{};
    for (int i = 0; i < 26; ++i) a.in[i] = (const float*)d_in[i];
    a.out = xres; a.ws = (unsigned char*)d_ws;
    if (hipMemsetAsync((char*)d_ws + WS_CTL + 4096 * 4, 0, XCD_BAR_WORDS * 4, stream) != hipSuccess) { fprintf(stderr, "kernel_launch: memset failed\n"); return; }
#if defined(MK_PER_PHASE)
    for (int ph = 0; ph < 11; ++ph) { a.ph_lo = ph; a.ph_hi = ph + 1; hipLaunchKernelGGL(mk_fwd, dim3(grid), dim3(NTHREADS), LDS_BYTES, stream, a); }
#else
    a.ph_lo = 0; a.ph_hi = 11;
    hipLaunchKernelGGL(mk_fwd, dim3(grid), dim3(NTHREADS), LDS_BYTES, stream, a);
    const hipError_t le = hipPeekAtLastError();
    if (le != hipSuccess) fprintf(stderr, "kernel_launch: launch failed: %s (grid %d)\n", hipGetErrorString(le), grid);
#endif
}
```

```cpp
#include <hip/hip_runtime.h>
#include <cstdint>
#include <cstdio>

namespace cfg {
constexpr int D = 1024, B = 8, S = 4096, T = B * S;
constexpr int CW = 512, GW = 512, NH = 8, HD = 64, CHUNK = 128, INC = 2560;
constexpr int ML = 256, XH = 4, XD = 256;
constexpr int NG = 4, EPG = 8, NE = 32, DE = 512;
constexpr float EPS = 1e-6f;
}
constexpr size_t MiB = 1u << 20;
using namespace cfg;

#define LAS __attribute__((address_space(3)))
#define GAS __attribute__((address_space(1)))
typedef unsigned short bf16_t;
typedef short bf16x8 __attribute__((ext_vector_type(8)));
typedef short s16x4 __attribute__((ext_vector_type(4)));
typedef float f32x4 __attribute__((ext_vector_type(4)));
typedef float f32x2 __attribute__((ext_vector_type(2)));
typedef unsigned u32x4 __attribute__((ext_vector_type(4)));
typedef unsigned u32x2 __attribute__((ext_vector_type(2)));

constexpr int NWAVES = 8, NTHREADS = 512;
constexpr int S_TILES = cfg::S / 256;
constexpr int LDS_BYTES = 147456;
constexpr int LDS_STAGE = 131072;
constexpr int LDS_EXCH = 131072;
constexpr int LDS_MISC = LDS_BYTES - 256;

constexpr size_t WS_CTL = 0;
constexpr size_t WS_WIN_T = 1 * MiB;
constexpr size_t WS_WOUT_T = 6 * MiB;
constexpr size_t WS_WQ_NAT = 8 * MiB;
constexpr size_t WS_WO_T = 10 * MiB;
constexpr size_t WS_WKV_T = 12 * MiB;
constexpr size_t WS_WS_BF = 16 * MiB;
constexpr size_t WS_MEMN = 17 * MiB;
constexpr size_t WS_KV = 21 * MiB;
constexpr size_t WS_WQK_T = 29 * MiB;
constexpr size_t WS_VW_T = 45 * MiB;
constexpr size_t WS_WGU_T = 61 * MiB;
constexpr size_t WS_WD_T = 125 * MiB;
constexpr size_t WS_WR = 157 * MiB;
constexpr size_t WS_SSQ1 = 158 * MiB;
constexpr size_t WS_ROUTE = 160 * MiB;
constexpr size_t WS_ACT0 = 164 * MiB;
constexpr size_t WS_ACT1 = 228 * MiB;
constexpr size_t WS_GB = WS_ACT1, WS_Z = WS_ACT1 + 32 * MiB, WS_UG = WS_ACT1 + 64 * MiB, WS_VG = WS_ACT1 + 96 * MiB;
constexpr size_t WS_X2B = WS_ACT1 + 64 * MiB;
constexpr size_t WS_HID = WS_ACT0;
constexpr size_t WS_YSLOT = 356 * MiB;
constexpr size_t RT_TOK_E = WS_ROUTE, RT_TOK_G = WS_ROUTE + 256 * 1024, RT_RS2 = WS_ROUTE + 512 * 1024, RT_TOK_R = WS_ROUTE + 640 * 1024, RT_HIST = WS_ROUTE + 896 * 1024,
                 RT_SLOT_OF = WS_ROUTE + 1024 * 1024, RT_GATE_SLOT = WS_ROUTE + 1536 * 1024, RT_TILE_E = WS_ROUTE + 2048 * 1024,
                 RT_TOK_OF_SLOT = WS_ROUTE + 2304 * 1024, RT_RS_SLOT = WS_ROUTE + 2816 * 1024;
constexpr int MAX_TILES = 288;
constexpr size_t WS_HB = WS_ACT0, WS_Y = WS_ACT0, WS_P = WS_ACT0, WS_X1B = WS_ACT1;

__device__ __forceinline__ unsigned f2bf(float f) { unsigned u = __builtin_bit_cast(unsigned, f); return (u + 0x7fffu + ((u >> 16) & 1u)) >> 16; }
__device__ __forceinline__ unsigned pk2(float lo, float hi) { return f2bf(lo) | (f2bf(hi) << 16); }
__device__ __forceinline__ unsigned cvt_pk_bf16(float lo, float hi) { unsigned r; asm volatile("v_cvt_pk_bf16_f32 %0, %1, %2" : "=v"(r) : "v"(lo), "v"(hi)); return r; }
__device__ __forceinline__ float bf_lo(unsigned w) { return __uint_as_float(w << 16); }
__device__ __forceinline__ float bf_hi(unsigned w) { return __uint_as_float(w & 0xffff0000u); }
__device__ __forceinline__ float wave_sum(float v) {
#pragma unroll
    for (int o = 1; o < 64; o <<= 1) v += __shfl_xor(v, o);
    return v;
}
__device__ __forceinline__ float gelu_fast(float x) {
    const float t = x * (1.0f + 0.044715f * x * x) * 2.302208198f;
    return x * __builtin_amdgcn_rcpf(1.0f + __builtin_amdgcn_exp2f(-t));
}
__device__ __forceinline__ int lane_id_fresh() { int l; asm volatile("v_mbcnt_lo_u32_b32 %0, -1, 0\n\tv_mbcnt_hi_u32_b32 %0, -1, %0" : "=v"(l)); return l; }
#define LDS_WAIT() asm volatile("s_waitcnt lgkmcnt(0)" ::: "memory")
#define VM_WAIT() asm volatile("s_waitcnt vmcnt(0)" ::: "memory")

namespace pg8 {
constexpr int BM = 256, BK = 64, HALF = 128, HTB = HALF * BK * 2, STAGE_BYTES = 8 * HTB, NXCD = 8, WGM = 8;
__host__ __device__ __forceinline__ int lds_byte(int r, int c) { const int st = (r >> 4) * 2 + (c >> 5), rr = r & 15, cc = c & 31, ob = rr * 64 + cc * 2; return st * 1024 + (ob ^ (((ob >> 9) & 1) << 5)); }
__host__ __device__ __forceinline__ void stage_rc(int b, int& R, int& C) { const int st = b / 1024, sb = b % 1024, swz = sb ^ (((sb >> 9) & 1) << 5); R = (st >> 1) * 16 + swz / 64; C = (st & 1) * 32 + (swz % 64) / 2; }
__host__ __device__ __forceinline__ int perm32(int rho) { const int n = rho >> 4, i = rho & 15; return 8 * (i >> 2) + 4 * n + (i & 3); }

__device__ __forceinline__ const char* uni(const char* p) { const unsigned long long v = (unsigned long long)p;
    const unsigned lo = __builtin_amdgcn_readfirstlane((unsigned)v), hi = __builtin_amdgcn_readfirstlane((unsigned)(v >> 32)); return (const char*)(((unsigned long long)hi << 32) | lo); }
struct Unit { int pm, pn, aux; const char* a; const char* b; };

typedef f32x4 Acc[2][2][4][2];

template <int lda, int ldb, int K, bool GATHER = false, class Epi, class Sched>
__device__ __forceinline__ void gemm_phase(LAS unsigned char* lds, const int wid, const Sched& S, const Epi& E, const int* gidx = nullptr) {
    const int lane = lane_id_fresh(), tid = wid * 64 + lane, wr = wid >> 2, wc = wid & 3, fr = lane & 15, fq = lane >> 4;
    constexpr int nt = K / BK;
    unsigned voffA, voffB;
    { int R, C; stage_rc(tid * 16, R, C); const int Rb = (R & ~31) + perm32(R & 31); voffA = (unsigned)(R * lda + C) * 2u; voffB = (unsigned)(Rb * ldb + C) * 2u; }
    constexpr size_t pstepA = (size_t)64 * lda * 2, pstepB = (size_t)64 * ldb * 2;
    constexpr size_t kstep = (size_t)(BK * 2);
    constexpr size_t hstepA = (size_t)HALF * lda * 2, hstepB = (size_t)HALF * ldb * 2;
    const unsigned ldsw = (unsigned)wid * 1024u;
    const int aoff = lds_byte(wr * 64 + fr, fq * 8), boff = lds_byte(wc * 32 + fr, fq * 8);
#define PG8_SA(b, h) (((b) * 2 + (h)) * HTB)
#define PG8_SB(b, h) ((4 + (b) * 2 + (h)) * HTB)
#define PG8_STAGE(bufoff, gbase, X) do { _Pragma("unroll") for (int _i = 0; _i < 2; ++_i) \
        __builtin_amdgcn_global_load_lds((const unsigned*)(uni((const char*)(gbase) + (size_t)_i * pstep##X) + voff##X), (LAS unsigned*)(lds + (bufoff) + ldsw + _i * 8192), 16, 0, 0); } while (0)
#define PG8_STAGE_A(bufoff, kp, h, OFF) do { _Pragma("unroll") for (int _i = 0; _i < 2; ++_i) { \
        if constexpr (GATHER) __builtin_amdgcn_global_load_lds((const unsigned*)(uni((const char*)(kp)) + OFF[h][_i]), (LAS unsigned*)(lds + (bufoff) + ldsw + _i * 8192), 16, 0, 0); \
        else __builtin_amdgcn_global_load_lds((const unsigned*)(uni((const char*)(kp) + (size_t)(h) * hstepA + (size_t)_i * pstepA) + voffA), (LAS unsigned*)(lds + (bufoff) + ldsw + _i * 8192), 16, 0, 0); } } while (0)
#define PG8_LDA(dst, b, h) do { _Pragma("unroll") for (int m = 0; m < 4; ++m) _Pragma("unroll") for (int k = 0; k < 2; ++k) dst[m][k] = *(const LAS bf16x8*)(lds + PG8_SA(b, h) + aoff + m * 2048 + k * 1024); } while (0)
#define PG8_LDB(dst, b, h) do { _Pragma("unroll") for (int n = 0; n < 2; ++n) _Pragma("unroll") for (int k = 0; k < 2; ++k) dst[n][k] = *(const LAS bf16x8*)(lds + PG8_SB(b, h) + boff + n * 2048 + k * 1024); } while (0)
#define PG8_MMA(ai, bj, At, Bt) do { __builtin_amdgcn_s_setprio(1); _Pragma("unroll") for (int m = 0; m < 4; ++m) _Pragma("unroll") for (int n = 0; n < 2; ++n) _Pragma("unroll") for (int k = 0; k < 2; ++k) \
        acc[ai][bj][m][n] = __builtin_amdgcn_mfma_f32_16x16x32_bf16(Bt[n][k], At[m][k], acc[ai][bj][m][n], 0, 0, 0); __builtin_amdgcn_s_setprio(0); } while (0)
#define PG8_WAIT_V(n) asm volatile("s_waitcnt vmcnt(" #n ")" ::: "memory")
#define PG8_WAIT_L(n) asm volatile("s_waitcnt lgkmcnt(" #n ")" ::: "memory")
#define PG8_BAR __builtin_amdgcn_s_barrier()
#define PG8_SCHED __builtin_amdgcn_sched_barrier(0)
    Unit cur, nxt; int ui = 0;
    if (!S.next(0, cur)) return;
    Acc acc;
#pragma unroll
    for (int a = 0; a < 2; ++a)
#pragma unroll
        for (int b = 0; b < 2; ++b)
#pragma unroll
            for (int m = 0; m < 4; ++m)
#pragma unroll
                for (int n = 0; n < 2; ++n) acc[a][b][m][n] = (f32x4){0.f, 0.f, 0.f, 0.f};
    bf16x8 At[4][2], B0[2][2], B1[2][2];
    const char* cA = cur.a; const char* cB = cur.b;
    unsigned go[2][2], gn[2][2];
    LAS const unsigned* lidx = (LAS const unsigned*)(lds + STAGE_BYTES);
    if constexpr (GATHER) {
        { Unit uu; for (int i = 0; S.next(i, uu); ++i) if (tid < 256) ((LAS unsigned*)lidx)[i * 256 + tid] = (unsigned)gidx[uu.pm * 256 + tid] * (unsigned)(lda * 2); }
        asm volatile("s_waitcnt vmcnt(0) lgkmcnt(0)" ::: "memory"); PG8_BAR; asm volatile("" ::: "memory");
        int R, C; stage_rc(tid * 16, R, C);
#pragma unroll
        for (int h = 0; h < 2; ++h)
#pragma unroll
            for (int i = 0; i < 2; ++i) { go[h][i] = lidx[h * 128 + i * 64 + R] + (unsigned)(C * 2); gn[h][i] = go[h][i]; }
    }
    PG8_STAGE(PG8_SB(0, 0), cB, B); PG8_STAGE(PG8_SB(0, 1), cB + hstepB, B); PG8_STAGE_A(PG8_SA(0, 0), cA, 0, go); PG8_STAGE_A(PG8_SA(0, 1), cA, 1, go);
    if (wr == 1) PG8_BAR;
    PG8_WAIT_V(2); PG8_BAR;
    PG8_STAGE(PG8_SB(1, 0), cB + kstep, B); PG8_STAGE_A(PG8_SA(1, 0), cA + kstep, 0, go); PG8_STAGE(PG8_SB(1, 1), cB + hstepB + kstep, B);
    PG8_WAIT_V(6); PG8_BAR;
    for (;;) {
        const bool has_next = S.next(ui + 1, nxt);
        const char* nA = has_next ? nxt.a : cA; const char* nB = has_next ? nxt.b : cB;
        for (int t = 0; t < nt; t += 2) {
            const bool last = (t == nt - 2);
            const char* a1 = cA + (size_t)(t + 1) * kstep;
            const char* a2 = last ? nA : cA + (size_t)(t + 2) * kstep; const char* b2 = last ? nB : cB + (size_t)(t + 2) * kstep;
            const char* a3 = a2 + kstep; const char* b3 = b2 + kstep;
            if constexpr (GATHER) { if (last && has_next) { int R, C; stage_rc(tid * 16, R, C);
#pragma unroll
                for (int h = 0; h < 2; ++h)
#pragma unroll
                    for (int i = 0; i < 2; ++i) gn[h][i] = lidx[(ui + 1) * 256 + h * 128 + i * 64 + R] + (unsigned)(C * 2); } }
            unsigned gx[2][2];
#pragma unroll
            for (int h = 0; h < 2; ++h)
#pragma unroll
                for (int i = 0; i < 2; ++i) gx[h][i] = GATHER ? (last ? gn[h][i] : go[h][i]) : 0u;
            PG8_LDB(B0, 0, 0); PG8_LDB(B1, 0, 1); PG8_SCHED; PG8_LDA(At, 0, 0); PG8_STAGE_A(PG8_SA(1, 1), a1, 1, go);
            PG8_WAIT_V(8); PG8_WAIT_L(0); PG8_BAR; PG8_MMA(0, 0, At, B0); PG8_MMA(0, 1, At, B1); PG8_BAR; PG8_SCHED;
            PG8_LDA(At, 0, 1); PG8_STAGE(PG8_SB(0, 0), b2, B); PG8_STAGE(PG8_SB(0, 1), b2 + hstepB, B); PG8_STAGE_A(PG8_SA(0, 0), a2, 0, gx);
            PG8_WAIT_V(8); PG8_WAIT_L(0); PG8_BAR; PG8_MMA(1, 0, At, B0); PG8_MMA(1, 1, At, B1); PG8_BAR; PG8_SCHED;
            PG8_LDB(B0, 1, 0); PG8_LDB(B1, 1, 1); PG8_SCHED; PG8_LDA(At, 1, 0); PG8_STAGE_A(PG8_SA(0, 1), a2, 1, gx);
            PG8_WAIT_V(8); PG8_WAIT_L(0); PG8_BAR; PG8_MMA(0, 0, At, B0); PG8_MMA(0, 1, At, B1); PG8_BAR; PG8_SCHED;
            PG8_LDA(At, 1, 1); PG8_STAGE(PG8_SB(1, 0), b3, B); PG8_STAGE(PG8_SB(1, 1), b3 + hstepB, B); PG8_STAGE_A(PG8_SA(1, 0), a3, 0, gx);
            PG8_WAIT_V(8); PG8_WAIT_L(0); PG8_BAR; PG8_MMA(1, 0, At, B0); PG8_MMA(1, 1, At, B1); PG8_BAR; PG8_SCHED;
            if constexpr (GATHER) { if (last) {
#pragma unroll
                for (int h = 0; h < 2; ++h)
#pragma unroll
                    for (int i = 0; i < 2; ++i) go[h][i] = gn[h][i]; } }
        }
        if (wr == 0) PG8_BAR;
        { const int le = lane_id_fresh();
          E(acc, cur, wr, wc, le & 15, le >> 4, lds + STAGE_BYTES, wid, le); }
        if (!has_next) break;
#pragma unroll
        for (int a = 0; a < 2; ++a)
#pragma unroll
            for (int b = 0; b < 2; ++b)
#pragma unroll
                for (int m = 0; m < 4; ++m)
#pragma unroll
                    for (int n = 0; n < 2; ++n) acc[a][b][m][n] = (f32x4){0.f, 0.f, 0.f, 0.f};
        cur = nxt; cA = nA; cB = nB; ++ui;
        if (wr == 1) PG8_BAR;
    }
    PG8_WAIT_V(0);
    PG8_BAR;
#undef PG8_SA
#undef PG8_SB
#undef PG8_STAGE
#undef PG8_STAGE_A
#undef PG8_LDA
#undef PG8_LDB
#undef PG8_MMA
#undef PG8_WAIT_V
#undef PG8_WAIT_L
#undef PG8_BAR
#undef PG8_SCHED
}

struct DenseOrder {
    int nM, nN, nwg, G, c; const char* A; const char* Bt; size_t tA, tB; int bdiv; size_t bstride;
    __device__ __forceinline__ void init(int M, int N, int G_, int c_, const void* A_, int lda, const void* Bt_, int ldb, int bdiv_ = 0, size_t bstride_ = 0) {
        nM = M / BM; nN = N / BM; nwg = nM * nN; G = G_; c = c_; A = (const char*)A_; Bt = (const char*)Bt_; tA = (size_t)BM * lda * 2; tB = (size_t)BM * ldb * 2; bdiv = bdiv_; bstride = bstride_; }
    __device__ __forceinline__ bool next(int i, Unit& u) const {
        const long L = (long)i * G + c; if (L >= nwg) return false;
        int wgid = (int)L; { const int q = nwg / NXCD, r = nwg % NXCD, xcd = wgid % NXCD, off = wgid / NXCD; wgid = (xcd < r ? xcd * (q + 1) : r * (q + 1) + (xcd - r) * q) + off; }
        const int nig = WGM * nN, gid = wgid / nig, fm = gid * WGM, gsz = (nM - fm) < WGM ? (nM - fm) : WGM;
        u.pm = fm + ((wgid % nig) % gsz); u.pn = (wgid % nig) / gsz; u.aux = 0;
        u.a = A + (size_t)u.pm * tA; u.b = Bt + (size_t)u.pn * tB + (bdiv ? (size_t)(u.pm / bdiv) * bstride : 0);
        return true;
    }
};
}

using pg8::Acc; using pg8::Unit;
#define EPI_ARGS Acc& acc, const Unit& u, int wr, int wc, int fr, int fq, LAS unsigned char* ldsx, int wid, int lane
struct EpiBf16 {
    bf16_t* O; int ldc;
    __device__ __forceinline__ void operator()(EPI_ARGS) const {
        bf16_t* base = O + (size_t)(u.pm * 256 + wr * 64 + fr) * ldc + u.pn * 256 + wc * 32 + 8 * fq;
#pragma unroll
        for (int ai = 0; ai < 2; ++ai)
#pragma unroll
            for (int m = 0; m < 4; ++m)
#pragma unroll
                for (int bj = 0; bj < 2; ++bj) { const f32x4 v0 = acc[ai][bj][m][0], v1 = acc[ai][bj][m][1]; u32x4 w;
                    w.x = cvt_pk_bf16(v0[0], v0[1]); w.y = cvt_pk_bf16(v0[2], v0[3]); w.z = cvt_pk_bf16(v1[0], v1[1]); w.w = cvt_pk_bf16(v1[2], v1[3]);
                    *(u32x4*)(base + (size_t)(ai * 128 + m * 16) * ldc + bj * 128) = w; }
    }
};
struct EpiBf16Aux {
    bf16_t* O; int ldc;
    __device__ __forceinline__ void operator()(EPI_ARGS) const {
        bf16_t* base = O + (size_t)(unsigned)u.aux + (size_t)(wr * 64 + fr) * ldc + wc * 32 + 8 * fq;
#pragma unroll
        for (int ai = 0; ai < 2; ++ai)
#pragma unroll
            for (int m = 0; m < 4; ++m)
#pragma unroll
                for (int bj = 0; bj < 2; ++bj) { const f32x4 v0 = acc[ai][bj][m][0], v1 = acc[ai][bj][m][1]; u32x4 w;
                    w.x = cvt_pk_bf16(v0[0], v0[1]); w.y = cvt_pk_bf16(v0[2], v0[3]); w.z = cvt_pk_bf16(v1[0], v1[1]); w.w = cvt_pk_bf16(v1[2], v1[3]);
                    *(u32x4*)(base + (size_t)(ai * 128 + m * 16) * ldc + bj * 128) = w; }
    }
};
struct EpiInProj {
    bf16_t *GB, *Z, *UG, *VG;
    __device__ __forceinline__ void operator()(EPI_ARGS) const {
        const int pn = u.pn; const size_t row0 = (size_t)(u.pm * 256 + wr * 64 + fr); const int cl = wc * 32 + 8 * fq;
        if (pn >= 2 && pn < 6) {
            bf16_t* base = Z + row0 * 512 + (pn - 2) * 128 + cl;
#pragma unroll
            for (int ai = 0; ai < 2; ++ai)
#pragma unroll
                for (int m = 0; m < 4; ++m) { const f32x4 z0 = acc[ai][0][m][0] * acc[ai][1][m][0], z1 = acc[ai][0][m][1] * acc[ai][1][m][1]; u32x4 w;
                    w.x = cvt_pk_bf16(z0[0], z0[1]); w.y = cvt_pk_bf16(z0[2], z0[3]); w.z = cvt_pk_bf16(z1[0], z1[1]); w.w = cvt_pk_bf16(z1[2], z1[3]);
                    *(u32x4*)(base + (size_t)(ai * 128 + m * 16) * 512) = w; }
        } else {
            const bool act = pn >= 6;
            const int sel = pn < 2 ? 0 : (pn < 8 ? 2 : 3), ct = pn < 2 ? pn : (pn < 8 ? pn - 6 : pn - 8);
            bf16_t* base = GB + (size_t)sel * (16u << 20) + row0 * 512 + ct * 256 + cl;
#pragma unroll
            for (int ai = 0; ai < 2; ++ai)
#pragma unroll
                for (int m = 0; m < 4; ++m)
#pragma unroll
                    for (int bj = 0; bj < 2; ++bj) { f32x4 v0 = acc[ai][bj][m][0], v1 = acc[ai][bj][m][1];
                        if (act) {
#pragma unroll
                            for (int i = 0; i < 4; ++i) { v0[i] = gelu_fast(v0[i]); v1[i] = gelu_fast(v1[i]); } }
                        u32x4 w; w.x = cvt_pk_bf16(v0[0], v0[1]); w.y = cvt_pk_bf16(v0[2], v0[3]); w.z = cvt_pk_bf16(v1[0], v1[1]); w.w = cvt_pk_bf16(v1[2], v1[3]);
                        *(u32x4*)(base + (size_t)(ai * 128 + m * 16) * 512 + bj * 128) = w; }
        }
    }
};
struct EpiResidA {
    const float* R; bf16_t* XB; float* SSQ;
    __device__ __forceinline__ void operator()(EPI_ARGS) const {
        const size_t row0 = (size_t)(u.pm * 256 + wr * 64 + fr); const int col0 = u.pn * 256 + wc * 32 + 8 * fq;
#pragma unroll
        for (int ai = 0; ai < 2; ++ai)
#pragma unroll
            for (int m = 0; m < 4; ++m) { const size_t off = (row0 + ai * 128 + m * 16) * 1024 + col0; float sq = 0.f;
#pragma unroll
                for (int bj = 0; bj < 2; ++bj) { const f32x4 r0 = *(const f32x4*)(R + off + bj * 128), r1 = *(const f32x4*)(R + off + bj * 128 + 4);
                    const f32x4 v0 = r0 + acc[ai][bj][m][0], v1 = r1 + acc[ai][bj][m][1];
                    u32x4 w; w.x = cvt_pk_bf16(v0[0], v0[1]); w.y = cvt_pk_bf16(v0[2], v0[3]); w.z = cvt_pk_bf16(v1[0], v1[1]); w.w = cvt_pk_bf16(v1[2], v1[3]); *(u32x4*)(XB + off + bj * 128) = w;
                    sq += (v0[0] * v0[0] + v0[1] * v0[1]) + (v0[2] * v0[2] + v0[3] * v0[3]) + (v1[0] * v1[0] + v1[1] * v1[1]) + (v1[2] * v1[2] + v1[3] * v1[3]); }
                sq += __shfl_xor(sq, 16); sq += __shfl_xor(sq, 32); if (fq == 0) SSQ[(row0 + ai * 128 + m * 16) * 16 + u.pn * 4 + wc] = sq;
                if (m & 1) asm volatile("" ::: "memory"); }
    }
};
struct EpiResidB {
    const bf16_t* RB; bf16_t* XB;
    __device__ __forceinline__ void operator()(EPI_ARGS) const {
        const size_t row0 = (size_t)(u.pm * 256 + wr * 64 + fr); const int col0 = u.pn * 256 + wc * 32 + 8 * fq;
#pragma unroll
        for (int ai = 0; ai < 2; ++ai)
#pragma unroll
            for (int m = 0; m < 4; ++m) { const size_t off = (row0 + ai * 128 + m * 16) * 1024 + col0;
#pragma unroll
                for (int bj = 0; bj < 2; ++bj) { const u32x4 r = *(const u32x4*)(RB + off + bj * 128);
                    const f32x4 v0 = (f32x4){bf_lo(r.x), bf_hi(r.x), bf_lo(r.y), bf_hi(r.y)} + acc[ai][bj][m][0], v1 = (f32x4){bf_lo(r.z), bf_hi(r.z), bf_lo(r.w), bf_hi(r.w)} + acc[ai][bj][m][1];
                    u32x4 w; w.x = cvt_pk_bf16(v0[0], v0[1]); w.y = cvt_pk_bf16(v0[2], v0[3]); w.z = cvt_pk_bf16(v1[0], v1[1]); w.w = cvt_pk_bf16(v1[2], v1[3]); *(u32x4*)(XB + off + bj * 128) = w; }
                if (m & 1) asm volatile("" ::: "memory"); }
    }
};
struct EpiSoftmax {
    const float* SSQ; bf16_t* P;
    __device__ __forceinline__ void operator()(EPI_ARGS) const {
        const size_t row0 = (size_t)(u.pm * 256 + wr * 64 + fr);
        LAS f32x2* ex = (LAS f32x2*)ldsx;
        float mw[2][4];
#pragma unroll
        for (int ai = 0; ai < 2; ++ai)
#pragma unroll
            for (int m = 0; m < 4; ++m) {
                const f32x4* q = (const f32x4*)(SSQ + (row0 + ai * 128 + m * 16) * 16);
                const f32x4 q0 = q[0], q1 = q[1], q2 = q[2], q3 = q[3];
                const float ss = ((q0[0] + q0[1]) + (q0[2] + q0[3])) + ((q1[0] + q1[1]) + (q1[2] + q1[3])) + ((q2[0] + q2[1]) + (q2[2] + q2[3])) + ((q3[0] + q3[1]) + (q3[2] + q3[3]));
                const float rs = rsqrtf(ss * (1.f / 1024.f) + EPS);
                float mx = -3.0e38f;
#pragma unroll
                for (int bj = 0; bj < 2; ++bj)
#pragma unroll
                    for (int n = 0; n < 2; ++n) { f32x4 v = acc[ai][bj][m][n] * rs; acc[ai][bj][m][n] = v; mx = fmaxf(fmaxf(mx, fmaxf(v[0], v[1])), fmaxf(v[2], v[3])); }
                mx = fmaxf(mx, __shfl_xor(mx, 16)); mx = fmaxf(mx, __shfl_xor(mx, 32));
                float sum = 0.f;
#pragma unroll
                for (int bj = 0; bj < 2; ++bj)
#pragma unroll
                    for (int n = 0; n < 2; ++n) { f32x4 v = acc[ai][bj][m][n];
#pragma unroll
                        for (int i = 0; i < 4; ++i) v[i] = __builtin_amdgcn_exp2f(v[i] - mx);
                        acc[ai][bj][m][n] = v; sum += (v[0] + v[1]) + (v[2] + v[3]); }
                sum += __shfl_xor(sum, 16); sum += __shfl_xor(sum, 32);
                mw[ai][m] = mx;
                if (fq == 0) ex[(ai * 128 + wr * 64 + m * 16 + fr) * 4 + wc] = (f32x2){mx, sum};
            }
        asm volatile("s_waitcnt lgkmcnt(0)" ::: "memory"); __builtin_amdgcn_s_barrier(); asm volatile("" ::: "memory");
        bf16_t* base = P + row0 * 1024 + u.pn * 256 + wc * 32 + 8 * fq;
#pragma unroll
        for (int ai = 0; ai < 2; ++ai)
#pragma unroll
            for (int m = 0; m < 4; ++m) {
                const LAS f32x2* e4 = ex + (ai * 128 + wr * 64 + m * 16 + fr) * 4;
                const f32x2 e0 = e4[0], e1 = e4[1], e2 = e4[2], e3 = e4[3];
                const float M = fmaxf(fmaxf(e0.x, e1.x), fmaxf(e2.x, e3.x));
                const float L = e0.y * __builtin_amdgcn_exp2f(e0.x - M) + e1.y * __builtin_amdgcn_exp2f(e1.x - M) + e2.y * __builtin_amdgcn_exp2f(e2.x - M) + e3.y * __builtin_amdgcn_exp2f(e3.x - M);
                const float f = __builtin_amdgcn_exp2f(mw[ai][m] - M) / L;
#pragma unroll
                for (int bj = 0; bj < 2; ++bj) { const f32x4 v0 = acc[ai][bj][m][0] * f, v1 = acc[ai][bj][m][1] * f; u32x4 w;
                    w.x = cvt_pk_bf16(v0[0], v0[1]); w.y = cvt_pk_bf16(v0[2], v0[3]); w.z = cvt_pk_bf16(v1[0], v1[1]); w.w = cvt_pk_bf16(v1[2], v1[3]);
                    *(u32x4*)(base + (size_t)(ai * 128 + m * 16) * 1024 + bj * 128) = w; }
            }
    }
};
struct WqkOrder {
    int G, c; const char* KV; const char* WQ;
    __device__ __forceinline__ bool next(int i, Unit& u) const {
        const int L = i * G + c; if (L >= 128) return false;
        const int b = L >> 4, h = (L >> 2) & 3, pn = L & 3;
        u.pm = 0; u.pn = pn; u.a = KV + ((size_t)(b * 256) * 2048 + h * 256) * 2; u.b = WQ + ((size_t)(pn * 256) * 1024 + h * 256) * 2;
        u.aux = b * (1024 * 1024) + (h * 256) * 1024 + pn * 256; return true; }
};
struct VwOrder {
    int G, c; const char* KV; const char* WO;
    __device__ __forceinline__ bool next(int i, Unit& u) const {
        const int L = i * G + c; if (L >= 128) return false;
        const int b = L >> 4, h = (L >> 2) & 3, pm = L & 3;
        u.pm = pm; u.pn = 0; u.a = WO + ((size_t)(pm * 256) * 1024 + h * 256) * 2; u.b = KV + ((size_t)(b * 256) * 2048 + 1024 + h * 256) * 2;
        u.aux = b * (1024 * 1024) + (pm * 256) * 1024 + h * 256; return true; }
};

struct EpiSwiGLU {
    bf16_t* H; const float* rs_slot;
    __device__ __forceinline__ void operator()(EPI_ARGS) const {
        const size_t row0 = (size_t)(u.pm * 256 + wr * 64 + fr);
        bf16_t* base = H + row0 * 512 + u.pn * 128 + wc * 32 + 8 * fq;
#pragma unroll
        for (int ai = 0; ai < 2; ++ai)
#pragma unroll
            for (int m = 0; m < 4; ++m) { const float rs = rs_slot[row0 + ai * 128 + m * 16]; f32x4 h0, h1;
#pragma unroll
                for (int i = 0; i < 4; ++i) { const float g0 = acc[ai][0][m][0][i] * rs, g1 = acc[ai][0][m][1][i] * rs;
                    h0[i] = g0 * __builtin_amdgcn_rcpf(1.0f + __builtin_amdgcn_exp2f(-1.4426950408889634f * g0)) * (acc[ai][1][m][0][i] * rs);
                    h1[i] = g1 * __builtin_amdgcn_rcpf(1.0f + __builtin_amdgcn_exp2f(-1.4426950408889634f * g1)) * (acc[ai][1][m][1][i] * rs); }
                u32x4 w; w.x = cvt_pk_bf16(h0[0], h0[1]); w.y = cvt_pk_bf16(h0[2], h0[3]); w.z = cvt_pk_bf16(h1[0], h1[1]); w.w = cvt_pk_bf16(h1[2], h1[3]);
                *(u32x4*)(base + (size_t)(ai * 128 + m * 16) * 512) = w; }
    }
};
struct EpiDown {
    bf16_t* Y; const float* gate;
    __device__ __forceinline__ void operator()(EPI_ARGS) const {
        const size_t row0 = (size_t)(u.pm * 256 + wr * 64 + fr);
        bf16_t* base = Y + row0 * 1024 + u.pn * 256 + wc * 32 + 8 * fq;
#pragma unroll
        for (int ai = 0; ai < 2; ++ai)
#pragma unroll
            for (int m = 0; m < 4; ++m) { const float g = gate[row0 + ai * 128 + m * 16];
#pragma unroll
                for (int bj = 0; bj < 2; ++bj) { const f32x4 v0 = acc[ai][bj][m][0] * g, v1 = acc[ai][bj][m][1] * g; u32x4 w;
                    w.x = cvt_pk_bf16(v0[0], v0[1]); w.y = cvt_pk_bf16(v0[2], v0[3]); w.z = cvt_pk_bf16(v1[0], v1[1]); w.w = cvt_pk_bf16(v1[2], v1[3]);
                    *(u32x4*)(base + (size_t)(ai * 128 + m * 16) * 1024 + bj * 128) = w; } }
    }
};
struct GroupedOrder {
    int G, c, nunits; const int* tile_e; const char* A; const char* W; size_t tA, wE, tB;
    __device__ __forceinline__ void init(int G_, int c_, const int* tbl, const void* A_, int lda, const void* W_, int ldb, size_t expert_bytes, bool gather = false) {
        G = G_; c = c_; tile_e = tbl + 16; nunits = 4 * __builtin_amdgcn_readfirstlane(__hip_atomic_load(tbl, __ATOMIC_RELAXED, __HIP_MEMORY_SCOPE_AGENT)); A = (const char*)A_; W = (const char*)W_; tA = gather ? 0 : (size_t)256 * lda * 2; tB = (size_t)256 * ldb * 2; wE = expert_bytes; }
    __device__ __forceinline__ bool next(int i, Unit& u) const {
        const int L = i * G + c; if (L >= nunits) return false;
        int wgid = L; { const int q = nunits / 8, r = nunits % 8, xcd = wgid % 8, off = wgid / 8; wgid = (xcd < r ? xcd * (q + 1) : r * (q + 1) + (xcd - r) * q) + off; }
        const int tile = wgid >> 2, pn = wgid & 3, e = __builtin_amdgcn_readfirstlane(__hip_atomic_load(tile_e + tile, __ATOMIC_RELAXED, __HIP_MEMORY_SCOPE_AGENT));
        u.pm = tile; u.pn = pn; u.aux = e; u.a = A + (size_t)tile * tA; u.b = W + (size_t)e * wE + (size_t)pn * tB; return true; }
};

struct Args {
    const float* in[26]; float* out; unsigned char* ws; int ph_lo, ph_hi;
};
struct Frame {
    LAS unsigned char* lds; int wave, vcu, G; unsigned char* ws; float* out;
};
#define IN_X 0
#define IN_MEM 1
#define IN_G_MIX 2
#define IN_W_IN 3
#define IN_CONV_W 4
#define IN_G_V 5
#define IN_W_S 6
#define IN_B_S 7
#define IN_G_OUT_CONV 8
#define IN_G_OUT_GMLP 9
#define IN_W_OUT 10
#define IN_G_XATTN 11
#define IN_G_MEM 12
#define IN_W_Q 13
#define IN_W_K 14
#define IN_W_V 15
#define IN_W_O 16
#define IN_G_FFN 17
#define IN_W_GRP 18
#define IN_B_GRP 19
#define IN_W_RT 20
#define IN_B_RT 21
#define IN_W_GATE 22
#define IN_W_UP 23
#define IN_W_DOWN 24
#define IN_G_FINAL 25

struct TrItem { const float* src; bf16_t* dst; const float* gk; int ldw, K; };
__device__ __forceinline__ void tr_load(const TrItem& t, float (&v)[32], int lane) {
    const float* p = t.src + (size_t)(lane >> 5) * t.ldw + (lane & 31);
#pragma unroll
    for (int i = 0; i < 32; ++i) v[i] = __builtin_nontemporal_load(p + (size_t)(2 * i) * t.ldw);
}
__device__ __forceinline__ void tr_finish(const TrItem& t, const float (&v)[32], LAS float* scr, int lane) {
    float g8[8];
    if (t.gk) { const f32x4 ga = *(const f32x4*)(t.gk + 8 * (lane & 7)), gb = *(const f32x4*)(t.gk + 8 * (lane & 7) + 4); g8[0] = ga[0]; g8[1] = ga[1]; g8[2] = ga[2]; g8[3] = ga[3]; g8[4] = gb[0]; g8[5] = gb[1]; g8[6] = gb[2]; g8[7] = gb[3]; }
    else {
#pragma unroll
        for (int j = 0; j < 8; ++j) g8[j] = 1.f; }
#pragma unroll
    for (int i = 0; i < 32; ++i) scr[(2 * i + (lane >> 5)) * 33 + (lane & 31)] = v[i];
    LDS_WAIT(); asm volatile("" ::: "memory");
    const int c = lane & 7;
#pragma unroll
    for (int j = 0; j < 4; ++j) { const int n = (lane >> 3) + 8 * j; const LAS float* s = scr + (8 * c) * 33 + n;
        u32x4 o; o.x = pk2(s[0 * 33] * g8[0], s[1 * 33] * g8[1]); o.y = pk2(s[2 * 33] * g8[2], s[3 * 33] * g8[3]); o.z = pk2(s[4 * 33] * g8[4], s[5 * 33] * g8[5]); o.w = pk2(s[6 * 33] * g8[6], s[7 * 33] * g8[7]);
        *(u32x4*)(t.dst + (size_t)n * t.K + 8 * c) = o; }
    LDS_WAIT(); asm volatile("" ::: "memory");
}
__device__ __forceinline__ TrItem tr_make(const float* W, int ldw, int K, bf16_t* WT, int dst_row0, int src_col0, int k0, const float* gk = nullptr) {
    TrItem t; t.src = W + (size_t)k0 * ldw + src_col0; t.dst = WT + (size_t)dst_row0 * K + k0; t.gk = gk ? gk + k0 : nullptr; t.ldw = ldw; t.K = K; return t; }
__device__ __forceinline__ int in_map(int n0) {
    if (n0 < 512 || n0 >= 1536) return n0;
    const int j = (n0 - 512) >> 8, r = (n0 - 512) & 255;
    return r < 128 ? 512 + 128 * j + r : 1024 + 128 * j + (r - 128);
}
__device__ __forceinline__ void norm_row_bf16(const float* xrow, const float* g, bf16_t* orow, int lane) {
    const f32x4* xr = (const f32x4*)xrow + lane; const f32x4* gr = (const f32x4*)g + lane;
    f32x4 v[4]; float s = 0.f;
#pragma unroll
    for (int j = 0; j < 4; ++j) { v[j] = xr[64 * j]; s += (v[j].x * v[j].x + v[j].y * v[j].y) + (v[j].z * v[j].z + v[j].w * v[j].w); }
    const float rs = rsqrtf(wave_sum(s) * (1.f / 1024.f) + EPS);
    u32x2* o8 = (u32x2*)orow + lane;
#pragma unroll
    for (int j = 0; j < 4; ++j) { const f32x4 gg = gr[64 * j]; u32x2 w; w.x = pk2(v[j].x * rs * gg.x, v[j].y * rs * gg.y); w.y = pk2(v[j].z * rs * gg.z, v[j].w * rs * gg.w); o8[64 * j] = w; }
}
__device__ __forceinline__ void norm_rows4_bf16(const float* X, const float* g, bf16_t* O, int m, int stride, int M, int lane) {
    f32x4 v[4][4]; float s[4]; const f32x4* gr = (const f32x4*)g + lane;
#pragma unroll
    for (int r = 0; r < 4; ++r) { const int mr = (m + r * stride < M) ? m + r * stride : m; const f32x4* xr = (const f32x4*)(X + (size_t)mr * 1024) + lane;
#pragma unroll
        for (int j = 0; j < 4; ++j) v[r][j] = __builtin_nontemporal_load(xr + 64 * j); }
#pragma unroll
    for (int r = 0; r < 4; ++r) { s[r] = 0.f;
#pragma unroll
        for (int j = 0; j < 4; ++j) s[r] += (v[r][j].x * v[r][j].x + v[r][j].y * v[r][j].y) + (v[r][j].z * v[r][j].z + v[r][j].w * v[r][j].w); }
#pragma unroll
    for (int r = 0; r < 4; ++r) { if (m + r * stride >= M) break; const float rs = rsqrtf(wave_sum(s[r]) * (1.f / 1024.f) + EPS); u32x2* o8 = (u32x2*)(O + (size_t)(m + r * stride) * 1024) + lane;
#pragma unroll
        for (int j = 0; j < 4; ++j) { const f32x4 gg = gr[64 * j]; u32x2 w; w.x = pk2(v[r][j].x * rs * gg.x, v[r][j].y * rs * gg.y); w.y = pk2(v[r][j].z * rs * gg.z, v[r][j].w * rs * gg.w); o8[64 * j] = w; } }
}
constexpr int PRO_I_IN = 16 * 80, PRO_I_SQ = 16 * 32, PRO_I_G = 16 * 16, PRO_I_D = 8 * 32, PRO_NITEMS = PRO_I_IN + 4 * PRO_I_SQ + NE * (2 * PRO_I_G + PRO_I_D);
__device__ __forceinline__ TrItem pro_item(const Args& a, unsigned char* ws, int it) {
    int r = it;
    if (r < PRO_I_IN) { const int kb = r / 80, nb = r % 80; return tr_make(a.in[IN_W_IN], INC, D, (bf16_t*)(ws + WS_WIN_T), 32 * nb, in_map(32 * nb), 64 * kb); } r -= PRO_I_IN;
    if (r < 4 * PRO_I_SQ) { const int q = r / PRO_I_SQ; r -= q * PRO_I_SQ; const int kb = r / 32, nb = r % 32;
        const float* W = a.in[q == 0 ? IN_W_OUT : (q == 1 ? IN_W_O : (q == 2 ? IN_W_K : IN_W_V))];
        bf16_t* WT = (bf16_t*)(ws + (q == 0 ? WS_WOUT_T : (q == 1 ? WS_WO_T : WS_WKV_T)));
        return tr_make(W, D, D, WT, (q == 3 ? 1024 : 0) + 32 * nb, 32 * nb, 64 * kb); }
    r -= 4 * PRO_I_SQ;
    const int e = r / (2 * PRO_I_G + PRO_I_D); r -= e * (2 * PRO_I_G + PRO_I_D);
    if (r < 2 * PRO_I_G) { const int up = r >= PRO_I_G; if (up) r -= PRO_I_G; const int kb = r / 16, nb = r % 16, n0 = 32 * nb;
        const int dst = 256 * (n0 >> 7) + (up ? 128 : 0) + (n0 & 127);
        return tr_make(a.in[up ? IN_W_UP : IN_W_GATE] + (size_t)e * D * DE, DE, D, (bf16_t*)(ws + WS_WGU_T) + (size_t)e * 1024 * 1024, dst, n0, 64 * kb, a.in[IN_G_FFN]); }
    r -= 2 * PRO_I_G;
    const int kb = r / 32, nb = r % 32;
    return tr_make(a.in[IN_W_DOWN] + (size_t)e * DE * D, D, DE, (bf16_t*)(ws + WS_WD_T) + (size_t)e * 1024 * 512, 32 * nb, 32 * nb, 64 * kb);
}
__device__ __forceinline__ void p0_prologue(const Frame& F, const Args& a) {
    LAS float* scr = (LAS float*)(F.lds + F.wave * 16384);
    const int lane = lane_id_fresh(), tid = F.wave * 64 + lane;
    unsigned char* ws = F.ws;
    const int gw = F.vcu * NWAVES + F.wave, NGW = F.G * NWAVES;
    {
        float va[32], vb[32]; TrItem ta, tb;
        int it = gw;
        if (it < PRO_NITEMS) { ta = pro_item(a, ws, it); tr_load(ta, va, lane); }
        while (it < PRO_NITEMS) {
            const int i1 = it + NGW; const bool h1 = i1 < PRO_NITEMS;
            if (h1) { tb = pro_item(a, ws, i1); tr_load(tb, vb, lane); }
            tr_finish(ta, va, scr, lane);
            if (!h1) break;
            const int i2 = i1 + NGW; const bool h2 = i2 < PRO_NITEMS;
            if (h2) { ta = pro_item(a, ws, i2); tr_load(ta, va, lane); }
            tr_finish(tb, vb, scr, lane);
            it = i2;
        }
    }
    for (int m = gw; m < T; m += 4 * NGW) norm_rows4_bf16(a.in[IN_X], a.in[IN_G_MIX], (bf16_t*)(ws + WS_HB), m, NGW, T, lane);
    for (int m = gw; m < B * ML; m += NGW) norm_row_bf16(a.in[IN_MEM] + (size_t)m * D, a.in[IN_G_MEM], (bf16_t*)(ws + WS_MEMN) + (size_t)m * D, lane);
    const int gt = F.vcu * NTHREADS + tid, NGT = F.G * NTHREADS;
    { const float* wq = a.in[IN_W_Q]; const float* gx = a.in[IN_G_XATTN]; bf16_t* o = (bf16_t*)(ws + WS_WQ_NAT);
      for (int i = gt; i < D * D / 2; i += NGT) { const int k = (2 * i) >> 10; const float sc = gx[k] * (1.4426950408889634f * 0.0625f); const f32x2 v = *(const f32x2*)(wq + 2 * i); *(unsigned*)(o + 2 * i) = pk2(v.x * sc, v.y * sc); } }
    { const float* w = a.in[IN_W_S]; bf16_t* o = (bf16_t*)(ws + WS_WS_BF);
      for (int i = gt; i < NH * CHUNK * CHUNK; i += NGT) { const int s = i & 127, t = (i >> 7) & 127; o[i] = (bf16_t)f2bf(s <= t ? w[i] : 0.f); } }
    { const float* wg = a.in[IN_W_GRP]; const float* wr = a.in[IN_W_RT]; const float* gf = a.in[IN_G_FFN]; bf16_t* o = (bf16_t*)(ws + WS_WR);
      for (int i = gt; i < 48 * 1024; i += NGT) { const int n = i >> 10, k = i & 1023; float v = 0.f;
          if (n < 4) v = wg[(size_t)k * NG + n] * gf[k]; else if (n < 36) v = wr[(size_t)k * NE + (n - 4)] * gf[k];
          const unsigned hi = f2bf(v); const float lo = v - __uint_as_float(hi << 16); o[i] = (bf16_t)hi; o[48 * 1024 + i] = (bf16_t)f2bf(lo); } }
}

__device__ __forceinline__ void unpack8(const u32x4 w, float (&f)[8]) { f[0] = bf_lo(w.x); f[1] = bf_hi(w.x); f[2] = bf_lo(w.y); f[3] = bf_hi(w.y); f[4] = bf_lo(w.z); f[5] = bf_hi(w.z); f[6] = bf_lo(w.w); f[7] = bf_hi(w.w); }
constexpr int VT_PITCH = 136, VT_HEAD = 128 * VT_PITCH, MIX_EXCH = 8 * VT_HEAD;
__device__ __forceinline__ void mixer_unit(const Frame& F, const Args& a, int ch) {
    const int t0 = ch * 128, w = F.wave, l = lane_id_fresh();
    unsigned char* ws = F.ws;
    const bf16_t* GBp = (const bf16_t*)(ws + WS_GB); const bf16_t* Zp = (const bf16_t*)(ws + WS_Z); const bf16_t* UGp = (const bf16_t*)(ws + WS_UG); const bf16_t* VGp = (const bf16_t*)(ws + WS_VG);
    bf16_t* Y = (bf16_t*)(ws + WS_Y);
    __syncthreads();
    const int h = w;
    u32x4 vraw[16], uraw[16];
    { const int d8 = 8 * (l & 7);
#pragma unroll
      for (int it = 0; it < 16; ++it) vraw[it] = *(const u32x4*)(VGp + (size_t)(t0 + 8 * it + (l >> 3)) * 512 + h * 64 + d8);
#pragma unroll
      for (int it = 0; it < 16; ++it) uraw[it] = *(const u32x4*)(UGp + (size_t)(t0 + 8 * it + (l >> 3)) * 512 + h * 64 + d8); }
    asm volatile("" ::: "memory");
    {
        const int c = 8 * l;
        float w0[8], w1[8], w2[8], ga[8], zp1[8], zp2[8];
        const float* cw = a.in[IN_CONV_W]; const float* gc = a.in[IN_G_OUT_CONV];
#pragma unroll
        for (int j = 0; j < 8; ++j) { w0[j] = cw[c + j]; w1[j] = cw[CW + c + j]; w2[j] = cw[2 * CW + c + j]; ga[j] = gc[c + j]; }
        const int r0 = 16 * w, pos0 = (t0 & (S - 1)) + r0;
        if (pos0 >= 2) { unpack8(*(const u32x4*)(Zp + (size_t)(t0 + r0 - 1) * 512 + c), zp1); unpack8(*(const u32x4*)(Zp + (size_t)(t0 + r0 - 2) * 512 + c), zp2); }
        else {
#pragma unroll
            for (int j = 0; j < 8; ++j) { zp1[j] = 0.f; zp2[j] = 0.f; } }
#pragma unroll 8
        for (int r = 0; r < 16; ++r) {
            const size_t t = (size_t)(t0 + r0 + r);
            float gb[8], z[8], ya[8]; unpack8(*(const u32x4*)(GBp + t * 512 + c), gb); unpack8(*(const u32x4*)(Zp + t * 512 + c), z);
            float sq = 0.f;
#pragma unroll
            for (int j = 0; j < 8; ++j) { ya[j] = gb[j] * (w2[j] * z[j] + w1[j] * zp1[j] + w0[j] * zp2[j]); sq += ya[j] * ya[j]; zp2[j] = zp1[j]; zp1[j] = z[j]; }
            const float rs = rsqrtf(wave_sum(sq) * (1.f / 512.f) + EPS);
            u32x4 o; o.x = pk2(ya[0] * rs * ga[0], ya[1] * rs * ga[1]); o.y = pk2(ya[2] * rs * ga[2], ya[3] * rs * ga[3]); o.z = pk2(ya[4] * rs * ga[4], ya[5] * rs * ga[5]); o.w = pk2(ya[6] * rs * ga[6], ya[7] * rs * ga[7]);
            *(u32x4*)(Y + t * 1024 + c) = o;
        }
    }
    asm volatile("" ::: "memory");
    LAS unsigned char* vt = F.lds + h * VT_HEAD;
    {
        const int d8 = 8 * (l & 7); float gv[8];
#pragma unroll
        for (int j = 0; j < 8; ++j) gv[j] = a.in[IN_G_V][h * 64 + d8 + j];
#pragma unroll
        for (int it = 0; it < 16; ++it) { const int s = 8 * it + (l >> 3); float v[8]; unpack8(vraw[it], v);
            float sq = 0.f;
#pragma unroll
            for (int j = 0; j < 8; ++j) sq += v[j] * v[j];
            sq += __shfl_xor(sq, 1); sq += __shfl_xor(sq, 2); sq += __shfl_xor(sq, 4);
            const float rs = rsqrtf(sq * (1.f / 64.f) + EPS);
            u32x2 lo, hi; lo.x = pk2(v[0] * rs * gv[0], v[1] * rs * gv[1]); lo.y = pk2(v[2] * rs * gv[2], v[3] * rs * gv[3]); hi.x = pk2(v[4] * rs * gv[4], v[5] * rs * gv[5]); hi.y = pk2(v[6] * rs * gv[6], v[7] * rs * gv[7]);
            *(LAS u32x2*)(vt + s * VT_PITCH + d8 * 2) = lo; *(LAS u32x2*)(vt + s * VT_PITCH + d8 * 2 + 8) = hi; }
    }
    __syncthreads();
    const int fr = l & 15, fq = l >> 4, trq = (l & 15) >> 2, trp = l & 3;
    const bf16_t* wsb = (const bf16_t*)(ws + WS_WS_BF) + (size_t)h * CHUNK * CHUNK;
    const unsigned wloff = (unsigned)(fr * CHUNK + 8 * fq);
    const float* bsp = a.in[IN_B_S] + h * CHUNK;
#pragma unroll 1
    for (int half = 0; half < 2; ++half) {
        f32x4 acc[8][2];
#pragma unroll
        for (int m = 0; m < 8; ++m)
#pragma unroll
            for (int n = 0; n < 2; ++n) acc[m][n] = (f32x4){0.f, 0.f, 0.f, 0.f};
#pragma unroll
        for (int ks = 0; ks < 4; ++ks) {
            unsigned wl = wloff; asm volatile("" : "+v"(wl));
            bf16x8 af[2];
#pragma unroll
            for (int n = 0; n < 2; ++n) { const int dc = 32 * half + 16 * n + 4 * trp;
                const s16x4 lo = __builtin_bit_cast(s16x4, __builtin_amdgcn_ds_read_tr16_b64_v4i16((LAS s16x4*)(vt + (32 * ks + 8 * fq + trq) * VT_PITCH + dc * 2)));
                const s16x4 hi = __builtin_bit_cast(s16x4, __builtin_amdgcn_ds_read_tr16_b64_v4i16((LAS s16x4*)(vt + (32 * ks + 8 * fq + 4 + trq) * VT_PITCH + dc * 2)));
                af[n] = (bf16x8){lo[0], lo[1], lo[2], lo[3], hi[0], hi[1], hi[2], hi[3]}; }
#pragma unroll
            for (int m = 2 * ks; m < 8; ++m) {
                const bf16x8 bfr = *(const bf16x8*)(wsb + (16 * m * CHUNK + 32 * ks) + wl);
#pragma unroll
                for (int n = 0; n < 2; ++n) acc[m][n] = __builtin_amdgcn_mfma_f32_16x16x32_bf16(af[n], bfr, acc[m][n], 0, 0, 0);
            }
        }
#pragma unroll
        for (int m = 0; m < 8; ++m) { const float bs = bsp[16 * m + fr];
#pragma unroll
            for (int n = 0; n < 2; ++n) { const int dc = 32 * half + 16 * n + 4 * fq;
                u32x2 o; o.x = pk2(acc[m][n][0] + bs, acc[m][n][1] + bs); o.y = pk2(acc[m][n][2] + bs, acc[m][n][3] + bs);
                *(LAS u32x2*)(vt + (16 * m + fr) * VT_PITCH + dc * 2) = o; } }
    }
    asm volatile("s_waitcnt lgkmcnt(0)" ::: "memory");
    LAS float* exch = (LAS float*)(F.lds + MIX_EXCH);
    {
        const int d8 = 8 * (l & 7);
#pragma unroll
        for (int it = 0; it < 16; ++it) { const int sidx = 8 * it + (l >> 3);
            const u32x2 lo = *(const LAS u32x2*)(vt + sidx * VT_PITCH + d8 * 2), hi = *(const LAS u32x2*)(vt + sidx * VT_PITCH + d8 * 2 + 8);
            float uf[8]; unpack8(uraw[it], uf);
            const float y0 = uf[0] * bf_lo(lo.x), y1 = uf[1] * bf_hi(lo.x), y2 = uf[2] * bf_lo(lo.y), y3 = uf[3] * bf_hi(lo.y), y4 = uf[4] * bf_lo(hi.x), y5 = uf[5] * bf_hi(hi.x), y6 = uf[6] * bf_lo(hi.y), y7 = uf[7] * bf_hi(hi.y);
            float sq = ((y0 * y0 + y1 * y1) + (y2 * y2 + y3 * y3)) + ((y4 * y4 + y5 * y5) + (y6 * y6 + y7 * y7));
            sq += __shfl_xor(sq, 1); sq += __shfl_xor(sq, 2); sq += __shfl_xor(sq, 4);
            if ((l & 7) == 0) exch[h * CHUNK + sidx] = sq;
            uraw[it] = (u32x4){pk2(y0, y1), pk2(y2, y3), pk2(y4, y5), pk2(y6, y7)}; }
    }
    __syncthreads();
    {
        const int d8 = 8 * (l & 7); float gg[8];
#pragma unroll
        for (int j = 0; j < 8; ++j) gg[j] = a.in[IN_G_OUT_GMLP][h * 64 + d8 + j];
#pragma unroll
        for (int it = 0; it < 16; ++it) { const int sidx = 8 * it + (l >> 3); float tot = 0.f;
#pragma unroll
            for (int hh = 0; hh < 8; ++hh) tot += exch[hh * CHUNK + sidx];
            const float rs = rsqrtf(tot * (1.f / 512.f) + EPS);
            float yf[8]; unpack8(uraw[it], yf);
            u32x4 o; o.x = pk2(yf[0] * rs * gg[0], yf[1] * rs * gg[1]); o.y = pk2(yf[2] * rs * gg[2], yf[3] * rs * gg[3]); o.z = pk2(yf[4] * rs * gg[4], yf[5] * rs * gg[5]); o.w = pk2(yf[6] * rs * gg[6], yf[7] * rs * gg[7]);
            *(u32x4*)(Y + (size_t)(t0 + sidx) * 1024 + 512 + h * 64 + d8) = o; }
    }
}

constexpr int RT_XS_PITCH = 272;
constexpr int RT_XS_WAVE = 16 * RT_XS_PITCH;
constexpr int RT_SLAB_OFF = 8 * RT_XS_WAVE;
constexpr int RT_LG_OFF = RT_SLAB_OFF + 2 * 24576;
__device__ __forceinline__ void router_block(const Frame& F, const Args& a, int blk) {
    const int l = lane_id_fresh(), w = F.wave, fr = l & 15, fq = l >> 4, tid = w * 64 + l;
    unsigned char* ws = F.ws;
    LAS unsigned char* xs = F.lds + w * RT_XS_WAVE;
    LAS float* slab = (LAS float*)(F.lds + RT_SLAB_OFF);
    LAS float* lg = (LAS float*)(F.lds + RT_LG_OFF);
    LAS float* biasl = lg + 128 * 48;
    LAS int* histl = (LAS int*)(biasl + 64);
    __syncthreads();
    if (tid < 32) histl[tid] = 0;
    if (tid >= 64 && tid < 64 + 36) { const int n = tid - 64; biasl[n] = n < 4 ? a.in[IN_B_GRP][n] : a.in[IN_B_RT][n - 4]; }
    bf16x8 bh[4][3], bl[4][3];
    { const bf16_t* wh = (const bf16_t*)(ws + WS_WR) + (size_t)fr * 1024 + 128 * w + 8 * fq; const bf16_t* wl = wh + 48 * 1024;
#pragma unroll
      for (int ks = 0; ks < 4; ++ks)
#pragma unroll
          for (int nt = 0; nt < 3; ++nt) { bh[ks][nt] = *(const bf16x8*)(wh + (size_t)nt * 16 * 1024 + 32 * ks); bl[ks][nt] = *(const bf16x8*)(wl + (size_t)nt * 16 * 1024 + 32 * ks); } }
    const bf16_t* xg = (const bf16_t*)(ws + WS_X2B) + (size_t)(blk * 128 + fq) * D + 128 * w + 8 * fr;
    u32x4 bufA[4], bufB[4];
#define RT_LOAD(buf, tg) do { _Pragma("unroll") for (int j = 0; j < 4; ++j) buf[j] = *(const u32x4*)(xg + (size_t)(16 * (tg) + 4 * j) * D); } while (0)
#define RT_GROUP(buf, tg) do { \
        float sq[4]; \
        _Pragma("unroll") for (int j = 0; j < 4; ++j) { const u32x4 v = buf[j]; float f[8]; unpack8(v, f); \
            sq[j] = ((f[0] * f[0] + f[1] * f[1]) + (f[2] * f[2] + f[3] * f[3])) + ((f[4] * f[4] + f[5] * f[5]) + (f[6] * f[6] + f[7] * f[7])); \
            *(LAS u32x4*)(xs + (4 * j + fq) * RT_XS_PITCH + 16 * fr) = v; } \
        asm volatile("s_waitcnt lgkmcnt(0)" ::: "memory"); \
        f32x4 acc[3] = {(f32x4){0.f, 0.f, 0.f, 0.f}, (f32x4){0.f, 0.f, 0.f, 0.f}, (f32x4){0.f, 0.f, 0.f, 0.f}}; \
        _Pragma("unroll") for (int ks = 0; ks < 4; ++ks) { \
            const bf16x8 ah = *(const LAS bf16x8*)(xs + fr * RT_XS_PITCH + (32 * ks + 8 * fq) * 2); \
            _Pragma("unroll") for (int nt = 0; nt < 3; ++nt) { \
                acc[nt] = __builtin_amdgcn_mfma_f32_16x16x32_bf16(ah, bh[ks][nt], acc[nt], 0, 0, 0); \
                acc[nt] = __builtin_amdgcn_mfma_f32_16x16x32_bf16(ah, bl[ks][nt], acc[nt], 0, 0, 0); } } \
        LAS float* sl = slab + ((tg) & 1) * 6144 + w * 768;                    \
        _Pragma("unroll") for (int nt = 0; nt < 3; ++nt) { if (nt < 2 || fr < 4) { _Pragma("unroll") for (int r = 0; r < 4; ++r) sl[(4 * fq + r) * 48 + 16 * nt + fr] = acc[nt][r]; } } \
        _Pragma("unroll") for (int j = 0; j < 4; ++j) { float v = sq[j]; \
            _Pragma("unroll") for (int o = 1; o < 16; o <<= 1) v += __shfl_xor(v, o); \
            if (fr == 0) sl[(4 * j + fq) * 48 + 36] = v; } \
        asm volatile("s_waitcnt lgkmcnt(0)" ::: "memory"); __builtin_amdgcn_s_barrier(); asm volatile("" ::: "memory"); \
        for (int o = tid; o < 16 * 37; o += NTHREADS) { const int tk = o / 37, c = o - tk * 37; const LAS float* sp = slab + ((tg) & 1) * 6144 + tk * 48 + c; \
            float s8 = 0.f; _Pragma("unroll") for (int ww = 0; ww < 8; ++ww) s8 += sp[ww * 768]; lg[(16 * (tg) + tk) * 48 + c] = s8; } \
    } while (0)
    RT_LOAD(bufA, 0);
#pragma unroll 1
    for (int tg = 0; tg < 8; tg += 2) {
        RT_LOAD(bufB, tg + 1);
        RT_GROUP(bufA, tg);
        if (tg + 2 < 8) RT_LOAD(bufA, tg + 2);
        RT_GROUP(bufB, tg + 1);
    }
#undef RT_LOAD
#undef RT_GROUP
    __syncthreads();
    if (tid < 128) {
        const int tl = tid, t = blk * 128 + tl; const LAS float* L = lg + tl * 48; const float rs = rsqrtf(L[36] * (1.f / 1024.f) + EPS);
        float g4[4];
#pragma unroll
        for (int i = 0; i < 4; ++i) g4[i] = L[i] * rs + biasl[i];
        int g = 0; float mx = g4[0];
#pragma unroll
        for (int i = 1; i < 4; ++i) if (g4[i] > mx) { mx = g4[i]; g = i; }
        float den = 0.f;
#pragma unroll
        for (int i = 0; i < 4; ++i) den += __expf(g4[i] - mx);
        const float gp = 1.f / den;
        float e8[8];
#pragma unroll
        for (int i = 0; i < 8; ++i) e8[i] = L[4 + g * 8 + i] * rs + biasl[4 + g * 8 + i];
        int i0 = 0; float v0 = e8[0];
#pragma unroll
        for (int i = 1; i < 8; ++i) if (e8[i] > v0) { v0 = e8[i]; i0 = i; }
        int i1 = -1; float v1 = -3.0e38f;
#pragma unroll
        for (int i = 0; i < 8; ++i) if (i != i0 && e8[i] > v1) { v1 = e8[i]; i1 = i; }
        const float ex = __expf(v1 - v0);
        const float g0 = gp / (1.f + ex), g1 = gp * ex / (1.f + ex);
        const int ex0 = g * 8 + i0, ex1 = g * 8 + i1;
        const int r0 = __hip_atomic_fetch_add((int*)(histl + ex0), 1, __ATOMIC_RELAXED, __HIP_MEMORY_SCOPE_WORKGROUP), r1 = __hip_atomic_fetch_add((int*)(histl + ex1), 1, __ATOMIC_RELAXED, __HIP_MEMORY_SCOPE_WORKGROUP);
        *(int2*)((int*)(ws + RT_TOK_E) + 2 * t) = make_int2(ex0, ex1); *(float2*)((float*)(ws + RT_TOK_G) + 2 * t) = make_float2(g0, g1);
        *(int2*)((int*)(ws + RT_TOK_R) + 2 * t) = make_int2(r0, r1); ((float*)(ws + RT_RS2))[t] = rs;
    }
    __syncthreads();
    if (tid < 32) ((int*)(ws + RT_HIST))[blk * 32 + tid] = histl[tid];
}
__device__ __forceinline__ void assign_block(const Frame& F, const Args& a, int blk) {
    const int l = lane_id_fresh(), w = F.wave, tid = w * 64 + l;
    unsigned char* ws = F.ws;
    LAS int* ptot = (LAS int*)F.lds;
    LAS int* ppre = ptot + 512;
    LAS int* base = ppre + 512;
    LAS int* ebase = base + 32;
    __syncthreads();
    { const int e = tid & 31, part = tid >> 5; const int* H = (const int*)(ws + RT_HIST); int st = 0, sp = 0; int hv[16];
#pragma unroll
      for (int i = 0; i < 16; ++i) hv[i] = H[(part * 16 + i) * 32 + e];
#pragma unroll
      for (int i = 0; i < 16; ++i) { st += hv[i]; sp += (part * 16 + i < blk) ? hv[i] : 0; }
      ptot[part * 32 + e] = st; ppre[part * 32 + e] = sp; }
    __syncthreads();
    if (tid < 32) { int st = 0, sp = 0; for (int p = 0; p < 16; ++p) { st += ptot[p * 32 + tid]; sp += ppre[p * 32 + tid]; } ptot[tid] = st; ppre[tid] = sp; }
    __syncthreads();
    if (tid == 0) { int run = 0;
        for (int e = 0; e < 32; ++e) { base[e] = run * 256 + ppre[e]; ebase[e] = run * 256 + ptot[e]; ebase[64 + e] = run; run += (ptot[e] + 255) >> 8; ebase[32 + e] = run * 256; }
        if (blk == 0) ((int*)(ws + RT_TILE_E))[0] = run; }
    __syncthreads();
    if (blk == 0 && tid < 32) { int* te = (int*)(ws + RT_TILE_E); const int r0 = ebase[64 + tid], nt = (ebase[32 + tid] >> 8) - r0; for (int i = 0; i < nt; ++i) te[16 + r0 + i] = tid; }
    int* tos = (int*)(ws + RT_TOK_OF_SLOT); float* rss = (float*)(ws + RT_RS_SLOT); float* gts = (float*)(ws + RT_GATE_SLOT);
    if (tid < 256) { const int t = blk * 128 + (tid >> 1), k = tid & 1;
        const int e = ((const int*)(ws + RT_TOK_E))[2 * t + k], r = ((const int*)(ws + RT_TOK_R))[2 * t + k];
        const int slot = base[e] + r;
        ((int*)(ws + RT_SLOT_OF))[2 * t + k] = slot; tos[slot] = t; rss[slot] = ((const float*)(ws + RT_RS2))[t]; gts[slot] = ((const float*)(ws + RT_TOK_G))[2 * t + k]; }
    if (blk < 32) {
        for (int sl = ebase[blk] + tid; sl < ebase[32 + blk]; sl += NTHREADS) { tos[sl] = 0; rss[sl] = 0.f; gts[sl] = 0.f; } }
}
__device__ __forceinline__ void combine_rows(const Frame& F, const Args& a, float* outp) {
    const int l = lane_id_fresh();
    unsigned char* ws = F.ws;
    const int gw = F.vcu * NWAVES + F.wave, NGW = F.G * NWAVES;
    const f32x4* gfin = (const f32x4*)a.in[IN_G_FINAL] + l;
    f32x4 gf4[4];
#pragma unroll
    for (int j = 0; j < 4; ++j) gf4[j] = gfin[64 * j];
    const int* slot_of = (const int*)(ws + RT_SLOT_OF); const bf16_t* Y = (const bf16_t*)(ws + WS_YSLOT); const bf16_t* XB = (const bf16_t*)(ws + WS_X2B);
    for (int t = gw; t < T; t += 2 * NGW) {
        const int tb = t + NGW; const bool hb = tb < T; const int t2 = hb ? tb : t;
        const int2 sa = *(const int2*)(slot_of + 2 * t), sb = *(const int2*)(slot_of + 2 * t2);
        const u32x2* xa = (const u32x2*)(XB + (size_t)t * D) + l; const u32x2* xb = (const u32x2*)(XB + (size_t)t2 * D) + l;
        const u32x2* ya0 = (const u32x2*)(Y + (size_t)sa.x * D) + l; const u32x2* ya1 = (const u32x2*)(Y + (size_t)sa.y * D) + l;
        const u32x2* yb0 = (const u32x2*)(Y + (size_t)sb.x * D) + l; const u32x2* yb1 = (const u32x2*)(Y + (size_t)sb.y * D) + l;
        f32x4 va[4], vb[4]; u32x2 ra[4], pa[4], qa[4], rb[4], pb[4], qb[4];
#pragma unroll
        for (int j = 0; j < 4; ++j) { ra[j] = __builtin_nontemporal_load(xa + 64 * j); pa[j] = __builtin_nontemporal_load(ya0 + 64 * j); qa[j] = __builtin_nontemporal_load(ya1 + 64 * j); rb[j] = __builtin_nontemporal_load(xb + 64 * j); pb[j] = __builtin_nontemporal_load(yb0 + 64 * j); qb[j] = __builtin_nontemporal_load(yb1 + 64 * j); }
        float sqa = 0.f, sqb = 0.f;
#pragma unroll
        for (int j = 0; j < 4; ++j) {
            va[j].x = bf_lo(ra[j].x) + bf_lo(pa[j].x) + bf_lo(qa[j].x); va[j].y = bf_hi(ra[j].x) + bf_hi(pa[j].x) + bf_hi(qa[j].x); va[j].z = bf_lo(ra[j].y) + bf_lo(pa[j].y) + bf_lo(qa[j].y); va[j].w = bf_hi(ra[j].y) + bf_hi(pa[j].y) + bf_hi(qa[j].y);
            vb[j].x = bf_lo(rb[j].x) + bf_lo(pb[j].x) + bf_lo(qb[j].x); vb[j].y = bf_hi(rb[j].x) + bf_hi(pb[j].x) + bf_hi(qb[j].x); vb[j].z = bf_lo(rb[j].y) + bf_lo(pb[j].y) + bf_lo(qb[j].y); vb[j].w = bf_hi(rb[j].y) + bf_hi(pb[j].y) + bf_hi(qb[j].y);
            sqa += (va[j].x * va[j].x + va[j].y * va[j].y) + (va[j].z * va[j].z + va[j].w * va[j].w); sqb += (vb[j].x * vb[j].x + vb[j].y * vb[j].y) + (vb[j].z * vb[j].z + vb[j].w * vb[j].w); }
        const float rsa = rsqrtf(wave_sum(sqa) * (1.f / 1024.f) + EPS), rsb = rsqrtf(wave_sum(sqb) * (1.f / 1024.f) + EPS);
        f32x4* oa = (f32x4*)(outp + (size_t)t * D) + l; f32x4* ob = (f32x4*)(outp + (size_t)t2 * D) + l;
#pragma unroll
        for (int j = 0; j < 4; ++j) { __builtin_nontemporal_store(va[j] * rsa * gf4[j], oa + 64 * j); if (hb) __builtin_nontemporal_store(vb[j] * rsb * gf4[j], ob + 64 * j); }
    }
}

#define XB_TMO      128
#define XB_XCNT(j)  (256  + 64 * (j))
#define XB_XSUB(j)  (1280 + 64 * (j))
#define XB_XGEN(j)  (2304 + 64 * (j))
#define XB_TOP      3328
#define XB_TOPGEN   3392
#define XCD_BAR_WORDS 3456
#define XB_SPIN_CAP (1u << 20)
__device__ __forceinline__ unsigned xb_ld(unsigned* p)              { return __hip_atomic_load(p, __ATOMIC_RELAXED, __HIP_MEMORY_SCOPE_AGENT); }
__device__ __forceinline__ unsigned xb_add(unsigned* p, unsigned v) { return __hip_atomic_fetch_add(p, v, __ATOMIC_RELAXED, __HIP_MEMORY_SCOPE_AGENT); }
__device__ __forceinline__ unsigned xb_xcc_id() { return (unsigned)__builtin_amdgcn_s_getreg((3 << 11) | 20) & 0xFu; }
#define XB_SPIN(cond, bar) do { unsigned _sp = 0; while (cond) { __builtin_amdgcn_s_sleep(1); \
    if ((++_sp & 255u) == 0u) { if (xb_ld(&(bar)[XB_TMO])) break; if (_sp > XB_SPIN_CAP) { atomicAdd(&(bar)[XB_TMO], 1u); break; } } } } while (0)
struct XcdBarrier { unsigned* bar; unsigned x; volatile LAS unsigned* st; };
__device__ __forceinline__ XcdBarrier xcd_barrier_post(unsigned* bar, volatile LAS unsigned* st) {
    XcdBarrier b; b.bar = bar; b.x = xb_xcc_id(); b.st = st;
    if (threadIdx.x == 0) (void)xb_add(&bar[XB_XCNT(b.x)], 1u);
    return b;
}
__device__ __forceinline__ void xcd_barrier_complete(unsigned* bar, unsigned x, unsigned& nloc, unsigned& nx) {
    const unsigned G = gridDim.x * gridDim.y * gridDim.z;
    unsigned sum, cnt, mine, sp = 0u;
    for (;;) {
        sum = 0u; cnt = 0u; mine = 0u;
#pragma unroll
        for (unsigned j = 0; j < 16; ++j) { const unsigned c = xb_ld(&bar[XB_XCNT(j)]); sum += c; cnt += (c > 0u) ? 1u : 0u; mine = (j == x) ? c : mine; }
        if (sum == G) break;
        __builtin_amdgcn_s_sleep(1);
        if ((++sp & 255u) == 0u) { if (xb_ld(&bar[XB_TMO])) break; if (sp > XB_SPIN_CAP) { atomicAdd(&bar[XB_TMO], 1u); break; } }
    }
    nloc = mine > 0u ? mine : 1u; nx = cnt > 0u ? cnt : 1u;
}
__device__ __forceinline__ void xcd_barrier(const XcdBarrier& b, const int wave) {
    asm volatile("s_waitcnt vmcnt(0)" ::: "memory");
    __syncthreads();
    if (wave == 0 && lane_id_fresh() == 0) {
        unsigned* bar = b.bar;
        __builtin_amdgcn_s_waitcnt(0);
        unsigned nloc = b.st[0], nx = b.st[1];
        if (nloc == 0u) { xcd_barrier_complete(bar, b.x, nloc, nx); b.st[0] = nloc; b.st[1] = nx; }
        const unsigned old = xb_add(&bar[XB_XSUB(b.x)], 1u);
        const unsigned gen = old / nloc;
        if (old + 1u == (gen + 1u) * nloc) {
            __builtin_amdgcn_fence(__ATOMIC_RELEASE, "agent");
            asm volatile("s_waitcnt vmcnt(0)" ::: "memory");
            const unsigned og = xb_add(&bar[XB_TOP], 1u);
            const unsigned tg = og / nx;
            if (og + 1u == (tg + 1u) * nx) xb_add(&bar[XB_TOPGEN], 1u);
            else XB_SPIN(xb_ld(&bar[XB_TOPGEN]) == tg, bar);
            __builtin_amdgcn_fence(__ATOMIC_ACQUIRE, "agent");
            xb_add(&bar[XB_XGEN(b.x)], 1u);
            asm volatile("s_waitcnt vmcnt(0)" ::: "memory");
        } else {
            XB_SPIN(xb_ld(&bar[XB_XGEN(b.x)]) == gen, bar);
            __builtin_amdgcn_fence(__ATOMIC_ACQUIRE, "agent");
            asm volatile("s_waitcnt vmcnt(0)" ::: "memory");
        }
    }
    __syncthreads();
}

__global__ void __launch_bounds__(NTHREADS, 2) mk_fwd(Args args) {
    extern __shared__ __attribute__((aligned(16))) unsigned char lds_raw[];
    Frame F;
    F.lds = (LAS unsigned char*)lds_raw;
    F.wave = __builtin_amdgcn_readfirstlane((int)threadIdx.x >> 6);
    F.G = gridDim.x; { const int bx = blockIdx.x; F.vcu = (F.G % 8 == 0) ? (bx % 8) * (F.G / 8) + bx / 8 : bx; }
    F.ws = args.ws; F.out = args.out;
    unsigned char* ws = args.ws;
    const int lo = args.ph_lo, hi = args.ph_hi;
    if (threadIdx.x < 64) ((LAS unsigned*)(F.lds + LDS_MISC))[threadIdx.x] = 0u;
    __syncthreads();
    XcdBarrier xbar; xbar.bar = (unsigned*)(ws + WS_CTL) + 4096; xbar.x = 0; xbar.st = nullptr;
    if (hi - lo > 1) xbar = xcd_barrier_post((unsigned*)(ws + WS_CTL) + 4096, (volatile LAS unsigned*)(F.lds + LDS_MISC) + 8);
#define IN(k) (lo <= (k) && (k) < hi)
#define SEAM(k) do { if (IN(k) && IN((k) + 1)) xcd_barrier(xbar, F.wave); } while (0)
    if (IN(0)) p0_prologue(F, args);
    SEAM(0);
    if (IN(1)) {
        { pg8::DenseOrder S; S.init(T, INC, F.G, (int)blockIdx.x, ws + WS_HB, D, ws + WS_WIN_T, D);
          EpiInProj E{(bf16_t*)(ws + WS_GB), (bf16_t*)(ws + WS_Z), (bf16_t*)(ws + WS_UG), (bf16_t*)(ws + WS_VG)};
          pg8::gemm_phase<D, D, D>(F.lds, F.wave, S, E); }
        { pg8::DenseOrder S; S.init(B * ML, 2 * D, F.G, (int)blockIdx.x, ws + WS_MEMN, D, ws + WS_WKV_T, D);
          EpiBf16 E{(bf16_t*)(ws + WS_KV), 2 * D};
          pg8::gemm_phase<D, D, D>(F.lds, F.wave, S, E); }
    }
    SEAM(1);
    if (IN(2)) {
        for (int ch = F.vcu; ch < T / CHUNK; ch += F.G) mixer_unit(F, args, ch);
    }
    SEAM(2);
    if (IN(3)) {
        { WqkOrder S{F.G, (int)blockIdx.x, (const char*)(ws + WS_KV), (const char*)(ws + WS_WQ_NAT)}; EpiBf16Aux E{(bf16_t*)(ws + WS_WQK_T), 1024};
          pg8::gemm_phase<2 * D, D, XD>(F.lds, F.wave, S, E); }
        { VwOrder S{F.G, (int)((blockIdx.x + F.G / 2) % F.G), (const char*)(ws + WS_KV), (const char*)(ws + WS_WO_T)}; EpiBf16Aux E{(bf16_t*)(ws + WS_VW_T), 1024};
          pg8::gemm_phase<D, 2 * D, XD>(F.lds, F.wave, S, E); }
        pg8::DenseOrder S; S.init(T, D, F.G, (int)blockIdx.x, ws + WS_Y, D, ws + WS_WOUT_T, D);
        EpiResidA E{args.in[IN_X], (bf16_t*)(ws + WS_X1B), (float*)(ws + WS_SSQ1)};
        pg8::gemm_phase<D, D, D>(F.lds, F.wave, S, E);
    }
    SEAM(3);
    if (IN(4)) {
        pg8::DenseOrder S; S.init(T, D, F.G, (int)blockIdx.x, ws + WS_X1B, D, ws + WS_WQK_T, D, S_TILES, (size_t)D * D * 2);
        EpiSoftmax E{(const float*)(ws + WS_SSQ1), (bf16_t*)(ws + WS_P)};
        pg8::gemm_phase<D, D, D>(F.lds, F.wave, S, E);
    }
    SEAM(4);
    if (IN(5)) {
        pg8::DenseOrder S; S.init(T, D, F.G, (int)blockIdx.x, ws + WS_P, D, ws + WS_VW_T, D, S_TILES, (size_t)D * D * 2);
        EpiResidB E{(const bf16_t*)(ws + WS_X1B), (bf16_t*)(ws + WS_X2B)};
        pg8::gemm_phase<D, D, D>(F.lds, F.wave, S, E);
    }
    SEAM(5);
    if (IN(6)) { for (int blk = F.vcu; blk < T / 128; blk += F.G) router_block(F, args, blk); }
    SEAM(6);
    if (IN(7)) { for (int blk = F.vcu; blk < T / 128; blk += F.G) assign_block(F, args, blk); }
    SEAM(7);
    if (IN(8)) {
        GroupedOrder S; S.init(F.G, (int)blockIdx.x, (const int*)(ws + RT_TILE_E), ws + WS_X2B, D, ws + WS_WGU_T, D, (size_t)1024 * 1024 * 2, true);
        EpiSwiGLU E{(bf16_t*)(ws + WS_HID), (const float*)(ws + RT_RS_SLOT)};
        pg8::gemm_phase<D, D, D, true>(F.lds, F.wave, S, E, (const int*)(ws + RT_TOK_OF_SLOT));
    }
    SEAM(8);
    if (IN(9)) {
        GroupedOrder S; S.init(F.G, (int)blockIdx.x, (const int*)(ws + RT_TILE_E), ws + WS_HID, DE, ws + WS_WD_T, DE, (size_t)1024 * 512 * 2);
        EpiDown E{(bf16_t*)(ws + WS_YSLOT), (const float*)(ws + RT_GATE_SLOT)};
        pg8::gemm_phase<DE, DE, DE>(F.lds, F.wave, S, E);
    }
    SEAM(9);
    if (IN(10)) { combine_rows(F, args, F.out); }
#undef IN
#undef SEAM
}
extern "C" void kernel_launch(void* const* d_in, const int* in_sizes, int n_in, void* d_out, int out_size, void* d_ws, size_t ws_size, hipStream_t stream) {
    if (n_in != 26 || out_size != T * D || ws_size < 500 * MiB) { fprintf(stderr, "kernel_launch: unexpected shapes n_in %d out %d ws %zu\n", n_in, out_size, ws_size); return; }
    float* xres = (float*)d_out;
    static int grid = 0;
    if (grid == 0) {
        int dev = 0, cus = 0, per_cu = 0;
        if (hipGetDevice(&dev) != hipSuccess || hipDeviceGetAttribute(&cus, hipDeviceAttributeMultiprocessorCount, dev) != hipSuccess) { fprintf(stderr, "kernel_launch: device query failed\n"); grid = -1; return; }
        if (hipFuncSetAttribute((const void*)mk_fwd, hipFuncAttributeMaxDynamicSharedMemorySize, LDS_BYTES) != hipSuccess) { fprintf(stderr, "kernel_launch: hipFuncSetAttribute failed\n"); grid = -1; return; }
        if (hipOccupancyMaxActiveBlocksPerMultiprocessor(&per_cu, (const void*)mk_fwd, NTHREADS, LDS_BYTES) != hipSuccess || per_cu < 1) { fprintf(stderr, "kernel_launch: occupancy query says %d blocks per CU\n", per_cu); (void)hipGetLastError(); grid = -1; return; }
        grid = cus;
        if (grid != 256) fprintf(stderr, "kernel_launch: note: %d CUs (built and tuned for 256)\n", grid);
    }
    if (grid < 0) return;
    Args a{};
    for (int i = 0; i < 26; ++i) a.in[i] = (const float*)d_in[i];
    a.out = xres; a.ws = (unsigned char*)d_ws;
    if (hipMemsetAsync((char*)d_ws + WS_CTL + 4096 * 4, 0, XCD_BAR_WORDS * 4, stream) != hipSuccess) { fprintf(stderr, "kernel_launch: memset failed\n"); return; }
#if defined(MK_PER_PHASE)
    for (int ph = 0; ph < 11; ++ph) { a.ph_lo = ph; a.ph_hi = ph + 1; hipLaunchKernelGGL(mk_fwd, dim3(grid), dim3(NTHREADS), LDS_BYTES, stream, a); }
#else
    a.ph_lo = 0; a.ph_hi = 11;
    hipLaunchKernelGGL(mk_fwd, dim3(grid), dim3(NTHREADS), LDS_BYTES, stream, a);
    const hipError_t le = hipPeekAtLastError();
    if (le != hipSuccess) fprintf(stderr, "kernel_launch: launch failed: %s (grid %d)\n", hipGetErrorString(le), grid);
#endif
}
```

```cpp
#include <hip/hip_runtime.h>
#include <cstdint>
#include <cstdio>

namespace cfg {
constexpr int D = 1024, B = 8, S = 4096, T = B * S;
constexpr int CW = 512, GW = 512, NH = 8, HD = 64, CHUNK = 128, INC = 2560;
constexpr int ML = 256, XH = 4, XD = 256;
constexpr int NG = 4, EPG = 8, NE = 32, DE = 512;
constexpr float EPS = 1e-6f;
}
constexpr size_t MiB = 1u << 20;
using namespace cfg;

#define LAS __attribute__((address_space(3)))
#define GAS __attribute__((address_space(1)))
typedef unsigned short bf16_t;
typedef short bf16x8 __attribute__((ext_vector_type(8)));
typedef short s16x4 __attribute__((ext_vector_type(4)));
typedef float f32x4 __attribute__((ext_vector_type(4)));
typedef float f32x2 __attribute__((ext_vector_type(2)));
typedef unsigned u32x4 __attribute__((ext_vector_type(4)));
typedef unsigned u32x2 __attribute__((ext_vector_type(2)));

constexpr int NWAVES = 8, NTHREADS = 512;
constexpr int S_TILES = cfg::S / 256;
constexpr int LDS_BYTES = 147456;
constexpr int LDS_STAGE = 131072;
constexpr int LDS_EXCH = 131072;
constexpr int LDS_MISC = LDS_BYTES - 256;

constexpr size_t WS_CTL = 0;
constexpr size_t WS_WIN_T = 1 * MiB;
constexpr size_t WS_WOUT_T = 6 * MiB;
constexpr size_t WS_WQ_NAT = 8 * MiB;
constexpr size_t WS_WO_T = 10 * MiB;
constexpr size_t WS_WKV_T = 12 * MiB;
constexpr size_t WS_WS_BF = 16 * MiB;
constexpr size_t WS_MEMN = 17 * MiB;
constexpr size_t WS_KV = 21 * MiB;
constexpr size_t WS_WQK_T = 29 * MiB;
constexpr size_t WS_VW_T = 45 * MiB;
constexpr size_t WS_WGU_T = 61 * MiB;
constexpr size_t WS_WD_T = 125 * MiB;
constexpr size_t WS_WR = 157 * MiB;
constexpr size_t WS_SSQ1 = 158 * MiB;
constexpr size_t WS_ROUTE = 160 * MiB;
constexpr size_t WS_ACT0 = 164 * MiB;
constexpr size_t WS_ACT1 = 228 * MiB;
constexpr size_t WS_GB = WS_ACT1, WS_Z = WS_ACT1 + 32 * MiB, WS_UG = WS_ACT1 + 64 * MiB, WS_VG = WS_ACT1 + 96 * MiB;
constexpr size_t WS_X2B = WS_ACT1 + 64 * MiB;
constexpr size_t WS_HID = WS_ACT0;
constexpr size_t WS_YSLOT = 356 * MiB;
constexpr size_t RT_TOK_E = WS_ROUTE, RT_TOK_G = WS_ROUTE + 256 * 1024, RT_RS2 = WS_ROUTE + 512 * 1024, RT_TOK_R = WS_ROUTE + 640 * 1024, RT_HIST = WS_ROUTE + 896 * 1024,
                 RT_SLOT_OF = WS_ROUTE + 1024 * 1024, RT_GATE_SLOT = WS_ROUTE + 1536 * 1024, RT_TILE_E = WS_ROUTE + 2048 * 1024,
                 RT_TOK_OF_SLOT = WS_ROUTE + 2304 * 1024, RT_RS_SLOT = WS_ROUTE + 2816 * 1024;
constexpr int MAX_TILES = 288;
constexpr size_t WS_HB = WS_ACT0, WS_Y = WS_ACT0, WS_P = WS_ACT0, WS_X1B = WS_ACT1;

__device__ __forceinline__ unsigned f2bf(float f) { unsigned u = __builtin_bit_cast(unsigned, f); return (u + 0x7fffu + ((u >> 16) & 1u)) >> 16; }
__device__ __forceinline__ unsigned pk2(float lo, float hi) { return f2bf(lo) | (f2bf(hi) << 16); }
__device__ __forceinline__ unsigned cvt_pk_bf16(float lo, float hi) { unsigned r; asm volatile("v_cvt_pk_bf16_f32 %0, %1, %2" : "=v"(r) : "v"(lo), "v"(hi)); return r; }
__device__ __forceinline__ float bf_lo(unsigned w) { return __uint_as_float(w << 16); }
__device__ __forceinline__ float bf_hi(unsigned w) { return __uint_as_float(w & 0xffff0000u); }
__device__ __forceinline__ float wave_sum(float v) {
#pragma unroll
    for (int o = 1; o < 64; o <<= 1) v += __shfl_xor(v, o);
    return v;
}
__device__ __forceinline__ float gelu_fast(float x) {
    const float t = x * (1.0f + 0.044715f * x * x) * 2.302208198f;
    return x * __builtin_amdgcn_rcpf(1.0f + __builtin_amdgcn_exp2f(-t));
}
__device__ __forceinline__ int lane_id_fresh() { int l; asm volatile("v_mbcnt_lo_u32_b32 %0, -1, 0\n\tv_mbcnt_hi_u32_b32 %0, -1, %0" : "=v"(l)); return l; }
#define LDS_WAIT() asm volatile("s_waitcnt lgkmcnt(0)" ::: "memory")
#define VM_WAIT() asm volatile("s_waitcnt vmcnt(0)" ::: "memory")

namespace pg8 {
constexpr int BM = 256, BK = 64, HALF = 128, HTB = HALF * BK * 2, STAGE_BYTES = 8 * HTB, NXCD = 8, WGM = 8;
__host__ __device__ __forceinline__ int lds_byte(int r, int c) { const int st = (r >> 4) * 2 + (c >> 5), rr = r & 15, cc = c & 31, ob = rr * 64 + cc * 2; return st * 1024 + (ob ^ (((ob >> 9) & 1) << 5)); }
__host__ __device__ __forceinline__ void stage_rc(int b, int& R, int& C) { const int st = b / 1024, sb = b % 1024, swz = sb ^ (((sb >> 9) & 1) << 5); R = (st >> 1) * 16 + swz / 64; C = (st & 1) * 32 + (swz % 64) / 2; }
__host__ __device__ __forceinline__ int perm32(int rho) { const int n = rho >> 4, i = rho & 15; return 8 * (i >> 2) + 4 * n + (i & 3); }

__device__ __forceinline__ const char* uni(const char* p) { const unsigned long long v = (unsigned long long)p;
    const unsigned lo = __builtin_amdgcn_readfirstlane((unsigned)v), hi = __builtin_amdgcn_readfirstlane((unsigned)(v >> 32)); return (const char*)(((unsigned long long)hi << 32) | lo); }
struct Unit { int pm, pn, aux; const char* a; const char* b; };

typedef f32x4 Acc[2][2][4][2];

template <int lda, int ldb, int K, bool GATHER = false, class Epi, class Sched>
__device__ __forceinline__ void gemm_phase(LAS unsigned char* lds, const int wid, const Sched& S, const Epi& E, const int* gidx = nullptr) {
    const int lane = lane_id_fresh(), tid = wid * 64 + lane, wr = wid >> 2, wc = wid & 3, fr = lane & 15, fq = lane >> 4;
    constexpr int nt = K / BK;
    unsigned voffA, voffB;
    { int R, C; stage_rc(tid * 16, R, C); const int Rb = (R & ~31) + perm32(R & 31); voffA = (unsigned)(R * lda + C) * 2u; voffB = (unsigned)(Rb * ldb + C) * 2u; }
    constexpr size_t pstepA = (size_t)64 * lda * 2, pstepB = (size_t)64 * ldb * 2;
    constexpr size_t kstep = (size_t)(BK * 2);
    constexpr size_t hstepA = (size_t)HALF * lda * 2, hstepB = (size_t)HALF * ldb * 2;
    const unsigned ldsw = (unsigned)wid * 1024u;
    const int aoff = lds_byte(wr * 64 + fr, fq * 8), boff = lds_byte(wc * 32 + fr, fq * 8);
#define PG8_SA(b, h) (((b) * 2 + (h)) * HTB)
#define PG8_SB(b, h) ((4 + (b) * 2 + (h)) * HTB)
#define PG8_STAGE(bufoff, gbase, X) do { _Pragma("unroll") for (int _i = 0; _i < 2; ++_i) \
        __builtin_amdgcn_global_load_lds((const unsigned*)(uni((const char*)(gbase) + (size_t)_i * pstep##X) + voff##X), (LAS unsigned*)(lds + (bufoff) + ldsw + _i * 8192), 16, 0, 0); } while (0)
#define PG8_STAGE_A(bufoff, kp, h, OFF) do { _Pragma("unroll") for (int _i = 0; _i < 2; ++_i) { \
        if constexpr (GATHER) __builtin_amdgcn_global_load_lds((const unsigned*)(uni((const char*)(kp)) + OFF[h][_i]), (LAS unsigned*)(lds + (bufoff) + ldsw + _i * 8192), 16, 0, 0); \
        else __builtin_amdgcn_global_load_lds((const unsigned*)(uni((const char*)(kp) + (size_t)(h) * hstepA + (size_t)_i * pstepA) + voffA), (LAS unsigned*)(lds + (bufoff) + ldsw + _i * 8192), 16, 0, 0); } } while (0)
#define PG8_LDA(dst, b, h) do { _Pragma("unroll") for (int m = 0; m < 4; ++m) _Pragma("unroll") for (int k = 0; k < 2; ++k) dst[m][k] = *(const LAS bf16x8*)(lds + PG8_SA(b, h) + aoff + m * 2048 + k * 1024); } while (0)
#define PG8_LDB(dst, b, h) do { _Pragma("unroll") for (int n = 0; n < 2; ++n) _Pragma("unroll") for (int k = 0; k < 2; ++k) dst[n][k] = *(const LAS bf16x8*)(lds + PG8_SB(b, h) + boff + n * 2048 + k * 1024); } while (0)
#define PG8_MMA(ai, bj, At, Bt) do { __builtin_amdgcn_s_setprio(1); _Pragma("unroll") for (int m = 0; m < 4; ++m) _Pragma("unroll") for (int n = 0; n < 2; ++n) _Pragma("unroll") for (int k = 0; k < 2; ++k) \
        acc[ai][bj][m][n] = __builtin_amdgcn_mfma_f32_16x16x32_bf16(Bt[n][k], At[m][k], acc[ai][bj][m][n], 0, 0, 0); __builtin_amdgcn_s_setprio(0); } while (0)
#define PG8_WAIT_V(n) asm volatile("s_waitcnt vmcnt(" #n ")" ::: "memory")
#define PG8_WAIT_L(n) asm volatile("s_waitcnt lgkmcnt(" #n ")" ::: "memory")
#define PG8_BAR __builtin_amdgcn_s_barrier()
#define PG8_SCHED __builtin_amdgcn_sched_barrier(0)
    Unit cur, nxt; int ui = 0;
    if (!S.next(0, cur)) return;
    Acc acc;
#pragma unroll
    for (int a = 0; a < 2; ++a)
#pragma unroll
        for (int b = 0; b < 2; ++b)
#pragma unroll
            for (int m = 0; m < 4; ++m)
#pragma unroll
                for (int n = 0; n < 2; ++n) acc[a][b][m][n] = (f32x4){0.f, 0.f, 0.f, 0.f};
    bf16x8 At[4][2], B0[2][2], B1[2][2];
    const char* cA = cur.a; const char* cB = cur.b;
    unsigned go[2][2], gn[2][2];
    LAS const unsigned* lidx = (LAS const unsigned*)(lds + STAGE_BYTES);
    if constexpr (GATHER) {
        { Unit uu; for (int i = 0; S.next(i, uu); ++i) if (tid < 256) ((LAS unsigned*)lidx)[i * 256 + tid] = (unsigned)gidx[uu.pm * 256 + tid] * (unsigned)(lda * 2); }
        asm volatile("s_waitcnt vmcnt(0) lgkmcnt(0)" ::: "memory"); PG8_BAR; asm volatile("" ::: "memory");
        int R, C; stage_rc(tid * 16, R, C);
#pragma unroll
        for (int h = 0; h < 2; ++h)
#pragma unroll
            for (int i = 0; i < 2; ++i) { go[h][i] = lidx[h * 128 + i * 64 + R] + (unsigned)(C * 2); gn[h][i] = go[h][i]; }
    }
    PG8_STAGE(PG8_SB(0, 0), cB, B); PG8_STAGE(PG8_SB(0, 1), cB + hstepB, B); PG8_STAGE_A(PG8_SA(0, 0), cA, 0, go); PG8_STAGE_A(PG8_SA(0, 1), cA, 1, go);
    if (wr == 1) PG8_BAR;
    PG8_WAIT_V(2); PG8_BAR;
    PG8_STAGE(PG8_SB(1, 0), cB + kstep, B); PG8_STAGE_A(PG8_SA(1, 0), cA + kstep, 0, go); PG8_STAGE(PG8_SB(1, 1), cB + hstepB + kstep, B);
    PG8_WAIT_V(6); PG8_BAR;
    for (;;) {
        const bool has_next = S.next(ui + 1, nxt);
        const char* nA = has_next ? nxt.a : cA; const char* nB = has_next ? nxt.b : cB;
        for (int t = 0; t < nt; t += 2) {
            const bool last = (t == nt - 2);
            const char* a1 = cA + (size_t)(t + 1) * kstep;
            const char* a2 = last ? nA : cA + (size_t)(t + 2) * kstep; const char* b2 = last ? nB : cB + (size_t)(t + 2) * kstep;
            const char* a3 = a2 + kstep; const char* b3 = b2 + kstep;
            if constexpr (GATHER) { if (last && has_next) { int R, C; stage_rc(tid * 16, R, C);
#pragma unroll
                for (int h = 0; h < 2; ++h)
#pragma unroll
                    for (int i = 0; i < 2; ++i) gn[h][i] = lidx[(ui + 1) * 256 + h * 128 + i * 64 + R] + (unsigned)(C * 2); } }
            unsigned gx[2][2];
#pragma unroll
            for (int h = 0; h < 2; ++h)
#pragma unroll
                for (int i = 0; i < 2; ++i) gx[h][i] = GATHER ? (last ? gn[h][i] : go[h][i]) : 0u;
            PG8_LDB(B0, 0, 0); PG8_LDB(B1, 0, 1); PG8_SCHED; PG8_LDA(At, 0, 0); PG8_STAGE_A(PG8_SA(1, 1), a1, 1, go);
            PG8_WAIT_V(8); PG8_WAIT_L(0); PG8_BAR; PG8_MMA(0, 0, At, B0); PG8_MMA(0, 1, At, B1); PG8_BAR; PG8_SCHED;
            PG8_LDA(At, 0, 1); PG8_STAGE(PG8_SB(0, 0), b2, B); PG8_STAGE(PG8_SB(0, 1), b2 + hstepB, B); PG8_STAGE_A(PG8_SA(0, 0), a2, 0, gx);
            PG8_WAIT_V(8); PG8_WAIT_L(0); PG8_BAR; PG8_MMA(1, 0, At, B0); PG8_MMA(1, 1, At, B1); PG8_BAR; PG8_SCHED;
            PG8_LDB(B0, 1, 0); PG8_LDB(B1, 1, 1); PG8_SCHED; PG8_LDA(At, 1, 0); PG8_STAGE_A(PG8_SA(0, 1), a2, 1, gx);
            PG8_WAIT_V(8); PG8_WAIT_L(0); PG8_BAR; PG8_MMA(0, 0, At, B0); PG8_MMA(0, 1, At, B1); PG8_BAR; PG8_SCHED;
            PG8_LDA(At, 1, 1); PG8_STAGE(PG8_SB(1, 0), b3, B); PG8_STAGE(PG8_SB(1, 1), b3 + hstepB, B); PG8_STAGE_A(PG8_SA(1, 0), a3, 0, gx);
            PG8_WAIT_V(8); PG8_WAIT_L(0); PG8_BAR; PG8_MMA(1, 0, At, B0); PG8_MMA(1, 1, At, B1); PG8_BAR; PG8_SCHED;
            if constexpr (GATHER) { if (last) {
#pragma unroll
                for (int h = 0; h < 2; ++h)
#pragma unroll
                    for (int i = 0; i < 2; ++i) go[h][i] = gn[h][i]; } }
        }
        if (wr == 0) PG8_BAR;
        { const int le = lane_id_fresh();
          E(acc, cur, wr, wc, le & 15, le >> 4, lds + STAGE_BYTES, wid, le); }
        if (!has_next) break;
#pragma unroll
        for (int a = 0; a < 2; ++a)
#pragma unroll
            for (int b = 0; b < 2; ++b)
#pragma unroll
                for (int m = 0; m < 4; ++m)
#pragma unroll
                    for (int n = 0; n < 2; ++n) acc[a][b][m][n] = (f32x4){0.f, 0.f, 0.f, 0.f};
        cur = nxt; cA = nA; cB = nB; ++ui;
        if (wr == 1) PG8_BAR;
    }
    PG8_WAIT_V(0);
    PG8_BAR;
#undef PG8_SA
#undef PG8_SB
#undef PG8_STAGE
#undef PG8_STAGE_A
#undef PG8_LDA
#undef PG8_LDB
#undef PG8_MMA
#undef PG8_WAIT_V
#undef PG8_WAIT_L
#undef PG8_BAR
#undef PG8_SCHED
}

struct DenseOrder {
    int nM, nN, nwg, G, c; const char* A; const char* Bt; size_t tA, tB; int bdiv; size_t bstride;
    __device__ __forceinline__ void init(int M, int N, int G_, int c_, const void* A_, int lda, const void* Bt_, int ldb, int bdiv_ = 0, size_t bstride_ = 0) {
        nM = M / BM; nN = N / BM; nwg = nM * nN; G = G_; c = c_; A = (const char*)A_; Bt = (const char*)Bt_; tA = (size_t)BM * lda * 2; tB = (size_t)BM * ldb * 2; bdiv = bdiv_; bstride = bstride_; }
    __device__ __forceinline__ bool next(int i, Unit& u) const {
        const long L = (long)i * G + c; if (L >= nwg) return false;
        int wgid = (int)L; { const int q = nwg / NXCD, r = nwg % NXCD, xcd = wgid % NXCD, off = wgid / NXCD; wgid = (xcd < r ? xcd * (q + 1) : r * (q + 1) + (xcd - r) * q) + off; }
        const int nig = WGM * nN, gid = wgid / nig, fm = gid * WGM, gsz = (nM - fm) < WGM ? (nM - fm) : WGM;
        u.pm = fm + ((wgid % nig) % gsz); u.pn = (wgid % nig) / gsz; u.aux = 0;
        u.a = A + (size_t)u.pm * tA; u.b = Bt + (size_t)u.pn * tB + (bdiv ? (size_t)(u.pm / bdiv) * bstride : 0);
        return true;
    }
};
}

using pg8::Acc; using pg8::Unit;
#define EPI_ARGS Acc& acc, const Unit& u, int wr, int wc, int fr, int fq, LAS unsigned char* ldsx, int wid, int lane
struct EpiBf16 {
    bf16_t* O; int ldc;
    __device__ __forceinline__ void operator()(EPI_ARGS) const {
        bf16_t* base = O + (size_t)(u.pm * 256 + wr * 64 + fr) * ldc + u.pn * 256 + wc * 32 + 8 * fq;
#pragma unroll
        for (int ai = 0; ai < 2; ++ai)
#pragma unroll
            for (int m = 0; m < 4; ++m)
#pragma unroll
                for (int bj = 0; bj < 2; ++bj) { const f32x4 v0 = acc[ai][bj][m][0], v1 = acc[ai][bj][m][1]; u32x4 w;
                    w.x = cvt_pk_bf16(v0[0], v0[1]); w.y = cvt_pk_bf16(v0[2], v0[3]); w.z = cvt_pk_bf16(v1[0], v1[1]); w.w = cvt_pk_bf16(v1[2], v1[3]);
                    *(u32x4*)(base + (size_t)(ai * 128 + m * 16) * ldc + bj * 128) = w; }
    }
};
struct EpiBf16Aux {
    bf16_t* O; int ldc;
    __device__ __forceinline__ void operator()(EPI_ARGS) const {
        bf16_t* base = O + (size_t)(unsigned)u.aux + (size_t)(wr * 64 + fr) * ldc + wc * 32 + 8 * fq;
#pragma unroll
        for (int ai = 0; ai < 2; ++ai)
#pragma unroll
            for (int m = 0; m < 4; ++m)
#pragma unroll
                for (int bj = 0; bj < 2; ++bj) { const f32x4 v0 = acc[ai][bj][m][0], v1 = acc[ai][bj][m][1]; u32x4 w;
                    w.x = cvt_pk_bf16(v0[0], v0[1]); w.y = cvt_pk_bf16(v0[2], v0[3]); w.z = cvt_pk_bf16(v1[0], v1[1]); w.w = cvt_pk_bf16(v1[2], v1[3]);
                    *(u32x4*)(base + (size_t)(ai * 128 + m * 16) * ldc + bj * 128) = w; }
    }
};
struct EpiInProj {
    bf16_t *GB, *Z, *UG, *VG;
    __device__ __forceinline__ void operator()(EPI_ARGS) const {
        const int pn = u.pn; const size_t row0 = (size_t)(u.pm * 256 + wr * 64 + fr); const int cl = wc * 32 + 8 * fq;
        if (pn >= 2 && pn < 6) {
            bf16_t* base = Z + row0 * 512 + (pn - 2) * 128 + cl;
#pragma unroll
            for (int ai = 0; ai < 2; ++ai)
#pragma unroll
                for (int m = 0; m < 4; ++m) { const f32x4 z0 = acc[ai][0][m][0] * acc[ai][1][m][0], z1 = acc[ai][0][m][1] * acc[ai][1][m][1]; u32x4 w;
                    w.x = cvt_pk_bf16(z0[0], z0[1]); w.y = cvt_pk_bf16(z0[2], z0[3]); w.z = cvt_pk_bf16(z1[0], z1[1]); w.w = cvt_pk_bf16(z1[2], z1[3]);
                    *(u32x4*)(base + (size_t)(ai * 128 + m * 16) * 512) = w; }
        } else {
            const bool act = pn >= 6;
            const int sel = pn < 2 ? 0 : (pn < 8 ? 2 : 3), ct = pn < 2 ? pn : (pn < 8 ? pn - 6 : pn - 8);
            bf16_t* base = GB + (size_t)sel * (16u << 20) + row0 * 512 + ct * 256 + cl;
#pragma unroll
            for (int ai = 0; ai < 2; ++ai)
#pragma unroll
                for (int m = 0; m < 4; ++m)
#pragma unroll
                    for (int bj = 0; bj < 2; ++bj) { f32x4 v0 = acc[ai][bj][m][0], v1 = acc[ai][bj][m][1];
                        if (act) {
#pragma unroll
                            for (int i = 0; i < 4; ++i) { v0[i] = gelu_fast(v0[i]); v1[i] = gelu_fast(v1[i]); } }
                        u32x4 w; w.x = cvt_pk_bf16(v0[0], v0[1]); w.y = cvt_pk_bf16(v0[2], v0[3]); w.z = cvt_pk_bf16(v1[0], v1[1]); w.w = cvt_pk_bf16(v1[2], v1[3]);
                        *(u32x4*)(base + (size_t)(ai * 128 + m * 16) * 512 + bj * 128) = w; }
        }
    }
};
struct EpiResidA {
    const float* R; bf16_t* XB; float* SSQ;
    __device__ __forceinline__ void operator()(EPI_ARGS) const {
        const size_t row0 = (size_t)(u.pm * 256 + wr * 64 + fr); const int col0 = u.pn * 256 + wc * 32 + 8 * fq;
#pragma unroll
        for (int ai = 0; ai < 2; ++ai)
#pragma unroll
            for (int m = 0; m < 4; ++m) { const size_t off = (row0 + ai * 128 + m * 16) * 1024 + col0; float sq = 0.f;
#pragma unroll
                for (int bj = 0; bj < 2; ++bj) { const f32x4 r0 = __builtin_nontemporal_load((const f32x4*)(R + off + bj * 128)), r1 = __builtin_nontemporal_load((const f32x4*)(R + off + bj * 128 + 4));
                    const f32x4 v0 = r0 + acc[ai][bj][m][0], v1 = r1 + acc[ai][bj][m][1];
                    u32x4 w; w.x = cvt_pk_bf16(v0[0], v0[1]); w.y = cvt_pk_bf16(v0[2], v0[3]); w.z = cvt_pk_bf16(v1[0], v1[1]); w.w = cvt_pk_bf16(v1[2], v1[3]); *(u32x4*)(XB + off + bj * 128) = w;
                    sq += (v0[0] * v0[0] + v0[1] * v0[1]) + (v0[2] * v0[2] + v0[3] * v0[3]) + (v1[0] * v1[0] + v1[1] * v1[1]) + (v1[2] * v1[2] + v1[3] * v1[3]); }
                sq += __shfl_xor(sq, 16); sq += __shfl_xor(sq, 32); if (fq == 0) SSQ[(row0 + ai * 128 + m * 16) * 16 + u.pn * 4 + wc] = sq;
                if (m & 1) asm volatile("" ::: "memory"); }
    }
};
struct EpiResidB {
    const bf16_t* RB; bf16_t* XB;
    __device__ __forceinline__ void operator()(EPI_ARGS) const {
        const size_t row0 = (size_t)(u.pm * 256 + wr * 64 + fr); const int col0 = u.pn * 256 + wc * 32 + 8 * fq;
#pragma unroll
        for (int ai = 0; ai < 2; ++ai)
#pragma unroll
            for (int m = 0; m < 4; ++m) { const size_t off = (row0 + ai * 128 + m * 16) * 1024 + col0;
#pragma unroll
                for (int bj = 0; bj < 2; ++bj) { const u32x4 r = __builtin_nontemporal_load((const u32x4*)(RB + off + bj * 128));
                    const f32x4 v0 = (f32x4){bf_lo(r.x), bf_hi(r.x), bf_lo(r.y), bf_hi(r.y)} + acc[ai][bj][m][0], v1 = (f32x4){bf_lo(r.z), bf_hi(r.z), bf_lo(r.w), bf_hi(r.w)} + acc[ai][bj][m][1];
                    u32x4 w; w.x = cvt_pk_bf16(v0[0], v0[1]); w.y = cvt_pk_bf16(v0[2], v0[3]); w.z = cvt_pk_bf16(v1[0], v1[1]); w.w = cvt_pk_bf16(v1[2], v1[3]); *(u32x4*)(XB + off + bj * 128) = w; }
                if (m & 1) asm volatile("" ::: "memory"); }
    }
};
struct EpiSoftmax {
    const float* SSQ; bf16_t* P;
    __device__ __forceinline__ void operator()(EPI_ARGS) const {
        const size_t row0 = (size_t)(u.pm * 256 + wr * 64 + fr);
        LAS f32x2* ex = (LAS f32x2*)ldsx;
        float mw[2][4];
#pragma unroll
        for (int ai = 0; ai < 2; ++ai)
#pragma unroll
            for (int m = 0; m < 4; ++m) {
                const f32x4* q = (const f32x4*)(SSQ + (row0 + ai * 128 + m * 16) * 16);
                const f32x4 q0 = q[0], q1 = q[1], q2 = q[2], q3 = q[3];
                const float ss = ((q0[0] + q0[1]) + (q0[2] + q0[3])) + ((q1[0] + q1[1]) + (q1[2] + q1[3])) + ((q2[0] + q2[1]) + (q2[2] + q2[3])) + ((q3[0] + q3[1]) + (q3[2] + q3[3]));
                const float rs = rsqrtf(ss * (1.f / 1024.f) + EPS);
                float mx = -3.0e38f;
#pragma unroll
                for (int bj = 0; bj < 2; ++bj)
#pragma unroll
                    for (int n = 0; n < 2; ++n) { f32x4 v = acc[ai][bj][m][n] * rs; acc[ai][bj][m][n] = v; mx = fmaxf(fmaxf(mx, fmaxf(v[0], v[1])), fmaxf(v[2], v[3])); }
                mx = fmaxf(mx, __shfl_xor(mx, 16)); mx = fmaxf(mx, __shfl_xor(mx, 32));
                float sum = 0.f;
#pragma unroll
                for (int bj = 0; bj < 2; ++bj)
#pragma unroll
                    for (int n = 0; n < 2; ++n) { f32x4 v = acc[ai][bj][m][n];
#pragma unroll
                        for (int i = 0; i < 4; ++i) v[i] = __builtin_amdgcn_exp2f(v[i] - mx);
                        acc[ai][bj][m][n] = v; sum += (v[0] + v[1]) + (v[2] + v[3]); }
                sum += __shfl_xor(sum, 16); sum += __shfl_xor(sum, 32);
                mw[ai][m] = mx;
                if (fq == 0) ex[(ai * 128 + wr * 64 + m * 16 + fr) * 4 + wc] = (f32x2){mx, sum};
            }
        asm volatile("s_waitcnt lgkmcnt(0)" ::: "memory"); __builtin_amdgcn_s_barrier(); asm volatile("" ::: "memory");
        bf16_t* base = P + row0 * 1024 + u.pn * 256 + wc * 32 + 8 * fq;
#pragma unroll
        for (int ai = 0; ai < 2; ++ai)
#pragma unroll
            for (int m = 0; m < 4; ++m) {
                const LAS f32x2* e4 = ex + (ai * 128 + wr * 64 + m * 16 + fr) * 4;
                const f32x2 e0 = e4[0], e1 = e4[1], e2 = e4[2], e3 = e4[3];
                const float M = fmaxf(fmaxf(e0.x, e1.x), fmaxf(e2.x, e3.x));
                const float L = e0.y * __builtin_amdgcn_exp2f(e0.x - M) + e1.y * __builtin_amdgcn_exp2f(e1.x - M) + e2.y * __builtin_amdgcn_exp2f(e2.x - M) + e3.y * __builtin_amdgcn_exp2f(e3.x - M);
                const float f = __builtin_amdgcn_exp2f(mw[ai][m] - M) / L;
#pragma unroll
                for (int bj = 0; bj < 2; ++bj) { const f32x4 v0 = acc[ai][bj][m][0] * f, v1 = acc[ai][bj][m][1] * f; u32x4 w;
                    w.x = cvt_pk_bf16(v0[0], v0[1]); w.y = cvt_pk_bf16(v0[2], v0[3]); w.z = cvt_pk_bf16(v1[0], v1[1]); w.w = cvt_pk_bf16(v1[2], v1[3]);
                    *(u32x4*)(base + (size_t)(ai * 128 + m * 16) * 1024 + bj * 128) = w; }
            }
    }
};
struct WqkOrder {
    int G, c; const char* KV; const char* WQ;
    __device__ __forceinline__ bool next(int i, Unit& u) const {
        const int L = i * G + c; if (L >= 128) return false;
        const int b = L >> 4, h = (L >> 2) & 3, pn = L & 3;
        u.pm = 0; u.pn = pn; u.a = KV + ((size_t)(b * 256) * 2048 + h * 256) * 2; u.b = WQ + ((size_t)(pn * 256) * 1024 + h * 256) * 2;
        u.aux = b * (1024 * 1024) + (h * 256) * 1024 + pn * 256; return true; }
};
struct VwOrder {
    int G, c; const char* KV; const char* WO;
    __device__ __forceinline__ bool next(int i, Unit& u) const {
        const int L = i * G + c; if (L >= 128) return false;
        const int b = L >> 4, h = (L >> 2) & 3, pm = L & 3;
        u.pm = pm; u.pn = 0; u.a = WO + ((size_t)(pm * 256) * 1024 + h * 256) * 2; u.b = KV + ((size_t)(b * 256) * 2048 + 1024 + h * 256) * 2;
        u.aux = b * (1024 * 1024) + (pm * 256) * 1024 + h * 256; return true; }
};

struct EpiSwiGLU {
    bf16_t* H; const float* rs_slot;
    __device__ __forceinline__ void operator()(EPI_ARGS) const {
        const size_t row0 = (size_t)(u.pm * 256 + wr * 64 + fr);
        bf16_t* base = H + row0 * 512 + u.pn * 128 + wc * 32 + 8 * fq;
#pragma unroll
        for (int ai = 0; ai < 2; ++ai)
#pragma unroll
            for (int m = 0; m < 4; ++m) { const float rs = rs_slot[row0 + ai * 128 + m * 16]; f32x4 h0, h1;
#pragma unroll
                for (int i = 0; i < 4; ++i) { const float g0 = acc[ai][0][m][0][i] * rs, g1 = acc[ai][0][m][1][i] * rs;
                    h0[i] = g0 * __builtin_amdgcn_rcpf(1.0f + __builtin_amdgcn_exp2f(-1.4426950408889634f * g0)) * (acc[ai][1][m][0][i] * rs);
                    h1[i] = g1 * __builtin_amdgcn_rcpf(1.0f + __builtin_amdgcn_exp2f(-1.4426950408889634f * g1)) * (acc[ai][1][m][1][i] * rs); }
                u32x4 w; w.x = cvt_pk_bf16(h0[0], h0[1]); w.y = cvt_pk_bf16(h0[2], h0[3]); w.z = cvt_pk_bf16(h1[0], h1[1]); w.w = cvt_pk_bf16(h1[2], h1[3]);
                *(u32x4*)(base + (size_t)(ai * 128 + m * 16) * 512) = w; }
    }
};
struct EpiDown {
    bf16_t* Y; const float* gate;
    __device__ __forceinline__ void operator()(EPI_ARGS) const {
        const size_t row0 = (size_t)(u.pm * 256 + wr * 64 + fr);
        bf16_t* base = Y + row0 * 1024 + u.pn * 256 + wc * 32 + 8 * fq;
#pragma unroll
        for (int ai = 0; ai < 2; ++ai)
#pragma unroll
            for (int m = 0; m < 4; ++m) { const float g = gate[row0 + ai * 128 + m * 16];
#pragma unroll
                for (int bj = 0; bj < 2; ++bj) { const f32x4 v0 = acc[ai][bj][m][0] * g, v1 = acc[ai][bj][m][1] * g; u32x4 w;
                    w.x = cvt_pk_bf16(v0[0], v0[1]); w.y = cvt_pk_bf16(v0[2], v0[3]); w.z = cvt_pk_bf16(v1[0], v1[1]); w.w = cvt_pk_bf16(v1[2], v1[3]);
                    *(u32x4*)(base + (size_t)(ai * 128 + m * 16) * 1024 + bj * 128) = w; } }
    }
};
struct GroupedOrder {
    int G, c, nunits; const int* tile_e; const char* A; const char* W; size_t tA, wE, tB;
    __device__ __forceinline__ void init(int G_, int c_, const int* tbl, const void* A_, int lda, const void* W_, int ldb, size_t expert_bytes, bool gather = false) {
        G = G_; c = c_; tile_e = tbl + 16; nunits = 4 * __builtin_amdgcn_readfirstlane(__hip_atomic_load(tbl, __ATOMIC_RELAXED, __HIP_MEMORY_SCOPE_AGENT)); A = (const char*)A_; W = (const char*)W_; tA = gather ? 0 : (size_t)256 * lda * 2; tB = (size_t)256 * ldb * 2; wE = expert_bytes; }
    __device__ __forceinline__ bool next(int i, Unit& u) const {
        const int L = i * G + c; if (L >= nunits) return false;
        int wgid = L; { const int q = nunits / 8, r = nunits % 8, xcd = wgid % 8, off = wgid / 8; wgid = (xcd < r ? xcd * (q + 1) : r * (q + 1) + (xcd - r) * q) + off; }
        const int tile = wgid >> 2, pn = wgid & 3, e = __builtin_amdgcn_readfirstlane(__hip_atomic_load(tile_e + tile, __ATOMIC_RELAXED, __HIP_MEMORY_SCOPE_AGENT));
        u.pm = tile; u.pn = pn; u.aux = e; u.a = A + (size_t)tile * tA; u.b = W + (size_t)e * wE + (size_t)pn * tB; return true; }
};

struct Args {
    const float* in[26]; float* out; unsigned char* ws; int ph_lo, ph_hi;
};
struct Frame {
    LAS unsigned char* lds; int wave, vcu, G; unsigned char* ws; float* out;
};
#define IN_X 0
#define IN_MEM 1
#define IN_G_MIX 2
#define IN_W_IN 3
#define IN_CONV_W 4
#define IN_G_V 5
#define IN_W_S 6
#define IN_B_S 7
#define IN_G_OUT_CONV 8
#define IN_G_OUT_GMLP 9
#define IN_W_OUT 10
#define IN_G_XATTN 11
#define IN_G_MEM 12
#define IN_W_Q 13
#define IN_W_K 14
#define IN_W_V 15
#define IN_W_O 16
#define IN_G_FFN 17
#define IN_W_GRP 18
#define IN_B_GRP 19
#define IN_W_RT 20
#define IN_B_RT 21
#define IN_W_GATE 22
#define IN_W_UP 23
#define IN_W_DOWN 24
#define IN_G_FINAL 25

struct TrItem { const float* src; bf16_t* dst; const float* gk; int ldw, K; };
__device__ __forceinline__ void tr_load(const TrItem& t, float (&v)[32], int lane) {
    const float* p = t.src + (size_t)(lane >> 5) * t.ldw + (lane & 31);
#pragma unroll
    for (int i = 0; i < 32; ++i) v[i] = __builtin_nontemporal_load(p + (size_t)(2 * i) * t.ldw);
}
__device__ __forceinline__ void tr_finish(const TrItem& t, const float (&v)[32], LAS float* scr, int lane) {
    float g8[8];
    if (t.gk) { const f32x4 ga = *(const f32x4*)(t.gk + 8 * (lane & 7)), gb = *(const f32x4*)(t.gk + 8 * (lane & 7) + 4); g8[0] = ga[0]; g8[1] = ga[1]; g8[2] = ga[2]; g8[3] = ga[3]; g8[4] = gb[0]; g8[5] = gb[1]; g8[6] = gb[2]; g8[7] = gb[3]; }
    else {
#pragma unroll
        for (int j = 0; j < 8; ++j) g8[j] = 1.f; }
#pragma unroll
    for (int i = 0; i < 32; ++i) scr[(2 * i + (lane >> 5)) * 33 + (lane & 31)] = v[i];
    LDS_WAIT(); asm volatile("" ::: "memory");
    const int c = lane & 7;
#pragma unroll
    for (int j = 0; j < 4; ++j) { const int n = (lane >> 3) + 8 * j; const LAS float* s = scr + (8 * c) * 33 + n;
        u32x4 o; o.x = pk2(s[0 * 33] * g8[0], s[1 * 33] * g8[1]); o.y = pk2(s[2 * 33] * g8[2], s[3 * 33] * g8[3]); o.z = pk2(s[4 * 33] * g8[4], s[5 * 33] * g8[5]); o.w = pk2(s[6 * 33] * g8[6], s[7 * 33] * g8[7]);
        *(u32x4*)(t.dst + (size_t)n * t.K + 8 * c) = o; }
    LDS_WAIT(); asm volatile("" ::: "memory");
}
__device__ __forceinline__ TrItem tr_make(const float* W, int ldw, int K, bf16_t* WT, int dst_row0, int src_col0, int k0, const float* gk = nullptr) {
    TrItem t; t.src = W + (size_t)k0 * ldw + src_col0; t.dst = WT + (size_t)dst_row0 * K + k0; t.gk = gk ? gk + k0 : nullptr; t.ldw = ldw; t.K = K; return t; }
__device__ __forceinline__ int in_map(int n0) {
    if (n0 < 512 || n0 >= 1536) return n0;
    const int j = (n0 - 512) >> 8, r = (n0 - 512) & 255;
    return r < 128 ? 512 + 128 * j + r : 1024 + 128 * j + (r - 128);
}
__device__ __forceinline__ void norm_row_bf16(const float* xrow, const float* g, bf16_t* orow, int lane) {
    const f32x4* xr = (const f32x4*)xrow + lane; const f32x4* gr = (const f32x4*)g + lane;
    f32x4 v[4]; float s = 0.f;
#pragma unroll
    for (int j = 0; j < 4; ++j) { v[j] = xr[64 * j]; s += (v[j].x * v[j].x + v[j].y * v[j].y) + (v[j].z * v[j].z + v[j].w * v[j].w); }
    const float rs = rsqrtf(wave_sum(s) * (1.f / 1024.f) + EPS);
    u32x2* o8 = (u32x2*)orow + lane;
#pragma unroll
    for (int j = 0; j < 4; ++j) { const f32x4 gg = gr[64 * j]; u32x2 w; w.x = pk2(v[j].x * rs * gg.x, v[j].y * rs * gg.y); w.y = pk2(v[j].z * rs * gg.z, v[j].w * rs * gg.w); o8[64 * j] = w; }
}
__device__ __forceinline__ void norm_rows4_bf16(const float* X, const float* g, bf16_t* O, int m, int stride, int M, int lane) {
    f32x4 v[4][4]; float s[4]; const f32x4* gr = (const f32x4*)g + lane;
#pragma unroll
    for (int r = 0; r < 4; ++r) { const int mr = (m + r * stride < M) ? m + r * stride : m; const f32x4* xr = (const f32x4*)(X + (size_t)mr * 1024) + lane;
#pragma unroll
        for (int j = 0; j < 4; ++j) v[r][j] = __builtin_nontemporal_load(xr + 64 * j); }
#pragma unroll
    for (int r = 0; r < 4; ++r) { s[r] = 0.f;
#pragma unroll
        for (int j = 0; j < 4; ++j) s[r] += (v[r][j].x * v[r][j].x + v[r][j].y * v[r][j].y) + (v[r][j].z * v[r][j].z + v[r][j].w * v[r][j].w); }
#pragma unroll
    for (int r = 0; r < 4; ++r) { if (m + r * stride >= M) break; const float rs = rsqrtf(wave_sum(s[r]) * (1.f / 1024.f) + EPS); u32x2* o8 = (u32x2*)(O + (size_t)(m + r * stride) * 1024) + lane;
#pragma unroll
        for (int j = 0; j < 4; ++j) { const f32x4 gg = gr[64 * j]; u32x2 w; w.x = pk2(v[r][j].x * rs * gg.x, v[r][j].y * rs * gg.y); w.y = pk2(v[r][j].z * rs * gg.z, v[r][j].w * rs * gg.w); o8[64 * j] = w; } }
}
constexpr int PRO_I_IN = 16 * 80, PRO_I_SQ = 16 * 32, PRO_I_G = 16 * 16, PRO_I_D = 8 * 32, PRO_NITEMS = PRO_I_IN + 4 * PRO_I_SQ + NE * (2 * PRO_I_G + PRO_I_D);
__device__ __forceinline__ TrItem pro_item(const Args& a, unsigned char* ws, int it) {
    int r = it;
    if (r < PRO_I_IN) { const int kb = r / 80, nb = r % 80; return tr_make(a.in[IN_W_IN], INC, D, (bf16_t*)(ws + WS_WIN_T), 32 * nb, in_map(32 * nb), 64 * kb); } r -= PRO_I_IN;
    if (r < 4 * PRO_I_SQ) { const int q = r / PRO_I_SQ; r -= q * PRO_I_SQ; const int kb = r / 32, nb = r % 32;
        const float* W = a.in[q == 0 ? IN_W_OUT : (q == 1 ? IN_W_O : (q == 2 ? IN_W_K : IN_W_V))];
        bf16_t* WT = (bf16_t*)(ws + (q == 0 ? WS_WOUT_T : (q == 1 ? WS_WO_T : WS_WKV_T)));
        return tr_make(W, D, D, WT, (q == 3 ? 1024 : 0) + 32 * nb, 32 * nb, 64 * kb); }
    r -= 4 * PRO_I_SQ;
    const int e = r / (2 * PRO_I_G + PRO_I_D); r -= e * (2 * PRO_I_G + PRO_I_D);
    if (r < 2 * PRO_I_G) { const int up = r >= PRO_I_G; if (up) r -= PRO_I_G; const int kb = r / 16, nb = r % 16, n0 = 32 * nb;
        const int dst = 256 * (n0 >> 7) + (up ? 128 : 0) + (n0 & 127);
        return tr_make(a.in[up ? IN_W_UP : IN_W_GATE] + (size_t)e * D * DE, DE, D, (bf16_t*)(ws + WS_WGU_T) + (size_t)e * 1024 * 1024, dst, n0, 64 * kb, a.in[IN_G_FFN]); }
    r -= 2 * PRO_I_G;
    const int kb = r / 32, nb = r % 32;
    return tr_make(a.in[IN_W_DOWN] + (size_t)e * DE * D, D, DE, (bf16_t*)(ws + WS_WD_T) + (size_t)e * 1024 * 512, 32 * nb, 32 * nb, 64 * kb);
}
__device__ __forceinline__ void p0_prologue(const Frame& F, const Args& a) {
    LAS float* scr = (LAS float*)(F.lds + F.wave * 16384);
    const int lane = lane_id_fresh(), tid = F.wave * 64 + lane;
    unsigned char* ws = F.ws;
    const int gw = F.vcu * NWAVES + F.wave, NGW = F.G * NWAVES;
    {
        float va[32], vb[32]; TrItem ta, tb;
        int it = gw;
        if (it < PRO_NITEMS) { ta = pro_item(a, ws, it); tr_load(ta, va, lane); }
        while (it < PRO_NITEMS) {
            const int i1 = it + NGW; const bool h1 = i1 < PRO_NITEMS;
            if (h1) { tb = pro_item(a, ws, i1); tr_load(tb, vb, lane); }
            tr_finish(ta, va, scr, lane);
            if (!h1) break;
            const int i2 = i1 + NGW; const bool h2 = i2 < PRO_NITEMS;
            if (h2) { ta = pro_item(a, ws, i2); tr_load(ta, va, lane); }
            tr_finish(tb, vb, scr, lane);
            it = i2;
        }
    }
    for (int m = gw; m < T; m += 4 * NGW) norm_rows4_bf16(a.in[IN_X], a.in[IN_G_MIX], (bf16_t*)(ws + WS_HB), m, NGW, T, lane);
    for (int m = gw; m < B * ML; m += NGW) norm_row_bf16(a.in[IN_MEM] + (size_t)m * D, a.in[IN_G_MEM], (bf16_t*)(ws + WS_MEMN) + (size_t)m * D, lane);
    const int gt = F.vcu * NTHREADS + tid, NGT = F.G * NTHREADS;
    { const float* wq = a.in[IN_W_Q]; const float* gx = a.in[IN_G_XATTN]; bf16_t* o = (bf16_t*)(ws + WS_WQ_NAT);
      for (int i = gt; i < D * D / 2; i += NGT) { const int k = (2 * i) >> 10; const float sc = gx[k] * (1.4426950408889634f * 0.0625f); const f32x2 v = *(const f32x2*)(wq + 2 * i); *(unsigned*)(o + 2 * i) = pk2(v.x * sc, v.y * sc); } }
    { const float* w = a.in[IN_W_S]; bf16_t* o = (bf16_t*)(ws + WS_WS_BF);
      for (int i = gt; i < NH * CHUNK * CHUNK; i += NGT) { const int s = i & 127, t = (i >> 7) & 127; o[i] = (bf16_t)f2bf(s <= t ? w[i] : 0.f); } }
    { const float* wg = a.in[IN_W_GRP]; const float* wr = a.in[IN_W_RT]; const float* gf = a.in[IN_G_FFN]; bf16_t* o = (bf16_t*)(ws + WS_WR);
      for (int i = gt; i < 48 * 1024; i += NGT) { const int n = i >> 10, k = i & 1023; float v = 0.f;
          if (n < 4) v = wg[(size_t)k * NG + n] * gf[k]; else if (n < 36) v = wr[(size_t)k * NE + (n - 4)] * gf[k];
          const unsigned hi = f2bf(v); const float lo = v - __uint_as_float(hi << 16); o[i] = (bf16_t)hi; o[48 * 1024 + i] = (bf16_t)f2bf(lo); } }
}

__device__ __forceinline__ void unpack8(const u32x4 w, float (&f)[8]) { f[0] = bf_lo(w.x); f[1] = bf_hi(w.x); f[2] = bf_lo(w.y); f[3] = bf_hi(w.y); f[4] = bf_lo(w.z); f[5] = bf_hi(w.z); f[6] = bf_lo(w.w); f[7] = bf_hi(w.w); }
constexpr int VT_PITCH = 136, VT_HEAD = 128 * VT_PITCH, MIX_EXCH = 8 * VT_HEAD;
__device__ __forceinline__ void mixer_unit(const Frame& F, const Args& a, int ch) {
    const int t0 = ch * 128, w = F.wave, l = lane_id_fresh();
    unsigned char* ws = F.ws;
    const bf16_t* GBp = (const bf16_t*)(ws + WS_GB); const bf16_t* Zp = (const bf16_t*)(ws + WS_Z); const bf16_t* UGp = (const bf16_t*)(ws + WS_UG); const bf16_t* VGp = (const bf16_t*)(ws + WS_VG);
    bf16_t* Y = (bf16_t*)(ws + WS_Y);
    __syncthreads();
    const int h = w;
    u32x4 vraw[16], uraw[16];
    { const int d8 = 8 * (l & 7);
#pragma unroll
      for (int it = 0; it < 16; ++it) vraw[it] = __builtin_nontemporal_load((const u32x4*)(VGp + (size_t)(t0 + 8 * it + (l >> 3)) * 512 + h * 64 + d8));
#pragma unroll
      for (int it = 0; it < 16; ++it) uraw[it] = __builtin_nontemporal_load((const u32x4*)(UGp + (size_t)(t0 + 8 * it + (l >> 3)) * 512 + h * 64 + d8)); }
    asm volatile("" ::: "memory");
    {
        const int c = 8 * l;
        float w0[8], w1[8], w2[8], ga[8], zp1[8], zp2[8];
        const float* cw = a.in[IN_CONV_W]; const float* gc = a.in[IN_G_OUT_CONV];
#pragma unroll
        for (int j = 0; j < 8; ++j) { w0[j] = cw[c + j]; w1[j] = cw[CW + c + j]; w2[j] = cw[2 * CW + c + j]; ga[j] = gc[c + j]; }
        const int r0 = 16 * w, pos0 = (t0 & (S - 1)) + r0;
        if (pos0 >= 2) { unpack8(*(const u32x4*)(Zp + (size_t)(t0 + r0 - 1) * 512 + c), zp1); unpack8(*(const u32x4*)(Zp + (size_t)(t0 + r0 - 2) * 512 + c), zp2); }
        else {
#pragma unroll
            for (int j = 0; j < 8; ++j) { zp1[j] = 0.f; zp2[j] = 0.f; } }
#pragma unroll 8
        for (int r = 0; r < 16; ++r) {
            const size_t t = (size_t)(t0 + r0 + r);
            float gb[8], z[8], ya[8]; unpack8(__builtin_nontemporal_load((const u32x4*)(GBp + t * 512 + c)), gb); unpack8(__builtin_nontemporal_load((const u32x4*)(Zp + t * 512 + c)), z);
            float sq = 0.f;
#pragma unroll
            for (int j = 0; j < 8; ++j) { ya[j] = gb[j] * (w2[j] * z[j] + w1[j] * zp1[j] + w0[j] * zp2[j]); sq += ya[j] * ya[j]; zp2[j] = zp1[j]; zp1[j] = z[j]; }
            const float rs = rsqrtf(wave_sum(sq) * (1.f / 512.f) + EPS);
            u32x4 o; o.x = pk2(ya[0] * rs * ga[0], ya[1] * rs * ga[1]); o.y = pk2(ya[2] * rs * ga[2], ya[3] * rs * ga[3]); o.z = pk2(ya[4] * rs * ga[4], ya[5] * rs * ga[5]); o.w = pk2(ya[6] * rs * ga[6], ya[7] * rs * ga[7]);
            *(u32x4*)(Y + t * 1024 + c) = o;
        }
    }
    asm volatile("" ::: "memory");
    LAS unsigned char* vt = F.lds + h * VT_HEAD;
    {
        const int d8 = 8 * (l & 7); float gv[8];
#pragma unroll
        for (int j = 0; j < 8; ++j) gv[j] = a.in[IN_G_V][h * 64 + d8 + j];
#pragma unroll
        for (int it = 0; it < 16; ++it) { const int s = 8 * it + (l >> 3); float v[8]; unpack8(vraw[it], v);
            float sq = 0.f;
#pragma unroll
            for (int j = 0; j < 8; ++j) sq += v[j] * v[j];
            sq += __shfl_xor(sq, 1); sq += __shfl_xor(sq, 2); sq += __shfl_xor(sq, 4);
            const float rs = rsqrtf(sq * (1.f / 64.f) + EPS);
            u32x2 lo, hi; lo.x = pk2(v[0] * rs * gv[0], v[1] * rs * gv[1]); lo.y = pk2(v[2] * rs * gv[2], v[3] * rs * gv[3]); hi.x = pk2(v[4] * rs * gv[4], v[5] * rs * gv[5]); hi.y = pk2(v[6] * rs * gv[6], v[7] * rs * gv[7]);
            *(LAS u32x2*)(vt + s * VT_PITCH + d8 * 2) = lo; *(LAS u32x2*)(vt + s * VT_PITCH + d8 * 2 + 8) = hi; }
    }
    __syncthreads();
    const int fr = l & 15, fq = l >> 4, trq = (l & 15) >> 2, trp = l & 3;
    const bf16_t* wsb = (const bf16_t*)(ws + WS_WS_BF) + (size_t)h * CHUNK * CHUNK;
    const unsigned wloff = (unsigned)(fr * CHUNK + 8 * fq);
    const float* bsp = a.in[IN_B_S] + h * CHUNK;
#pragma unroll 1
    for (int half = 0; half < 2; ++half) {
        f32x4 acc[8][2];
#pragma unroll
        for (int m = 0; m < 8; ++m)
#pragma unroll
            for (int n = 0; n < 2; ++n) acc[m][n] = (f32x4){0.f, 0.f, 0.f, 0.f};
#pragma unroll
        for (int ks = 0; ks < 4; ++ks) {
            unsigned wl = wloff; asm volatile("" : "+v"(wl));
            bf16x8 af[2];
#pragma unroll
            for (int n = 0; n < 2; ++n) { const int dc = 32 * half + 16 * n + 4 * trp;
                const s16x4 lo = __builtin_bit_cast(s16x4, __builtin_amdgcn_ds_read_tr16_b64_v4i16((LAS s16x4*)(vt + (32 * ks + 8 * fq + trq) * VT_PITCH + dc * 2)));
                const s16x4 hi = __builtin_bit_cast(s16x4, __builtin_amdgcn_ds_read_tr16_b64_v4i16((LAS s16x4*)(vt + (32 * ks + 8 * fq + 4 + trq) * VT_PITCH + dc * 2)));
                af[n] = (bf16x8){lo[0], lo[1], lo[2], lo[3], hi[0], hi[1], hi[2], hi[3]}; }
#pragma unroll
            for (int m = 2 * ks; m < 8; ++m) {
                const bf16x8 bfr = *(const bf16x8*)(wsb + (16 * m * CHUNK + 32 * ks) + wl);
#pragma unroll
                for (int n = 0; n < 2; ++n) acc[m][n] = __builtin_amdgcn_mfma_f32_16x16x32_bf16(af[n], bfr, acc[m][n], 0, 0, 0);
            }
        }
#pragma unroll
        for (int m = 0; m < 8; ++m) { const float bs = bsp[16 * m + fr];
#pragma unroll
            for (int n = 0; n < 2; ++n) { const int dc = 32 * half + 16 * n + 4 * fq;
                u32x2 o; o.x = pk2(acc[m][n][0] + bs, acc[m][n][1] + bs); o.y = pk2(acc[m][n][2] + bs, acc[m][n][3] + bs);
                *(LAS u32x2*)(vt + (16 * m + fr) * VT_PITCH + dc * 2) = o; } }
    }
    asm volatile("s_waitcnt lgkmcnt(0)" ::: "memory");
    LAS float* exch = (LAS float*)(F.lds + MIX_EXCH);
    {
        const int d8 = 8 * (l & 7);
#pragma unroll
        for (int it = 0; it < 16; ++it) { const int sidx = 8 * it + (l >> 3);
            const u32x2 lo = *(const LAS u32x2*)(vt + sidx * VT_PITCH + d8 * 2), hi = *(const LAS u32x2*)(vt + sidx * VT_PITCH + d8 * 2 + 8);
            float uf[8]; unpack8(uraw[it], uf);
            const float y0 = uf[0] * bf_lo(lo.x), y1 = uf[1] * bf_hi(lo.x), y2 = uf[2] * bf_lo(lo.y), y3 = uf[3] * bf_hi(lo.y), y4 = uf[4] * bf_lo(hi.x), y5 = uf[5] * bf_hi(hi.x), y6 = uf[6] * bf_lo(hi.y), y7 = uf[7] * bf_hi(hi.y);
            float sq = ((y0 * y0 + y1 * y1) + (y2 * y2 + y3 * y3)) + ((y4 * y4 + y5 * y5) + (y6 * y6 + y7 * y7));
            sq += __shfl_xor(sq, 1); sq += __shfl_xor(sq, 2); sq += __shfl_xor(sq, 4);
            if ((l & 7) == 0) exch[h * CHUNK + sidx] = sq;
            uraw[it] = (u32x4){pk2(y0, y1), pk2(y2, y3), pk2(y4, y5), pk2(y6, y7)}; }
    }
    __syncthreads();
    {
        const int d8 = 8 * (l & 7); float gg[8];
#pragma unroll
        for (int j = 0; j < 8; ++j) gg[j] = a.in[IN_G_OUT_GMLP][h * 64 + d8 + j];
#pragma unroll
        for (int it = 0; it < 16; ++it) { const int sidx = 8 * it + (l >> 3); float tot = 0.f;
#pragma unroll
            for (int hh = 0; hh < 8; ++hh) tot += exch[hh * CHUNK + sidx];
            const float rs = rsqrtf(tot * (1.f / 512.f) + EPS);
            float yf[8]; unpack8(uraw[it], yf);
            u32x4 o; o.x = pk2(yf[0] * rs * gg[0], yf[1] * rs * gg[1]); o.y = pk2(yf[2] * rs * gg[2], yf[3] * rs * gg[3]); o.z = pk2(yf[4] * rs * gg[4], yf[5] * rs * gg[5]); o.w = pk2(yf[6] * rs * gg[6], yf[7] * rs * gg[7]);
            *(u32x4*)(Y + (size_t)(t0 + sidx) * 1024 + 512 + h * 64 + d8) = o; }
    }
}

constexpr int RT_XS_PITCH = 272;
constexpr int RT_XS_WAVE = 16 * RT_XS_PITCH;
constexpr int RT_SLAB_OFF = 8 * RT_XS_WAVE;
constexpr int RT_LG_OFF = RT_SLAB_OFF + 2 * 24576;
__device__ __forceinline__ void router_block(const Frame& F, const Args& a, int blk) {
    const int l = lane_id_fresh(), w = F.wave, fr = l & 15, fq = l >> 4, tid = w * 64 + l;
    unsigned char* ws = F.ws;
    LAS unsigned char* xs = F.lds + w * RT_XS_WAVE;
    LAS float* slab = (LAS float*)(F.lds + RT_SLAB_OFF);
    LAS float* lg = (LAS float*)(F.lds + RT_LG_OFF);
    LAS float* biasl = lg + 128 * 48;
    LAS int* histl = (LAS int*)(biasl + 64);
    __syncthreads();
    if (tid < 32) histl[tid] = 0;
    if (tid >= 64 && tid < 64 + 36) { const int n = tid - 64; biasl[n] = n < 4 ? a.in[IN_B_GRP][n] : a.in[IN_B_RT][n - 4]; }
    bf16x8 bh[4][3], bl[4][3];
    { const bf16_t* wh = (const bf16_t*)(ws + WS_WR) + (size_t)fr * 1024 + 128 * w + 8 * fq; const bf16_t* wl = wh + 48 * 1024;
#pragma unroll
      for (int ks = 0; ks < 4; ++ks)
#pragma unroll
          for (int nt = 0; nt < 3; ++nt) { bh[ks][nt] = *(const bf16x8*)(wh + (size_t)nt * 16 * 1024 + 32 * ks); bl[ks][nt] = *(const bf16x8*)(wl + (size_t)nt * 16 * 1024 + 32 * ks); } }
    const bf16_t* xg = (const bf16_t*)(ws + WS_X2B) + (size_t)(blk * 128 + fq) * D + 128 * w + 8 * fr;
    u32x4 bufA[4], bufB[4];
#define RT_LOAD(buf, tg) do { _Pragma("unroll") for (int j = 0; j < 4; ++j) buf[j] = *(const u32x4*)(xg + (size_t)(16 * (tg) + 4 * j) * D); } while (0)
#define RT_GROUP(buf, tg) do { \
        float sq[4]; \
        _Pragma("unroll") for (int j = 0; j < 4; ++j) { const u32x4 v = buf[j]; float f[8]; unpack8(v, f); \
            sq[j] = ((f[0] * f[0] + f[1] * f[1]) + (f[2] * f[2] + f[3] * f[3])) + ((f[4] * f[4] + f[5] * f[5]) + (f[6] * f[6] + f[7] * f[7])); \
            *(LAS u32x4*)(xs + (4 * j + fq) * RT_XS_PITCH + 16 * fr) = v; } \
        asm volatile("s_waitcnt lgkmcnt(0)" ::: "memory"); \
        f32x4 acc[3] = {(f32x4){0.f, 0.f, 0.f, 0.f}, (f32x4){0.f, 0.f, 0.f, 0.f}, (f32x4){0.f, 0.f, 0.f, 0.f}}; \
        _Pragma("unroll") for (int ks = 0; ks < 4; ++ks) { \
            const bf16x8 ah = *(const LAS bf16x8*)(xs + fr * RT_XS_PITCH + (32 * ks + 8 * fq) * 2); \
            _Pragma("unroll") for (int nt = 0; nt < 3; ++nt) { \
                acc[nt] = __builtin_amdgcn_mfma_f32_16x16x32_bf16(ah, bh[ks][nt], acc[nt], 0, 0, 0); \
                acc[nt] = __builtin_amdgcn_mfma_f32_16x16x32_bf16(ah, bl[ks][nt], acc[nt], 0, 0, 0); } } \
        LAS float* sl = slab + ((tg) & 1) * 6144 + w * 768;                    \
        _Pragma("unroll") for (int nt = 0; nt < 3; ++nt) { if (nt < 2 || fr < 4) { _Pragma("unroll") for (int r = 0; r < 4; ++r) sl[(4 * fq + r) * 48 + 16 * nt + fr] = acc[nt][r]; } } \
        _Pragma("unroll") for (int j = 0; j < 4; ++j) { float v = sq[j]; \
            _Pragma("unroll") for (int o = 1; o < 16; o <<= 1) v += __shfl_xor(v, o); \
            if (fr == 0) sl[(4 * j + fq) * 48 + 36] = v; } \
        asm volatile("s_waitcnt lgkmcnt(0)" ::: "memory"); __builtin_amdgcn_s_barrier(); asm volatile("" ::: "memory"); \
        for (int o = tid; o < 16 * 37; o += NTHREADS) { const int tk = o / 37, c = o - tk * 37; const LAS float* sp = slab + ((tg) & 1) * 6144 + tk * 48 + c; \
            float s8 = 0.f; _Pragma("unroll") for (int ww = 0; ww < 8; ++ww) s8 += sp[ww * 768]; lg[(16 * (tg) + tk) * 48 + c] = s8; } \
    } while (0)
    RT_LOAD(bufA, 0);
#pragma unroll 1
    for (int tg = 0; tg < 8; tg += 2) {
        RT_LOAD(bufB, tg + 1);
        RT_GROUP(bufA, tg);
        if (tg + 2 < 8) RT_LOAD(bufA, tg + 2);
        RT_GROUP(bufB, tg + 1);
    }
#undef RT_LOAD
#undef RT_GROUP
    __syncthreads();
    if (tid < 128) {
        const int tl = tid, t = blk * 128 + tl; const LAS float* L = lg + tl * 48; const float rs = rsqrtf(L[36] * (1.f / 1024.f) + EPS);
        float g4[4];
#pragma unroll
        for (int i = 0; i < 4; ++i) g4[i] = L[i] * rs + biasl[i];
        int g = 0; float mx = g4[0];
#pragma unroll
        for (int i = 1; i < 4; ++i) if (g4[i] > mx) { mx = g4[i]; g = i; }
        float den = 0.f;
#pragma unroll
        for (int i = 0; i < 4; ++i) den += __expf(g4[i] - mx);
        const float gp = 1.f / den;
        float e8[8];
#pragma unroll
        for (int i = 0; i < 8; ++i) e8[i] = L[4 + g * 8 + i] * rs + biasl[4 + g * 8 + i];
        int i0 = 0; float v0 = e8[0];
#pragma unroll
        for (int i = 1; i < 8; ++i) if (e8[i] > v0) { v0 = e8[i]; i0 = i; }
        int i1 = -1; float v1 = -3.0e38f;
#pragma unroll
        for (int i = 0; i < 8; ++i) if (i != i0 && e8[i] > v1) { v1 = e8[i]; i1 = i; }
        const float ex = __expf(v1 - v0);
        const float g0 = gp / (1.f + ex), g1 = gp * ex / (1.f + ex);
        const int ex0 = g * 8 + i0, ex1 = g * 8 + i1;
        const int r0 = __hip_atomic_fetch_add((int*)(histl + ex0), 1, __ATOMIC_RELAXED, __HIP_MEMORY_SCOPE_WORKGROUP), r1 = __hip_atomic_fetch_add((int*)(histl + ex1), 1, __ATOMIC_RELAXED, __HIP_MEMORY_SCOPE_WORKGROUP);
        *(int2*)((int*)(ws + RT_TOK_E) + 2 * t) = make_int2(ex0, ex1); *(float2*)((float*)(ws + RT_TOK_G) + 2 * t) = make_float2(g0, g1);
        *(int2*)((int*)(ws + RT_TOK_R) + 2 * t) = make_int2(r0, r1); ((float*)(ws + RT_RS2))[t] = rs;
    }
    __syncthreads();
    if (tid < 32) ((int*)(ws + RT_HIST))[blk * 32 + tid] = histl[tid];
}
__device__ __forceinline__ void assign_block(const Frame& F, const Args& a, int blk) {
    const int l = lane_id_fresh(), w = F.wave, tid = w * 64 + l;
    unsigned char* ws = F.ws;
    LAS int* ptot = (LAS int*)F.lds;
    LAS int* ppre = ptot + 512;
    LAS int* base = ppre + 512;
    LAS int* ebase = base + 32;
    __syncthreads();
    { const int e = tid & 31, part = tid >> 5; const int* H = (const int*)(ws + RT_HIST); int st = 0, sp = 0; int hv[16];
#pragma unroll
      for (int i = 0; i < 16; ++i) hv[i] = H[(part * 16 + i) * 32 + e];
#pragma unroll
      for (int i = 0; i < 16; ++i) { st += hv[i]; sp += (part * 16 + i < blk) ? hv[i] : 0; }
      ptot[part * 32 + e] = st; ppre[part * 32 + e] = sp; }
    __syncthreads();
    if (tid < 32) { int st = 0, sp = 0; for (int p = 0; p < 16; ++p) { st += ptot[p * 32 + tid]; sp += ppre[p * 32 + tid]; } ptot[tid] = st; ppre[tid] = sp; }
    __syncthreads();
    if (tid == 0) { int run = 0;
        for (int e = 0; e < 32; ++e) { base[e] = run * 256 + ppre[e]; ebase[e] = run * 256 + ptot[e]; ebase[64 + e] = run; run += (ptot[e] + 255) >> 8; ebase[32 + e] = run * 256; }
        if (blk == 0) ((int*)(ws + RT_TILE_E))[0] = run; }
    __syncthreads();
    if (blk == 0 && tid < 32) { int* te = (int*)(ws + RT_TILE_E); const int r0 = ebase[64 + tid], nt = (ebase[32 + tid] >> 8) - r0; for (int i = 0; i < nt; ++i) te[16 + r0 + i] = tid; }
    int* tos = (int*)(ws + RT_TOK_OF_SLOT); float* rss = (float*)(ws + RT_RS_SLOT); float* gts = (float*)(ws + RT_GATE_SLOT);
    if (tid < 256) { const int t = blk * 128 + (tid >> 1), k = tid & 1;
        const int e = ((const int*)(ws + RT_TOK_E))[2 * t + k], r = ((const int*)(ws + RT_TOK_R))[2 * t + k];
        const int slot = base[e] + r;
        ((int*)(ws + RT_SLOT_OF))[2 * t + k] = slot; tos[slot] = t; rss[slot] = ((const float*)(ws + RT_RS2))[t]; gts[slot] = ((const float*)(ws + RT_TOK_G))[2 * t + k]; }
    if (blk < 32) {
        for (int sl = ebase[blk] + tid; sl < ebase[32 + blk]; sl += NTHREADS) { tos[sl] = 0; rss[sl] = 0.f; gts[sl] = 0.f; } }
}
__device__ __forceinline__ void combine_rows(const Frame& F, const Args& a, float* outp) {
    const int l = lane_id_fresh();
    unsigned char* ws = F.ws;
    const int gw = F.vcu * NWAVES + F.wave, NGW = F.G * NWAVES;
    const f32x4* gfin = (const f32x4*)a.in[IN_G_FINAL] + l;
    f32x4 gf4[4];
#pragma unroll
    for (int j = 0; j < 4; ++j) gf4[j] = gfin[64 * j];
    const int* slot_of = (const int*)(ws + RT_SLOT_OF); const bf16_t* Y = (const bf16_t*)(ws + WS_YSLOT); const bf16_t* XB = (const bf16_t*)(ws + WS_X2B);
    for (int t = gw; t < T; t += 2 * NGW) {
        const int tb = t + NGW; const bool hb = tb < T; const int t2 = hb ? tb : t;
        const int2 sa = *(const int2*)(slot_of + 2 * t), sb = *(const int2*)(slot_of + 2 * t2);
        const u32x2* xa = (const u32x2*)(XB + (size_t)t * D) + l; const u32x2* xb = (const u32x2*)(XB + (size_t)t2 * D) + l;
        const u32x2* ya0 = (const u32x2*)(Y + (size_t)sa.x * D) + l; const u32x2* ya1 = (const u32x2*)(Y + (size_t)sa.y * D) + l;
        const u32x2* yb0 = (const u32x2*)(Y + (size_t)sb.x * D) + l; const u32x2* yb1 = (const u32x2*)(Y + (size_t)sb.y * D) + l;
        f32x4 va[4], vb[4]; u32x2 ra[4], pa[4], qa[4], rb[4], pb[4], qb[4];
#pragma unroll
        for (int j = 0; j < 4; ++j) { ra[j] = __builtin_nontemporal_load(xa + 64 * j); pa[j] = __builtin_nontemporal_load(ya0 + 64 * j); qa[j] = __builtin_nontemporal_load(ya1 + 64 * j); rb[j] = __builtin_nontemporal_load(xb + 64 * j); pb[j] = __builtin_nontemporal_load(yb0 + 64 * j); qb[j] = __builtin_nontemporal_load(yb1 + 64 * j); }
        float sqa = 0.f, sqb = 0.f;
#pragma unroll
        for (int j = 0; j < 4; ++j) {
            va[j].x = bf_lo(ra[j].x) + bf_lo(pa[j].x) + bf_lo(qa[j].x); va[j].y = bf_hi(ra[j].x) + bf_hi(pa[j].x) + bf_hi(qa[j].x); va[j].z = bf_lo(ra[j].y) + bf_lo(pa[j].y) + bf_lo(qa[j].y); va[j].w = bf_hi(ra[j].y) + bf_hi(pa[j].y) + bf_hi(qa[j].y);
            vb[j].x = bf_lo(rb[j].x) + bf_lo(pb[j].x) + bf_lo(qb[j].x); vb[j].y = bf_hi(rb[j].x) + bf_hi(pb[j].x) + bf_hi(qb[j].x); vb[j].z = bf_lo(rb[j].y) + bf_lo(pb[j].y) + bf_lo(qb[j].y); vb[j].w = bf_hi(rb[j].y) + bf_hi(pb[j].y) + bf_hi(qb[j].y);
            sqa += (va[j].x * va[j].x + va[j].y * va[j].y) + (va[j].z * va[j].z + va[j].w * va[j].w); sqb += (vb[j].x * vb[j].x + vb[j].y * vb[j].y) + (vb[j].z * vb[j].z + vb[j].w * vb[j].w); }
        const float rsa = rsqrtf(wave_sum(sqa) * (1.f / 1024.f) + EPS), rsb = rsqrtf(wave_sum(sqb) * (1.f / 1024.f) + EPS);
        f32x4* oa = (f32x4*)(outp + (size_t)t * D) + l; f32x4* ob = (f32x4*)(outp + (size_t)t2 * D) + l;
#pragma unroll
        for (int j = 0; j < 4; ++j) { __builtin_nontemporal_store(va[j] * rsa * gf4[j], oa + 64 * j); if (hb) __builtin_nontemporal_store(vb[j] * rsb * gf4[j], ob + 64 * j); }
    }
}

#define XB_TMO      128
#define XB_XCNT(j)  (256  + 64 * (j))
#define XB_XSUB(j)  (1280 + 64 * (j))
#define XB_XGEN(j)  (2304 + 64 * (j))
#define XB_TOP      3328
#define XB_TOPGEN   3392
#define XCD_BAR_WORDS 3456
#define XB_SPIN_CAP (1u << 20)
__device__ __forceinline__ unsigned xb_ld(unsigned* p)              { return __hip_atomic_load(p, __ATOMIC_RELAXED, __HIP_MEMORY_SCOPE_AGENT); }
__device__ __forceinline__ unsigned xb_add(unsigned* p, unsigned v) { return __hip_atomic_fetch_add(p, v, __ATOMIC_RELAXED, __HIP_MEMORY_SCOPE_AGENT); }
__device__ __forceinline__ unsigned xb_xcc_id() { return (unsigned)__builtin_amdgcn_s_getreg((3 << 11) | 20) & 0xFu; }
#define XB_SPIN(cond, bar) do { unsigned _sp = 0; while (cond) { __builtin_amdgcn_s_sleep(1); \
    if ((++_sp & 255u) == 0u) { if (xb_ld(&(bar)[XB_TMO])) break; if (_sp > XB_SPIN_CAP) { atomicAdd(&(bar)[XB_TMO], 1u); break; } } } } while (0)
struct XcdBarrier { unsigned* bar; unsigned x; volatile LAS unsigned* st; };
__device__ __forceinline__ XcdBarrier xcd_barrier_post(unsigned* bar, volatile LAS unsigned* st) {
    XcdBarrier b; b.bar = bar; b.x = xb_xcc_id(); b.st = st;
    if (threadIdx.x == 0) (void)xb_add(&bar[XB_XCNT(b.x)], 1u);
    return b;
}
__device__ __forceinline__ void xcd_barrier_complete(unsigned* bar, unsigned x, unsigned& nloc, unsigned& nx) {
    const unsigned G = gridDim.x * gridDim.y * gridDim.z;
    unsigned sum, cnt, mine, sp = 0u;
    for (;;) {
        sum = 0u; cnt = 0u; mine = 0u;
#pragma unroll
        for (unsigned j = 0; j < 16; ++j) { const unsigned c = xb_ld(&bar[XB_XCNT(j)]); sum += c; cnt += (c > 0u) ? 1u : 0u; mine = (j == x) ? c : mine; }
        if (sum == G) break;
        __builtin_amdgcn_s_sleep(1);
        if ((++sp & 255u) == 0u) { if (xb_ld(&bar[XB_TMO])) break; if (sp > XB_SPIN_CAP) { atomicAdd(&bar[XB_TMO], 1u); break; } }
    }
    nloc = mine > 0u ? mine : 1u; nx = cnt > 0u ? cnt : 1u;
}
__device__ __forceinline__ void xcd_barrier(const XcdBarrier& b, const int wave) {
    asm volatile("s_waitcnt vmcnt(0)" ::: "memory");
    __syncthreads();
    if (wave == 0 && lane_id_fresh() == 0) {
        unsigned* bar = b.bar;
        __builtin_amdgcn_s_waitcnt(0);
        unsigned nloc = b.st[0], nx = b.st[1];
        if (nloc == 0u) { xcd_barrier_complete(bar, b.x, nloc, nx); b.st[0] = nloc; b.st[1] = nx; }
        const unsigned old = xb_add(&bar[XB_XSUB(b.x)], 1u);
        const unsigned gen = old / nloc;
        if (old + 1u == (gen + 1u) * nloc) {
            __builtin_amdgcn_fence(__ATOMIC_RELEASE, "agent");
            asm volatile("s_waitcnt vmcnt(0)" ::: "memory");
            const unsigned og = xb_add(&bar[XB_TOP], 1u);
            const unsigned tg = og / nx;
            if (og + 1u == (tg + 1u) * nx) xb_add(&bar[XB_TOPGEN], 1u);
            else XB_SPIN(xb_ld(&bar[XB_TOPGEN]) == tg, bar);
            __builtin_amdgcn_fence(__ATOMIC_ACQUIRE, "agent");
            xb_add(&bar[XB_XGEN(b.x)], 1u);
            asm volatile("s_waitcnt vmcnt(0)" ::: "memory");
        } else {
            XB_SPIN(xb_ld(&bar[XB_XGEN(b.x)]) == gen, bar);
            __builtin_amdgcn_fence(__ATOMIC_ACQUIRE, "agent");
            asm volatile("s_waitcnt vmcnt(0)" ::: "memory");
        }
    }
    __syncthreads();
}

__global__ void __launch_bounds__(NTHREADS, 2) mk_fwd(Args args) {
    extern __shared__ __attribute__((aligned(16))) unsigned char lds_raw[];
    Frame F;
    F.lds = (LAS unsigned char*)lds_raw;
    F.wave = __builtin_amdgcn_readfirstlane((int)threadIdx.x >> 6);
    F.G = gridDim.x; { const int bx = blockIdx.x; F.vcu = (F.G % 8 == 0) ? (bx % 8) * (F.G / 8) + bx / 8 : bx; }
    F.ws = args.ws; F.out = args.out;
    unsigned char* ws = args.ws;
    const int lo = args.ph_lo, hi = args.ph_hi;
    if (threadIdx.x < 64) ((LAS unsigned*)(F.lds + LDS_MISC))[threadIdx.x] = 0u;
    __syncthreads();
    XcdBarrier xbar; xbar.bar = (unsigned*)(ws + WS_CTL) + 4096; xbar.x = 0; xbar.st = nullptr;
    if (hi - lo > 1) xbar = xcd_barrier_post((unsigned*)(ws + WS_CTL) + 4096, (volatile LAS unsigned*)(F.lds + LDS_MISC) + 8);
#define IN(k) (lo <= (k) && (k) < hi)
#define SEAM(k) do { if (IN(k) && IN((k) + 1)) xcd_barrier(xbar, F.wave); } while (0)
    if (IN(0)) p0_prologue(F, args);
    SEAM(0);
    if (IN(1)) {
        { pg8::DenseOrder S; S.init(T, INC, F.G, (int)blockIdx.x, ws + WS_HB, D, ws + WS_WIN_T, D);
          EpiInProj E{(bf16_t*)(ws + WS_GB), (bf16_t*)(ws + WS_Z), (bf16_t*)(ws + WS_UG), (bf16_t*)(ws + WS_VG)};
          pg8::gemm_phase<D, D, D>(F.lds, F.wave, S, E); }
        { pg8::DenseOrder S; S.init(B * ML, 2 * D, F.G, (int)blockIdx.x, ws + WS_MEMN, D, ws + WS_WKV_T, D);
          EpiBf16 E{(bf16_t*)(ws + WS_KV), 2 * D};
          pg8::gemm_phase<D, D, D>(F.lds, F.wave, S, E); }
    }
    SEAM(1);
    if (IN(2)) {
        for (int ch = F.vcu; ch < T / CHUNK; ch += F.G) mixer_unit(F, args, ch);
    }
    SEAM(2);
    if (IN(3)) {
        { WqkOrder S{F.G, (int)blockIdx.x, (const char*)(ws + WS_KV), (const char*)(ws + WS_WQ_NAT)}; EpiBf16Aux E{(bf16_t*)(ws + WS_WQK_T), 1024};
          pg8::gemm_phase<2 * D, D, XD>(F.lds, F.wave, S, E); }
        { VwOrder S{F.G, (int)((blockIdx.x + F.G / 2) % F.G), (const char*)(ws + WS_KV), (const char*)(ws + WS_WO_T)}; EpiBf16Aux E{(bf16_t*)(ws + WS_VW_T), 1024};
          pg8::gemm_phase<D, 2 * D, XD>(F.lds, F.wave, S, E); }
        pg8::DenseOrder S; S.init(T, D, F.G, (int)blockIdx.x, ws + WS_Y, D, ws + WS_WOUT_T, D);
        EpiResidA E{args.in[IN_X], (bf16_t*)(ws + WS_X1B), (float*)(ws + WS_SSQ1)};
        pg8::gemm_phase<D, D, D>(F.lds, F.wave, S, E);
    }
    SEAM(3);
    if (IN(4)) {
        pg8::DenseOrder S; S.init(T, D, F.G, (int)blockIdx.x, ws + WS_X1B, D, ws + WS_WQK_T, D, S_TILES, (size_t)D * D * 2);
        EpiSoftmax E{(const float*)(ws + WS_SSQ1), (bf16_t*)(ws + WS_P)};
        pg8::gemm_phase<D, D, D>(F.lds, F.wave, S, E);
    }
    SEAM(4);
    if (IN(5)) {
        pg8::DenseOrder S; S.init(T, D, F.G, (int)blockIdx.x, ws + WS_P, D, ws + WS_VW_T, D, S_TILES, (size_t)D * D * 2);
        EpiResidB E{(const bf16_t*)(ws + WS_X1B), (bf16_t*)(ws + WS_X2B)};
        pg8::gemm_phase<D, D, D>(F.lds, F.wave, S, E);
    }
    SEAM(5);
    if (IN(6)) { for (int blk = F.vcu; blk < T / 128; blk += F.G) router_block(F, args, blk); }
    SEAM(6);
    if (IN(7)) { for (int blk = F.vcu; blk < T / 128; blk += F.G) assign_block(F, args, blk); }
    SEAM(7);
    if (IN(8)) {
        GroupedOrder S; S.init(F.G, (int)blockIdx.x, (const int*)(ws + RT_TILE_E), ws + WS_X2B, D, ws + WS_WGU_T, D, (size_t)1024 * 1024 * 2, true);
        EpiSwiGLU E{(bf16_t*)(ws + WS_HID), (const float*)(ws + RT_RS_SLOT)};
        pg8::gemm_phase<D, D, D, true>(F.lds, F.wave, S, E, (const int*)(ws + RT_TOK_OF_SLOT));
    }
    SEAM(8);
    if (IN(9)) {
        GroupedOrder S; S.init(F.G, (int)blockIdx.x, (const int*)(ws + RT_TILE_E), ws + WS_HID, DE, ws + WS_WD_T, DE, (size_t)1024 * 512 * 2);
        EpiDown E{(bf16_t*)(ws + WS_YSLOT), (const float*)(ws + RT_GATE_SLOT)};
        pg8::gemm_phase<DE, DE, DE>(F.lds, F.wave, S, E);
    }
    SEAM(9);
    if (IN(10)) { combine_rows(F, args, F.out); }
#undef IN
#undef SEAM
}
extern "C" void kernel_launch(void* const* d_in, const int* in_sizes, int n_in, void* d_out, int out_size, void* d_ws, size_t ws_size, hipStream_t stream) {
    if (n_in != 26 || out_size != T * D || ws_size < 500 * MiB) { fprintf(stderr, "kernel_launch: unexpected shapes n_in %d out %d ws %zu\n", n_in, out_size, ws_size); return; }
    float* xres = (float*)d_out;
    static int grid = 0;
    if (grid == 0) {
        int dev = 0, cus = 0, per_cu = 0;
        if (hipGetDevice(&dev) != hipSuccess || hipDeviceGetAttribute(&cus, hipDeviceAttributeMultiprocessorCount, dev) != hipSuccess) { fprintf(stderr, "kernel_launch: device query failed\n"); grid = -1; return; }
        if (hipFuncSetAttribute((const void*)mk_fwd, hipFuncAttributeMaxDynamicSharedMemorySize, LDS_BYTES) != hipSuccess) { fprintf(stderr, "kernel_launch: hipFuncSetAttribute failed\n"); grid = -1; return; }
        if (hipOccupancyMaxActiveBlocksPerMultiprocessor(&per_cu, (const void*)mk_fwd, NTHREADS, LDS_BYTES) != hipSuccess || per_cu < 1) { fprintf(stderr, "kernel_launch: occupancy query says %d blocks per CU\n", per_cu); (void)hipGetLastError(); grid = -1; return; }
        grid = cus;
        if (grid != 256) fprintf(stderr, "kernel_launch: note: %d CUs (built and tuned for 256)\n", grid);
    }
    if (grid < 0) return;
    Args a{};
    for (int i = 0; i < 26; ++i) a.in[i] = (const float*)d_in[i];
    a.out = xres; a.ws = (unsigned char*)d_ws;
    if (hipMemsetAsync((char*)d_ws + WS_CTL + 4096 * 4, 0, XCD_BAR_WORDS * 4, stream) != hipSuccess) { fprintf(stderr, "kernel_launch: memset failed\n"); return; }
#if defined(MK_PER_PHASE)
    for (int ph = 0; ph < 11; ++ph) { a.ph_lo = ph; a.ph_hi = ph + 1; hipLaunchKernelGGL(mk_fwd, dim3(grid), dim3(NTHREADS), LDS_BYTES, stream, a); }
#else
    a.ph_lo = 0; a.ph_hi = 11;
    hipLaunchKernelGGL(mk_fwd, dim3(grid), dim3(NTHREADS), LDS_BYTES, stream, a);
    const hipError_t le = hipPeekAtLastError();
    if (le != hipSuccess) fprintf(stderr, "kernel_launch: launch failed: %s (grid %d)\n", hipGetErrorString(le), grid);
#endif
}
```

```cpp
#include <hip/hip_runtime.h>
#include <cstdint>
#include <cstdio>

namespace cfg {
constexpr int D = 1024, B = 8, S = 4096, T = B * S;
constexpr int CW = 512, GW = 512, NH = 8, HD = 64, CHUNK = 128, INC = 2560;
constexpr int ML = 256, XH = 4, XD = 256;
constexpr int NG = 4, EPG = 8, NE = 32, DE = 512;
constexpr float EPS = 1e-6f;
}
constexpr size_t MiB = 1u << 20;
using namespace cfg;

#define LAS __attribute__((address_space(3)))
#define GAS __attribute__((address_space(1)))
typedef unsigned short bf16_t;
typedef short bf16x8 __attribute__((ext_vector_type(8)));
typedef short s16x4 __attribute__((ext_vector_type(4)));
typedef float f32x4 __attribute__((ext_vector_type(4)));
typedef float f32x2 __attribute__((ext_vector_type(2)));
typedef unsigned u32x4 __attribute__((ext_vector_type(4)));
typedef unsigned u32x2 __attribute__((ext_vector_type(2)));

constexpr int NWAVES = 8, NTHREADS = 512;
constexpr int S_TILES = cfg::S / 256;
constexpr int LDS_BYTES = 147456;
constexpr int LDS_STAGE = 131072;
constexpr int LDS_EXCH = 131072;
constexpr int LDS_MISC = LDS_BYTES - 256;

constexpr size_t WS_CTL = 0;
constexpr size_t WS_WIN_T = 1 * MiB;
constexpr size_t WS_WOUT_T = 6 * MiB;
constexpr size_t WS_WQ_NAT = 8 * MiB;
constexpr size_t WS_WO_T = 10 * MiB;
constexpr size_t WS_WKV_T = 12 * MiB;
constexpr size_t WS_WS_BF = 16 * MiB;
constexpr size_t WS_MEMN = 17 * MiB;
constexpr size_t WS_KV = 21 * MiB;
constexpr size_t WS_WQK_T = 29 * MiB;
constexpr size_t WS_VW_T = 45 * MiB;
constexpr size_t WS_WGU_T = 61 * MiB;
constexpr size_t WS_WD_T = 125 * MiB;
constexpr size_t WS_WR = 157 * MiB;
constexpr size_t WS_SSQ1 = 158 * MiB;
constexpr size_t WS_ROUTE = 160 * MiB;
constexpr size_t WS_ACT0 = 164 * MiB;
constexpr size_t WS_ACT1 = 228 * MiB;
constexpr size_t WS_GB = WS_ACT1, WS_Z = WS_ACT1 + 32 * MiB, WS_UG = WS_ACT1 + 64 * MiB, WS_VG = WS_ACT1 + 96 * MiB;
constexpr size_t WS_X2B = WS_ACT1 + 64 * MiB;
constexpr size_t WS_HID = WS_ACT0;
constexpr size_t WS_YSLOT = 356 * MiB;
constexpr size_t RT_TOK_E = WS_ROUTE, RT_TOK_G = WS_ROUTE + 256 * 1024, RT_RS2 = WS_ROUTE + 512 * 1024, RT_TOK_R = WS_ROUTE + 640 * 1024, RT_HIST = WS_ROUTE + 896 * 1024,
                 RT_SLOT_OF = WS_ROUTE + 1024 * 1024, RT_GATE_SLOT = WS_ROUTE + 1536 * 1024, RT_TILE_E = WS_ROUTE + 2048 * 1024,
                 RT_TOK_OF_SLOT = WS_ROUTE + 2304 * 1024, RT_RS_SLOT = WS_ROUTE + 2816 * 1024;
constexpr int MAX_TILES = 288;
constexpr size_t WS_HB = WS_ACT0, WS_Y = WS_ACT0, WS_P = WS_ACT0, WS_X1B = WS_ACT1;

__device__ __forceinline__ unsigned f2bf(float f) { unsigned u = __builtin_bit_cast(unsigned, f); return (u + 0x7fffu + ((u >> 16) & 1u)) >> 16; }
__device__ __forceinline__ unsigned pk2(float lo, float hi) { unsigned r; asm("v_cvt_pk_bf16_f32 %0, %1, %2" : "=v"(r) : "v"(lo), "v"(hi)); return r; }
__device__ __forceinline__ unsigned cvt_pk_bf16(float lo, float hi) { unsigned r; asm volatile("v_cvt_pk_bf16_f32 %0, %1, %2" : "=v"(r) : "v"(lo), "v"(hi)); return r; }
__device__ __forceinline__ float bf_lo(unsigned w) { return __uint_as_float(w << 16); }
__device__ __forceinline__ float bf_hi(unsigned w) { return __uint_as_float(w & 0xffff0000u); }
__device__ __forceinline__ float wave_sum(float v) {
#pragma unroll
    for (int o = 1; o < 64; o <<= 1) v += __shfl_xor(v, o);
    return v;
}
__device__ __forceinline__ float gelu_fast(float x) {
    const float t = x * (1.0f + 0.044715f * x * x) * 2.302208198f;
    return x * __builtin_amdgcn_rcpf(1.0f + __builtin_amdgcn_exp2f(-t));
}
__device__ __forceinline__ int lane_id_fresh() { int l; asm volatile("v_mbcnt_lo_u32_b32 %0, -1, 0\n\tv_mbcnt_hi_u32_b32 %0, -1, %0" : "=v"(l)); return l; }
#define LDS_WAIT() asm volatile("s_waitcnt lgkmcnt(0)" ::: "memory")
#define VM_WAIT() asm volatile("s_waitcnt vmcnt(0)" ::: "memory")

namespace pg8 {
constexpr int BM = 256, BK = 64, HALF = 128, HTB = HALF * BK * 2, STAGE_BYTES = 8 * HTB, NXCD = 8, WGM = 8;
__host__ __device__ __forceinline__ int lds_byte(int r, int c) { const int st = (r >> 4) * 2 + (c >> 5), rr = r & 15, cc = c & 31, ob = rr * 64 + cc * 2; return st * 1024 + (ob ^ (((ob >> 9) & 1) << 5)); }
__host__ __device__ __forceinline__ void stage_rc(int b, int& R, int& C) { const int st = b / 1024, sb = b % 1024, swz = sb ^ (((sb >> 9) & 1) << 5); R = (st >> 1) * 16 + swz / 64; C = (st & 1) * 32 + (swz % 64) / 2; }
__host__ __device__ __forceinline__ int perm32(int rho) { const int n = rho >> 4, i = rho & 15; return 8 * (i >> 2) + 4 * n + (i & 3); }

__device__ __forceinline__ const char* uni(const char* p) { const unsigned long long v = (unsigned long long)p;
    const unsigned lo = __builtin_amdgcn_readfirstlane((unsigned)v), hi = __builtin_amdgcn_readfirstlane((unsigned)(v >> 32)); return (const char*)(((unsigned long long)hi << 32) | lo); }
struct Unit { int pm, pn, aux; const char* a; const char* b; };

typedef f32x4 Acc[2][2][4][2];

template <int lda, int ldb, int K, bool GATHER = false, class Epi, class Sched>
__device__ __forceinline__ void gemm_phase(LAS unsigned char* lds, const int wid, const Sched& S, const Epi& E, const int* gidx = nullptr) {
    const int lane = lane_id_fresh(), tid = wid * 64 + lane, wr = wid >> 2, wc = wid & 3, fr = lane & 15, fq = lane >> 4;
    constexpr int nt = K / BK;
    unsigned voffA, voffB;
    { int R, C; stage_rc(tid * 16, R, C); const int Rb = (R & ~31) + perm32(R & 31); voffA = (unsigned)(R * lda + C) * 2u; voffB = (unsigned)(Rb * ldb + C) * 2u; }
    constexpr size_t pstepA = (size_t)64 * lda * 2, pstepB = (size_t)64 * ldb * 2;
    constexpr size_t kstep = (size_t)(BK * 2);
    constexpr size_t hstepA = (size_t)HALF * lda * 2, hstepB = (size_t)HALF * ldb * 2;
    const unsigned ldsw = (unsigned)wid * 1024u;
    const int aoff = lds_byte(wr * 64 + fr, fq * 8), boff = lds_byte(wc * 32 + fr, fq * 8);
#define PG8_SA(b, h) (((b) * 2 + (h)) * HTB)
#define PG8_SB(b, h) ((4 + (b) * 2 + (h)) * HTB)
#define PG8_STAGE(bufoff, gbase, X) do { _Pragma("unroll") for (int _i = 0; _i < 2; ++_i) \
        __builtin_amdgcn_global_load_lds((const unsigned*)(uni((const char*)(gbase) + (size_t)_i * pstep##X) + voff##X), (LAS unsigned*)(lds + (bufoff) + ldsw + _i * 8192), 16, 0, 0); } while (0)
#define PG8_STAGE_A(bufoff, kp, h, OFF) do { _Pragma("unroll") for (int _i = 0; _i < 2; ++_i) { \
        if constexpr (GATHER) __builtin_amdgcn_global_load_lds((const unsigned*)(uni((const char*)(kp)) + OFF[h][_i]), (LAS unsigned*)(lds + (bufoff) + ldsw + _i * 8192), 16, 0, 0); \
        else __builtin_amdgcn_global_load_lds((const unsigned*)(uni((const char*)(kp) + (size_t)(h) * hstepA + (size_t)_i * pstepA) + voffA), (LAS unsigned*)(lds + (bufoff) + ldsw + _i * 8192), 16, 0, 0); } } while (0)
#define PG8_LDA(dst, b, h) do { _Pragma("unroll") for (int m = 0; m < 4; ++m) _Pragma("unroll") for (int k = 0; k < 2; ++k) dst[m][k] = *(const LAS bf16x8*)(lds + PG8_SA(b, h) + aoff + m * 2048 + k * 1024); } while (0)
#define PG8_LDB(dst, b, h) do { _Pragma("unroll") for (int n = 0; n < 2; ++n) _Pragma("unroll") for (int k = 0; k < 2; ++k) dst[n][k] = *(const LAS bf16x8*)(lds + PG8_SB(b, h) + boff + n * 2048 + k * 1024); } while (0)
#define PG8_MMA(ai, bj, At, Bt) do { __builtin_amdgcn_s_setprio(1); _Pragma("unroll") for (int m = 0; m < 4; ++m) _Pragma("unroll") for (int n = 0; n < 2; ++n) _Pragma("unroll") for (int k = 0; k < 2; ++k) \
        acc[ai][bj][m][n] = __builtin_amdgcn_mfma_f32_16x16x32_bf16(Bt[n][k], At[m][k], acc[ai][bj][m][n], 0, 0, 0); __builtin_amdgcn_s_setprio(0); } while (0)
#define PG8_WAIT_V(n) asm volatile("s_waitcnt vmcnt(" #n ")" ::: "memory")
#define PG8_WAIT_L(n) asm volatile("s_waitcnt lgkmcnt(" #n ")" ::: "memory")
#define PG8_BAR __builtin_amdgcn_s_barrier()
#define PG8_SCHED __builtin_amdgcn_sched_barrier(0)
    Unit cur, nxt; int ui = 0;
    if (!S.next(0, cur)) return;
    Acc acc;
#pragma unroll
    for (int a = 0; a < 2; ++a)
#pragma unroll
        for (int b = 0; b < 2; ++b)
#pragma unroll
            for (int m = 0; m < 4; ++m)
#pragma unroll
                for (int n = 0; n < 2; ++n) acc[a][b][m][n] = (f32x4){0.f, 0.f, 0.f, 0.f};
    bf16x8 At[4][2], B0[2][2], B1[2][2];
    const char* cA = cur.a; const char* cB = cur.b;
    unsigned go[2][2], gn[2][2];
    LAS const unsigned* lidx = (LAS const unsigned*)(lds + STAGE_BYTES);
    if constexpr (GATHER) {
        { Unit uu; for (int i = 0; S.next(i, uu); ++i) if (tid < 256) ((LAS unsigned*)lidx)[i * 256 + tid] = (unsigned)gidx[uu.pm * 256 + tid] * (unsigned)(lda * 2); }
        asm volatile("s_waitcnt vmcnt(0) lgkmcnt(0)" ::: "memory"); PG8_BAR; asm volatile("" ::: "memory");
        int R, C; stage_rc(tid * 16, R, C);
#pragma unroll
        for (int h = 0; h < 2; ++h)
#pragma unroll
            for (int i = 0; i < 2; ++i) { go[h][i] = lidx[h * 128 + i * 64 + R] + (unsigned)(C * 2); gn[h][i] = go[h][i]; }
    }
    PG8_STAGE(PG8_SB(0, 0), cB, B); PG8_STAGE(PG8_SB(0, 1), cB + hstepB, B); PG8_STAGE_A(PG8_SA(0, 0), cA, 0, go); PG8_STAGE_A(PG8_SA(0, 1), cA, 1, go);
    if (wr == 1) PG8_BAR;
    PG8_WAIT_V(2); PG8_BAR;
    PG8_STAGE(PG8_SB(1, 0), cB + kstep, B); PG8_STAGE_A(PG8_SA(1, 0), cA + kstep, 0, go); PG8_STAGE(PG8_SB(1, 1), cB + hstepB + kstep, B);
    PG8_WAIT_V(6); PG8_BAR;
    for (;;) {
        const bool has_next = S.next(ui + 1, nxt);
        const char* nA = has_next ? nxt.a : cA; const char* nB = has_next ? nxt.b : cB;
        for (int t = 0; t < nt; t += 2) {
            const bool last = (t == nt - 2);
            const char* a1 = cA + (size_t)(t + 1) * kstep;
            const char* a2 = last ? nA : cA + (size_t)(t + 2) * kstep; const char* b2 = last ? nB : cB + (size_t)(t + 2) * kstep;
            const char* a3 = a2 + kstep; const char* b3 = b2 + kstep;
            if constexpr (GATHER) { if (last && has_next) { int R, C; stage_rc(tid * 16, R, C);
#pragma unroll
                for (int h = 0; h < 2; ++h)
#pragma unroll
                    for (int i = 0; i < 2; ++i) gn[h][i] = lidx[(ui + 1) * 256 + h * 128 + i * 64 + R] + (unsigned)(C * 2); } }
            unsigned gx[2][2];
#pragma unroll
            for (int h = 0; h < 2; ++h)
#pragma unroll
                for (int i = 0; i < 2; ++i) gx[h][i] = GATHER ? (last ? gn[h][i] : go[h][i]) : 0u;
            PG8_LDB(B0, 0, 0); PG8_LDB(B1, 0, 1); PG8_SCHED; PG8_LDA(At, 0, 0); PG8_STAGE_A(PG8_SA(1, 1), a1, 1, go);
            PG8_WAIT_V(8); PG8_WAIT_L(0); PG8_BAR; PG8_MMA(0, 0, At, B0); PG8_MMA(0, 1, At, B1); PG8_BAR; PG8_SCHED;
            PG8_LDA(At, 0, 1); PG8_STAGE(PG8_SB(0, 0), b2, B); PG8_STAGE(PG8_SB(0, 1), b2 + hstepB, B); PG8_STAGE_A(PG8_SA(0, 0), a2, 0, gx);
            PG8_WAIT_V(8); PG8_WAIT_L(0); PG8_BAR; PG8_MMA(1, 0, At, B0); PG8_MMA(1, 1, At, B1); PG8_BAR; PG8_SCHED;
            PG8_LDB(B0, 1, 0); PG8_LDB(B1, 1, 1); PG8_SCHED; PG8_LDA(At, 1, 0); PG8_STAGE_A(PG8_SA(0, 1), a2, 1, gx);
            PG8_WAIT_V(8); PG8_WAIT_L(0); PG8_BAR; PG8_MMA(0, 0, At, B0); PG8_MMA(0, 1, At, B1); PG8_BAR; PG8_SCHED;
            PG8_LDA(At, 1, 1); PG8_STAGE(PG8_SB(1, 0), b3, B); PG8_STAGE(PG8_SB(1, 1), b3 + hstepB, B); PG8_STAGE_A(PG8_SA(1, 0), a3, 0, gx);
            PG8_WAIT_V(8); PG8_WAIT_L(0); PG8_BAR; PG8_MMA(1, 0, At, B0); PG8_MMA(1, 1, At, B1); PG8_BAR; PG8_SCHED;
            if constexpr (GATHER) { if (last) {
#pragma unroll
                for (int h = 0; h < 2; ++h)
#pragma unroll
                    for (int i = 0; i < 2; ++i) go[h][i] = gn[h][i]; } }
        }
        if (wr == 0) PG8_BAR;
        { const int le = lane_id_fresh();
          E(acc, cur, wr, wc, le & 15, le >> 4, lds + STAGE_BYTES, wid, le); }
        if (!has_next) break;
#pragma unroll
        for (int a = 0; a < 2; ++a)
#pragma unroll
            for (int b = 0; b < 2; ++b)
#pragma unroll
                for (int m = 0; m < 4; ++m)
#pragma unroll
                    for (int n = 0; n < 2; ++n) acc[a][b][m][n] = (f32x4){0.f, 0.f, 0.f, 0.f};
        cur = nxt; cA = nA; cB = nB; ++ui;
        if (wr == 1) PG8_BAR;
    }
    PG8_WAIT_V(0);
    PG8_BAR;
#undef PG8_SA
#undef PG8_SB
#undef PG8_STAGE
#undef PG8_STAGE_A
#undef PG8_LDA
#undef PG8_LDB
#undef PG8_MMA
#undef PG8_WAIT_V
#undef PG8_WAIT_L
#undef PG8_BAR
#undef PG8_SCHED
}

struct DenseOrder {
    int nM, nN, nwg, G, c; const char* A; const char* Bt; size_t tA, tB; int bdiv; size_t bstride;
    __device__ __forceinline__ void init(int M, int N, int G_, int c_, const void* A_, int lda, const void* Bt_, int ldb, int bdiv_ = 0, size_t bstride_ = 0) {
        nM = M / BM; nN = N / BM; nwg = nM * nN; G = G_; c = c_; A = (const char*)A_; Bt = (const char*)Bt_; tA = (size_t)BM * lda * 2; tB = (size_t)BM * ldb * 2; bdiv = bdiv_; bstride = bstride_; }
    __device__ __forceinline__ bool next(int i, Unit& u) const {
        const long L = (long)i * G + c; if (L >= nwg) return false;
        int wgid = (int)L; { const int q = nwg / NXCD, r = nwg % NXCD, xcd = wgid % NXCD, off = wgid / NXCD; wgid = (xcd < r ? xcd * (q + 1) : r * (q + 1) + (xcd - r) * q) + off; }
        const int nig = WGM * nN, gid = wgid / nig, fm = gid * WGM, gsz = (nM - fm) < WGM ? (nM - fm) : WGM;
        u.pm = fm + ((wgid % nig) % gsz); u.pn = (wgid % nig) / gsz; u.aux = 0;
        u.a = A + (size_t)u.pm * tA; u.b = Bt + (size_t)u.pn * tB + (bdiv ? (size_t)(u.pm / bdiv) * bstride : 0);
        return true;
    }
};
}

using pg8::Acc; using pg8::Unit;
#define EPI_ARGS Acc& acc, const Unit& u, int wr, int wc, int fr, int fq, LAS unsigned char* ldsx, int wid, int lane
struct EpiBf16 {
    bf16_t* O; int ldc;
    __device__ __forceinline__ void operator()(EPI_ARGS) const {
        bf16_t* base = O + (size_t)(u.pm * 256 + wr * 64 + fr) * ldc + u.pn * 256 + wc * 32 + 8 * fq;
#pragma unroll
        for (int ai = 0; ai < 2; ++ai)
#pragma unroll
            for (int m = 0; m < 4; ++m)
#pragma unroll
                for (int bj = 0; bj < 2; ++bj) { const f32x4 v0 = acc[ai][bj][m][0], v1 = acc[ai][bj][m][1]; u32x4 w;
                    w.x = cvt_pk_bf16(v0[0], v0[1]); w.y = cvt_pk_bf16(v0[2], v0[3]); w.z = cvt_pk_bf16(v1[0], v1[1]); w.w = cvt_pk_bf16(v1[2], v1[3]);
                    *(u32x4*)(base + (size_t)(ai * 128 + m * 16) * ldc + bj * 128) = w; }
    }
};
struct EpiBf16Aux {
    bf16_t* O; int ldc;
    __device__ __forceinline__ void operator()(EPI_ARGS) const {
        bf16_t* base = O + (size_t)(unsigned)u.aux + (size_t)(wr * 64 + fr) * ldc + wc * 32 + 8 * fq;
#pragma unroll
        for (int ai = 0; ai < 2; ++ai)
#pragma unroll
            for (int m = 0; m < 4; ++m)
#pragma unroll
                for (int bj = 0; bj < 2; ++bj) { const f32x4 v0 = acc[ai][bj][m][0], v1 = acc[ai][bj][m][1]; u32x4 w;
                    w.x = cvt_pk_bf16(v0[0], v0[1]); w.y = cvt_pk_bf16(v0[2], v0[3]); w.z = cvt_pk_bf16(v1[0], v1[1]); w.w = cvt_pk_bf16(v1[2], v1[3]);
                    *(u32x4*)(base + (size_t)(ai * 128 + m * 16) * ldc + bj * 128) = w; }
    }
};
struct EpiInProj {
    bf16_t *GB, *Z, *UG, *VG;
    __device__ __forceinline__ void operator()(EPI_ARGS) const {
        const int pn = u.pn; const size_t row0 = (size_t)(u.pm * 256 + wr * 64 + fr); const int cl = wc * 32 + 8 * fq;
        if (pn >= 2 && pn < 6) {
            bf16_t* base = Z + row0 * 512 + (pn - 2) * 128 + cl;
#pragma unroll
            for (int ai = 0; ai < 2; ++ai)
#pragma unroll
                for (int m = 0; m < 4; ++m) { const f32x4 z0 = acc[ai][0][m][0] * acc[ai][1][m][0], z1 = acc[ai][0][m][1] * acc[ai][1][m][1]; u32x4 w;
                    w.x = cvt_pk_bf16(z0[0], z0[1]); w.y = cvt_pk_bf16(z0[2], z0[3]); w.z = cvt_pk_bf16(z1[0], z1[1]); w.w = cvt_pk_bf16(z1[2], z1[3]);
                    *(u32x4*)(base + (size_t)(ai * 128 + m * 16) * 512) = w; }
        } else {
            const bool act = pn >= 6;
            const int sel = pn < 2 ? 0 : (pn < 8 ? 2 : 3), ct = pn < 2 ? pn : (pn < 8 ? pn - 6 : pn - 8);
            bf16_t* base = GB + (size_t)sel * (16u << 20) + row0 * 512 + ct * 256 + cl;
#pragma unroll
            for (int ai = 0; ai < 2; ++ai)
#pragma unroll
                for (int m = 0; m < 4; ++m)
#pragma unroll
                    for (int bj = 0; bj < 2; ++bj) { f32x4 v0 = acc[ai][bj][m][0], v1 = acc[ai][bj][m][1];
                        if (act) {
#pragma unroll
                            for (int i = 0; i < 4; ++i) { v0[i] = gelu_fast(v0[i]); v1[i] = gelu_fast(v1[i]); } }
                        u32x4 w; w.x = cvt_pk_bf16(v0[0], v0[1]); w.y = cvt_pk_bf16(v0[2], v0[3]); w.z = cvt_pk_bf16(v1[0], v1[1]); w.w = cvt_pk_bf16(v1[2], v1[3]);
                        *(u32x4*)(base + (size_t)(ai * 128 + m * 16) * 512 + bj * 128) = w; }
        }
    }
};
struct EpiResidA {
    const float* R; bf16_t* XB; float* SSQ;
    __device__ __forceinline__ void operator()(EPI_ARGS) const {
        const size_t row0 = (size_t)(u.pm * 256 + wr * 64 + fr); const int col0 = u.pn * 256 + wc * 32 + 8 * fq;
#pragma unroll
        for (int ai = 0; ai < 2; ++ai)
#pragma unroll
            for (int m = 0; m < 4; ++m) { const size_t off = (row0 + ai * 128 + m * 16) * 1024 + col0; float sq = 0.f;
#pragma unroll
                for (int bj = 0; bj < 2; ++bj) { const f32x4 r0 = __builtin_nontemporal_load((const f32x4*)(R + off + bj * 128)), r1 = __builtin_nontemporal_load((const f32x4*)(R + off + bj * 128 + 4));
                    const f32x4 v0 = r0 + acc[ai][bj][m][0], v1 = r1 + acc[ai][bj][m][1];
                    u32x4 w; w.x = cvt_pk_bf16(v0[0], v0[1]); w.y = cvt_pk_bf16(v0[2], v0[3]); w.z = cvt_pk_bf16(v1[0], v1[1]); w.w = cvt_pk_bf16(v1[2], v1[3]); *(u32x4*)(XB + off + bj * 128) = w;
                    sq += (v0[0] * v0[0] + v0[1] * v0[1]) + (v0[2] * v0[2] + v0[3] * v0[3]) + (v1[0] * v1[0] + v1[1] * v1[1]) + (v1[2] * v1[2] + v1[3] * v1[3]); }
                sq += __shfl_xor(sq, 16); sq += __shfl_xor(sq, 32); if (fq == 0) SSQ[(row0 + ai * 128 + m * 16) * 16 + u.pn * 4 + wc] = sq;
                if (m & 1) asm volatile("" ::: "memory"); }
    }
};
struct EpiResidB {
    const bf16_t* RB; bf16_t* XB;
    __device__ __forceinline__ void operator()(EPI_ARGS) const {
        const size_t row0 = (size_t)(u.pm * 256 + wr * 64 + fr); const int col0 = u.pn * 256 + wc * 32 + 8 * fq;
#pragma unroll
        for (int ai = 0; ai < 2; ++ai)
#pragma unroll
            for (int m = 0; m < 4; ++m) { const size_t off = (row0 + ai * 128 + m * 16) * 1024 + col0;
#pragma unroll
                for (int bj = 0; bj < 2; ++bj) { const u32x4 r = __builtin_nontemporal_load((const u32x4*)(RB + off + bj * 128));
                    const f32x4 v0 = (f32x4){bf_lo(r.x), bf_hi(r.x), bf_lo(r.y), bf_hi(r.y)} + acc[ai][bj][m][0], v1 = (f32x4){bf_lo(r.z), bf_hi(r.z), bf_lo(r.w), bf_hi(r.w)} + acc[ai][bj][m][1];
                    u32x4 w; w.x = cvt_pk_bf16(v0[0], v0[1]); w.y = cvt_pk_bf16(v0[2], v0[3]); w.z = cvt_pk_bf16(v1[0], v1[1]); w.w = cvt_pk_bf16(v1[2], v1[3]); *(u32x4*)(XB + off + bj * 128) = w; }
                if (m & 1) asm volatile("" ::: "memory"); }
    }
};
struct EpiSoftmax {
    const float* SSQ; bf16_t* P;
    __device__ __forceinline__ void operator()(EPI_ARGS) const {
        const size_t row0 = (size_t)(u.pm * 256 + wr * 64 + fr);
        LAS f32x2* ex = (LAS f32x2*)ldsx;
        float mw[2][4];
#pragma unroll
        for (int ai = 0; ai < 2; ++ai)
#pragma unroll
            for (int m = 0; m < 4; ++m) {
                const f32x4* q = (const f32x4*)(SSQ + (row0 + ai * 128 + m * 16) * 16);
                const f32x4 q0 = q[0], q1 = q[1], q2 = q[2], q3 = q[3];
                const float ss = ((q0[0] + q0[1]) + (q0[2] + q0[3])) + ((q1[0] + q1[1]) + (q1[2] + q1[3])) + ((q2[0] + q2[1]) + (q2[2] + q2[3])) + ((q3[0] + q3[1]) + (q3[2] + q3[3]));
                const float rs = rsqrtf(ss * (1.f / 1024.f) + EPS);
                float mx = -3.0e38f;
#pragma unroll
                for (int bj = 0; bj < 2; ++bj)
#pragma unroll
                    for (int n = 0; n < 2; ++n) { f32x4 v = acc[ai][bj][m][n] * rs; acc[ai][bj][m][n] = v; mx = fmaxf(fmaxf(mx, fmaxf(v[0], v[1])), fmaxf(v[2], v[3])); }
                mx = fmaxf(mx, __shfl_xor(mx, 16)); mx = fmaxf(mx, __shfl_xor(mx, 32));
                float sum = 0.f;
#pragma unroll
                for (int bj = 0; bj < 2; ++bj)
#pragma unroll
                    for (int n = 0; n < 2; ++n) { f32x4 v = acc[ai][bj][m][n];
#pragma unroll
                        for (int i = 0; i < 4; ++i) v[i] = __builtin_amdgcn_exp2f(v[i] - mx);
                        acc[ai][bj][m][n] = v; sum += (v[0] + v[1]) + (v[2] + v[3]); }
                sum += __shfl_xor(sum, 16); sum += __shfl_xor(sum, 32);
                mw[ai][m] = mx;
                if (fq == 0) ex[(ai * 128 + wr * 64 + m * 16 + fr) * 4 + wc] = (f32x2){mx, sum};
            }
        asm volatile("s_waitcnt lgkmcnt(0)" ::: "memory"); __builtin_amdgcn_s_barrier(); asm volatile("" ::: "memory");
        bf16_t* base = P + row0 * 1024 + u.pn * 256 + wc * 32 + 8 * fq;
#pragma unroll
        for (int ai = 0; ai < 2; ++ai)
#pragma unroll
            for (int m = 0; m < 4; ++m) {
                const LAS f32x2* e4 = ex + (ai * 128 + wr * 64 + m * 16 + fr) * 4;
                const f32x2 e0 = e4[0], e1 = e4[1], e2 = e4[2], e3 = e4[3];
                const float M = fmaxf(fmaxf(e0.x, e1.x), fmaxf(e2.x, e3.x));
                const float L = e0.y * __builtin_amdgcn_exp2f(e0.x - M) + e1.y * __builtin_amdgcn_exp2f(e1.x - M) + e2.y * __builtin_amdgcn_exp2f(e2.x - M) + e3.y * __builtin_amdgcn_exp2f(e3.x - M);
                const float f = __builtin_amdgcn_exp2f(mw[ai][m] - M) / L;
#pragma unroll
                for (int bj = 0; bj < 2; ++bj) { const f32x4 v0 = acc[ai][bj][m][0] * f, v1 = acc[ai][bj][m][1] * f; u32x4 w;
                    w.x = cvt_pk_bf16(v0[0], v0[1]); w.y = cvt_pk_bf16(v0[2], v0[3]); w.z = cvt_pk_bf16(v1[0], v1[1]); w.w = cvt_pk_bf16(v1[2], v1[3]);
                    *(u32x4*)(base + (size_t)(ai * 128 + m * 16) * 1024 + bj * 128) = w; }
            }
    }
};
struct WqkOrder {
    int G, c; const char* KV; const char* WQ;
    __device__ __forceinline__ bool next(int i, Unit& u) const {
        const int L = i * G + c; if (L >= 128) return false;
        const int b = L >> 4, h = (L >> 2) & 3, pn = L & 3;
        u.pm = 0; u.pn = pn; u.a = KV + ((size_t)(b * 256) * 2048 + h * 256) * 2; u.b = WQ + ((size_t)(pn * 256) * 1024 + h * 256) * 2;
        u.aux = b * (1024 * 1024) + (h * 256) * 1024 + pn * 256; return true; }
};
struct VwOrder {
    int G, c; const char* KV; const char* WO;
    __device__ __forceinline__ bool next(int i, Unit& u) const {
        const int L = i * G + c; if (L >= 128) return false;
        const int b = L >> 4, h = (L >> 2) & 3, pm = L & 3;
        u.pm = pm; u.pn = 0; u.a = WO + ((size_t)(pm * 256) * 1024 + h * 256) * 2; u.b = KV + ((size_t)(b * 256) * 2048 + 1024 + h * 256) * 2;
        u.aux = b * (1024 * 1024) + (pm * 256) * 1024 + h * 256; return true; }
};

struct EpiSwiGLU {
    bf16_t* H; const float* rs_slot;
    __device__ __forceinline__ void operator()(EPI_ARGS) const {
        const size_t row0 = (size_t)(u.pm * 256 + wr * 64 + fr);
        bf16_t* base = H + row0 * 512 + u.pn * 128 + wc * 32 + 8 * fq;
#pragma unroll
        for (int ai = 0; ai < 2; ++ai)
#pragma unroll
            for (int m = 0; m < 4; ++m) { const float rs = rs_slot[row0 + ai * 128 + m * 16]; f32x4 h0, h1;
#pragma unroll
                for (int i = 0; i < 4; ++i) { const float g0 = acc[ai][0][m][0][i] * rs, g1 = acc[ai][0][m][1][i] * rs;
                    h0[i] = g0 * __builtin_amdgcn_rcpf(1.0f + __builtin_amdgcn_exp2f(-1.4426950408889634f * g0)) * (acc[ai][1][m][0][i] * rs);
                    h1[i] = g1 * __builtin_amdgcn_rcpf(1.0f + __builtin_amdgcn_exp2f(-1.4426950408889634f * g1)) * (acc[ai][1][m][1][i] * rs); }
                u32x4 w; w.x = cvt_pk_bf16(h0[0], h0[1]); w.y = cvt_pk_bf16(h0[2], h0[3]); w.z = cvt_pk_bf16(h1[0], h1[1]); w.w = cvt_pk_bf16(h1[2], h1[3]);
                *(u32x4*)(base + (size_t)(ai * 128 + m * 16) * 512) = w; }
    }
};
struct EpiDown {
    bf16_t* Y; const float* gate;
    __device__ __forceinline__ void operator()(EPI_ARGS) const {
        const size_t row0 = (size_t)(u.pm * 256 + wr * 64 + fr);
        bf16_t* base = Y + row0 * 1024 + u.pn * 256 + wc * 32 + 8 * fq;
#pragma unroll
        for (int ai = 0; ai < 2; ++ai)
#pragma unroll
            for (int m = 0; m < 4; ++m) { const float g = gate[row0 + ai * 128 + m * 16];
#pragma unroll
                for (int bj = 0; bj < 2; ++bj) { const f32x4 v0 = acc[ai][bj][m][0] * g, v1 = acc[ai][bj][m][1] * g; u32x4 w;
                    w.x = cvt_pk_bf16(v0[0], v0[1]); w.y = cvt_pk_bf16(v0[2], v0[3]); w.z = cvt_pk_bf16(v1[0], v1[1]); w.w = cvt_pk_bf16(v1[2], v1[3]);
                    *(u32x4*)(base + (size_t)(ai * 128 + m * 16) * 1024 + bj * 128) = w; } }
    }
};
struct GroupedOrder {
    int G, c, nunits; const int* tile_e; const char* A; const char* W; size_t tA, wE, tB;
    __device__ __forceinline__ void init(int G_, int c_, const int* tbl, const void* A_, int lda, const void* W_, int ldb, size_t expert_bytes, bool gather = false) {
        G = G_; c = c_; tile_e = tbl + 16; nunits = 4 * __builtin_amdgcn_readfirstlane(__hip_atomic_load(tbl, __ATOMIC_RELAXED, __HIP_MEMORY_SCOPE_AGENT)); A = (const char*)A_; W = (const char*)W_; tA = gather ? 0 : (size_t)256 * lda * 2; tB = (size_t)256 * ldb * 2; wE = expert_bytes; }
    __device__ __forceinline__ bool next(int i, Unit& u) const {
        const int L = i * G + c; if (L >= nunits) return false;
        int wgid = L; { const int q = nunits / 8, r = nunits % 8, xcd = wgid % 8, off = wgid / 8; wgid = (xcd < r ? xcd * (q + 1) : r * (q + 1) + (xcd - r) * q) + off; }
        const int tile = wgid >> 2, pn = wgid & 3, e = __builtin_amdgcn_readfirstlane(__hip_atomic_load(tile_e + tile, __ATOMIC_RELAXED, __HIP_MEMORY_SCOPE_AGENT));
        u.pm = tile; u.pn = pn; u.aux = e; u.a = A + (size_t)tile * tA; u.b = W + (size_t)e * wE + (size_t)pn * tB; return true; }
};

struct Args {
    const float* in[26]; float* out; unsigned char* ws; int ph_lo, ph_hi;
};
struct Frame {
    LAS unsigned char* lds; int wave, vcu, G; unsigned char* ws; float* out;
};
#define IN_X 0
#define IN_MEM 1
#define IN_G_MIX 2
#define IN_W_IN 3
#define IN_CONV_W 4
#define IN_G_V 5
#define IN_W_S 6
#define IN_B_S 7
#define IN_G_OUT_CONV 8
#define IN_G_OUT_GMLP 9
#define IN_W_OUT 10
#define IN_G_XATTN 11
#define IN_G_MEM 12
#define IN_W_Q 13
#define IN_W_K 14
#define IN_W_V 15
#define IN_W_O 16
#define IN_G_FFN 17
#define IN_W_GRP 18
#define IN_B_GRP 19
#define IN_W_RT 20
#define IN_B_RT 21
#define IN_W_GATE 22
#define IN_W_UP 23
#define IN_W_DOWN 24
#define IN_G_FINAL 25

struct TrItem { const float* src; bf16_t* dst; const float* gk; int ldw, K; };
__device__ __forceinline__ void tr_load(const TrItem& t, float (&v)[32], int lane) {
    const float* p = t.src + (size_t)(lane >> 5) * t.ldw + (lane & 31);
#pragma unroll
    for (int i = 0; i < 32; ++i) v[i] = __builtin_nontemporal_load(p + (size_t)(2 * i) * t.ldw);
}
__device__ __forceinline__ void tr_finish(const TrItem& t, const float (&v)[32], LAS float* scr, int lane) {
    float g8[8];
    if (t.gk) { const f32x4 ga = *(const f32x4*)(t.gk + 8 * (lane & 7)), gb = *(const f32x4*)(t.gk + 8 * (lane & 7) + 4); g8[0] = ga[0]; g8[1] = ga[1]; g8[2] = ga[2]; g8[3] = ga[3]; g8[4] = gb[0]; g8[5] = gb[1]; g8[6] = gb[2]; g8[7] = gb[3]; }
    else {
#pragma unroll
        for (int j = 0; j < 8; ++j) g8[j] = 1.f; }
#pragma unroll
    for (int i = 0; i < 32; ++i) scr[(2 * i + (lane >> 5)) * 33 + (lane & 31)] = v[i];
    LDS_WAIT(); asm volatile("" ::: "memory");
    const int c = lane & 7;
#pragma unroll
    for (int j = 0; j < 4; ++j) { const int n = (lane >> 3) + 8 * j; const LAS float* s = scr + (8 * c) * 33 + n;
        u32x4 o; o.x = pk2(s[0 * 33] * g8[0], s[1 * 33] * g8[1]); o.y = pk2(s[2 * 33] * g8[2], s[3 * 33] * g8[3]); o.z = pk2(s[4 * 33] * g8[4], s[5 * 33] * g8[5]); o.w = pk2(s[6 * 33] * g8[6], s[7 * 33] * g8[7]);
        *(u32x4*)(t.dst + (size_t)n * t.K + 8 * c) = o; }
    LDS_WAIT(); asm volatile("" ::: "memory");
}
__device__ __forceinline__ TrItem tr_make(const float* W, int ldw, int K, bf16_t* WT, int dst_row0, int src_col0, int k0, const float* gk = nullptr) {
    TrItem t; t.src = W + (size_t)k0 * ldw + src_col0; t.dst = WT + (size_t)dst_row0 * K + k0; t.gk = gk ? gk + k0 : nullptr; t.ldw = ldw; t.K = K; return t; }
__device__ __forceinline__ int in_map(int n0) {
    if (n0 < 512 || n0 >= 1536) return n0;
    const int j = (n0 - 512) >> 8, r = (n0 - 512) & 255;
    return r < 128 ? 512 + 128 * j + r : 1024 + 128 * j + (r - 128);
}
__device__ __forceinline__ void norm_row_bf16(const float* xrow, const float* g, bf16_t* orow, int lane) {
    const f32x4* xr = (const f32x4*)xrow + lane; const f32x4* gr = (const f32x4*)g + lane;
    f32x4 v[4]; float s = 0.f;
#pragma unroll
    for (int j = 0; j < 4; ++j) { v[j] = xr[64 * j]; s += (v[j].x * v[j].x + v[j].y * v[j].y) + (v[j].z * v[j].z + v[j].w * v[j].w); }
    const float rs = rsqrtf(wave_sum(s) * (1.f / 1024.f) + EPS);
    u32x2* o8 = (u32x2*)orow + lane;
#pragma unroll
    for (int j = 0; j < 4; ++j) { const f32x4 gg = gr[64 * j]; u32x2 w; w.x = pk2(v[j].x * rs * gg.x, v[j].y * rs * gg.y); w.y = pk2(v[j].z * rs * gg.z, v[j].w * rs * gg.w); o8[64 * j] = w; }
}
__device__ __forceinline__ void norm_rows4_bf16(const float* X, const float* g, bf16_t* O, int m, int stride, int M, int lane) {
    f32x4 v[4][4]; float s[4]; const f32x4* gr = (const f32x4*)g + lane;
#pragma unroll
    for (int r = 0; r < 4; ++r) { const int mr = (m + r * stride < M) ? m + r * stride : m; const f32x4* xr = (const f32x4*)(X + (size_t)mr * 1024) + lane;
#pragma unroll
        for (int j = 0; j < 4; ++j) v[r][j] = __builtin_nontemporal_load(xr + 64 * j); }
#pragma unroll
    for (int r = 0; r < 4; ++r) { s[r] = 0.f;
#pragma unroll
        for (int j = 0; j < 4; ++j) s[r] += (v[r][j].x * v[r][j].x + v[r][j].y * v[r][j].y) + (v[r][j].z * v[r][j].z + v[r][j].w * v[r][j].w); }
#pragma unroll
    for (int r = 0; r < 4; ++r) { if (m + r * stride >= M) break; const float rs = rsqrtf(wave_sum(s[r]) * (1.f / 1024.f) + EPS); u32x2* o8 = (u32x2*)(O + (size_t)(m + r * stride) * 1024) + lane;
#pragma unroll
        for (int j = 0; j < 4; ++j) { const f32x4 gg = gr[64 * j]; u32x2 w; w.x = pk2(v[r][j].x * rs * gg.x, v[r][j].y * rs * gg.y); w.y = pk2(v[r][j].z * rs * gg.z, v[r][j].w * rs * gg.w); o8[64 * j] = w; } }
}
constexpr int PRO_I_IN = 16 * 80, PRO_I_SQ = 16 * 32, PRO_I_G = 16 * 16, PRO_I_D = 8 * 32, PRO_NITEMS = PRO_I_IN + 4 * PRO_I_SQ + NE * (2 * PRO_I_G + PRO_I_D);
__device__ __forceinline__ TrItem pro_item(const Args& a, unsigned char* ws, int it) {
    int r = it;
    if (r < PRO_I_IN) { const int kb = r / 80, nb = r % 80; return tr_make(a.in[IN_W_IN], INC, D, (bf16_t*)(ws + WS_WIN_T), 32 * nb, in_map(32 * nb), 64 * kb); } r -= PRO_I_IN;
    if (r < 4 * PRO_I_SQ) { const int q = r / PRO_I_SQ; r -= q * PRO_I_SQ; const int kb = r / 32, nb = r % 32;
        const float* W = a.in[q == 0 ? IN_W_OUT : (q == 1 ? IN_W_O : (q == 2 ? IN_W_K : IN_W_V))];
        bf16_t* WT = (bf16_t*)(ws + (q == 0 ? WS_WOUT_T : (q == 1 ? WS_WO_T : WS_WKV_T)));
        return tr_make(W, D, D, WT, (q == 3 ? 1024 : 0) + 32 * nb, 32 * nb, 64 * kb); }
    r -= 4 * PRO_I_SQ;
    const int e = r / (2 * PRO_I_G + PRO_I_D); r -= e * (2 * PRO_I_G + PRO_I_D);
    if (r < 2 * PRO_I_G) { const int up = r >= PRO_I_G; if (up) r -= PRO_I_G; const int kb = r / 16, nb = r % 16, n0 = 32 * nb;
        const int dst = 256 * (n0 >> 7) + (up ? 128 : 0) + (n0 & 127);
        return tr_make(a.in[up ? IN_W_UP : IN_W_GATE] + (size_t)e * D * DE, DE, D, (bf16_t*)(ws + WS_WGU_T) + (size_t)e * 1024 * 1024, dst, n0, 64 * kb, a.in[IN_G_FFN]); }
    r -= 2 * PRO_I_G;
    const int kb = r / 32, nb = r % 32;
    return tr_make(a.in[IN_W_DOWN] + (size_t)e * DE * D, D, DE, (bf16_t*)(ws + WS_WD_T) + (size_t)e * 1024 * 512, 32 * nb, 32 * nb, 64 * kb);
}
__device__ __forceinline__ void p0_prologue(const Frame& F, const Args& a) {
    LAS float* scr = (LAS float*)(F.lds + F.wave * 16384);
    const int lane = lane_id_fresh(), tid = F.wave * 64 + lane;
    unsigned char* ws = F.ws;
    const int gw = F.vcu * NWAVES + F.wave, NGW = F.G * NWAVES;
    {
        float va[32], vb[32]; TrItem ta, tb;
        int it = gw;
        if (it < PRO_NITEMS) { ta = pro_item(a, ws, it); tr_load(ta, va, lane); }
        while (it < PRO_NITEMS) {
            const int i1 = it + NGW; const bool h1 = i1 < PRO_NITEMS;
            if (h1) { tb = pro_item(a, ws, i1); tr_load(tb, vb, lane); }
            tr_finish(ta, va, scr, lane);
            if (!h1) break;
            const int i2 = i1 + NGW; const bool h2 = i2 < PRO_NITEMS;
            if (h2) { ta = pro_item(a, ws, i2); tr_load(ta, va, lane); }
            tr_finish(tb, vb, scr, lane);
            it = i2;
        }
    }
    for (int m = gw; m < T; m += 4 * NGW) norm_rows4_bf16(a.in[IN_X], a.in[IN_G_MIX], (bf16_t*)(ws + WS_HB), m, NGW, T, lane);
    for (int m = gw; m < B * ML; m += NGW) norm_row_bf16(a.in[IN_MEM] + (size_t)m * D, a.in[IN_G_MEM], (bf16_t*)(ws + WS_MEMN) + (size_t)m * D, lane);
    const int gt = F.vcu * NTHREADS + tid, NGT = F.G * NTHREADS;
    { const float* wq = a.in[IN_W_Q]; const float* gx = a.in[IN_G_XATTN]; bf16_t* o = (bf16_t*)(ws + WS_WQ_NAT);
      for (int i = gt; i < D * D / 2; i += NGT) { const int k = (2 * i) >> 10; const float sc = gx[k] * (1.4426950408889634f * 0.0625f); const f32x2 v = *(const f32x2*)(wq + 2 * i); *(unsigned*)(o + 2 * i) = pk2(v.x * sc, v.y * sc); } }
    { const float* w = a.in[IN_W_S]; bf16_t* o = (bf16_t*)(ws + WS_WS_BF);
      for (int i = gt; i < NH * CHUNK * CHUNK; i += NGT) { const int s = i & 127, t = (i >> 7) & 127; o[i] = (bf16_t)f2bf(s <= t ? w[i] : 0.f); } }
    { const float* wg = a.in[IN_W_GRP]; const float* wr = a.in[IN_W_RT]; const float* gf = a.in[IN_G_FFN]; bf16_t* o = (bf16_t*)(ws + WS_WR);
      for (int i = gt; i < 48 * 1024; i += NGT) { const int n = i >> 10, k = i & 1023; float v = 0.f;
          if (n < 4) v = wg[(size_t)k * NG + n] * gf[k]; else if (n < 36) v = wr[(size_t)k * NE + (n - 4)] * gf[k];
          const unsigned hi = f2bf(v); const float lo = v - __uint_as_float(hi << 16); o[i] = (bf16_t)hi; o[48 * 1024 + i] = (bf16_t)f2bf(lo); } }
}

__device__ __forceinline__ void unpack8(const u32x4 w, float (&f)[8]) { f[0] = bf_lo(w.x); f[1] = bf_hi(w.x); f[2] = bf_lo(w.y); f[3] = bf_hi(w.y); f[4] = bf_lo(w.z); f[5] = bf_hi(w.z); f[6] = bf_lo(w.w); f[7] = bf_hi(w.w); }
constexpr int VT_PITCH = 136, VT_HEAD = 128 * VT_PITCH, MIX_EXCH = 8 * VT_HEAD;
__device__ __forceinline__ void mixer_unit(const Frame& F, const Args& a, int ch) {
    const int t0 = ch * 128, w = F.wave, l = lane_id_fresh();
    unsigned char* ws = F.ws;
    const bf16_t* GBp = (const bf16_t*)(ws + WS_GB); const bf16_t* Zp = (const bf16_t*)(ws + WS_Z); const bf16_t* UGp = (const bf16_t*)(ws + WS_UG); const bf16_t* VGp = (const bf16_t*)(ws + WS_VG);
    bf16_t* Y = (bf16_t*)(ws + WS_Y);
    __syncthreads();
    const int h = w;
    u32x4 vraw[16], uraw[16];
    { const int d8 = 8 * (l & 7);
#pragma unroll
      for (int it = 0; it < 16; ++it) vraw[it] = __builtin_nontemporal_load((const u32x4*)(VGp + (size_t)(t0 + 8 * it + (l >> 3)) * 512 + h * 64 + d8));
#pragma unroll
      for (int it = 0; it < 16; ++it) uraw[it] = __builtin_nontemporal_load((const u32x4*)(UGp + (size_t)(t0 + 8 * it + (l >> 3)) * 512 + h * 64 + d8)); }
    asm volatile("" ::: "memory");
    {
        const int c = 8 * l;
        float w0[8], w1[8], w2[8], ga[8], zp1[8], zp2[8];
        const float* cw = a.in[IN_CONV_W]; const float* gc = a.in[IN_G_OUT_CONV];
#pragma unroll
        for (int j = 0; j < 8; ++j) { w0[j] = cw[c + j]; w1[j] = cw[CW + c + j]; w2[j] = cw[2 * CW + c + j]; ga[j] = gc[c + j]; }
        const int r0 = 16 * w, pos0 = (t0 & (S - 1)) + r0;
        if (pos0 >= 2) { unpack8(*(const u32x4*)(Zp + (size_t)(t0 + r0 - 1) * 512 + c), zp1); unpack8(*(const u32x4*)(Zp + (size_t)(t0 + r0 - 2) * 512 + c), zp2); }
        else {
#pragma unroll
            for (int j = 0; j < 8; ++j) { zp1[j] = 0.f; zp2[j] = 0.f; } }
#pragma unroll 8
        for (int r = 0; r < 16; ++r) {
            const size_t t = (size_t)(t0 + r0 + r);
            float gb[8], z[8], ya[8]; unpack8(__builtin_nontemporal_load((const u32x4*)(GBp + t * 512 + c)), gb); unpack8(__builtin_nontemporal_load((const u32x4*)(Zp + t * 512 + c)), z);
            float sq = 0.f;
#pragma unroll
            for (int j = 0; j < 8; ++j) { ya[j] = gb[j] * (w2[j] * z[j] + w1[j] * zp1[j] + w0[j] * zp2[j]); sq += ya[j] * ya[j]; zp2[j] = zp1[j]; zp1[j] = z[j]; }
            const float rs = rsqrtf(wave_sum(sq) * (1.f / 512.f) + EPS);
            u32x4 o; o.x = pk2(ya[0] * rs * ga[0], ya[1] * rs * ga[1]); o.y = pk2(ya[2] * rs * ga[2], ya[3] * rs * ga[3]); o.z = pk2(ya[4] * rs * ga[4], ya[5] * rs * ga[5]); o.w = pk2(ya[6] * rs * ga[6], ya[7] * rs * ga[7]);
            *(u32x4*)(Y + t * 1024 + c) = o;
        }
    }
    asm volatile("" ::: "memory");
    LAS unsigned char* vt = F.lds + h * VT_HEAD;
    {
        const int d8 = 8 * (l & 7); float gv[8];
#pragma unroll
        for (int j = 0; j < 8; ++j) gv[j] = a.in[IN_G_V][h * 64 + d8 + j];
#pragma unroll
        for (int it = 0; it < 16; ++it) { const int s = 8 * it + (l >> 3); float v[8]; unpack8(vraw[it], v);
            float sq = 0.f;
#pragma unroll
            for (int j = 0; j < 8; ++j) sq += v[j] * v[j];
            sq += __shfl_xor(sq, 1); sq += __shfl_xor(sq, 2); sq += __shfl_xor(sq, 4);
            const float rs = rsqrtf(sq * (1.f / 64.f) + EPS);
            u32x2 lo, hi; lo.x = pk2(v[0] * rs * gv[0], v[1] * rs * gv[1]); lo.y = pk2(v[2] * rs * gv[2], v[3] * rs * gv[3]); hi.x = pk2(v[4] * rs * gv[4], v[5] * rs * gv[5]); hi.y = pk2(v[6] * rs * gv[6], v[7] * rs * gv[7]);
            *(LAS u32x2*)(vt + s * VT_PITCH + d8 * 2) = lo; *(LAS u32x2*)(vt + s * VT_PITCH + d8 * 2 + 8) = hi; }
    }
    __syncthreads();
    const int fr = l & 15, fq = l >> 4, trq = (l & 15) >> 2, trp = l & 3;
    const bf16_t* wsb = (const bf16_t*)(ws + WS_WS_BF) + (size_t)h * CHUNK * CHUNK;
    const unsigned wloff = (unsigned)(fr * CHUNK + 8 * fq);
    const float* bsp = a.in[IN_B_S] + h * CHUNK;
#pragma unroll 1
    for (int half = 0; half < 2; ++half) {
        f32x4 acc[8][2];
#pragma unroll
        for (int m = 0; m < 8; ++m)
#pragma unroll
            for (int n = 0; n < 2; ++n) acc[m][n] = (f32x4){0.f, 0.f, 0.f, 0.f};
#pragma unroll
        for (int ks = 0; ks < 4; ++ks) {
            unsigned wl = wloff; asm volatile("" : "+v"(wl));
            bf16x8 af[2];
#pragma unroll
            for (int n = 0; n < 2; ++n) { const int dc = 32 * half + 16 * n + 4 * trp;
                const s16x4 lo = __builtin_bit_cast(s16x4, __builtin_amdgcn_ds_read_tr16_b64_v4i16((LAS s16x4*)(vt + (32 * ks + 8 * fq + trq) * VT_PITCH + dc * 2)));
                const s16x4 hi = __builtin_bit_cast(s16x4, __builtin_amdgcn_ds_read_tr16_b64_v4i16((LAS s16x4*)(vt + (32 * ks + 8 * fq + 4 + trq) * VT_PITCH + dc * 2)));
                af[n] = (bf16x8){lo[0], lo[1], lo[2], lo[3], hi[0], hi[1], hi[2], hi[3]}; }
#pragma unroll
            for (int m = 2 * ks; m < 8; ++m) {
                const bf16x8 bfr = *(const bf16x8*)(wsb + (16 * m * CHUNK + 32 * ks) + wl);
#pragma unroll
                for (int n = 0; n < 2; ++n) acc[m][n] = __builtin_amdgcn_mfma_f32_16x16x32_bf16(af[n], bfr, acc[m][n], 0, 0, 0);
            }
        }
#pragma unroll
        for (int m = 0; m < 8; ++m) { const float bs = bsp[16 * m + fr];
#pragma unroll
            for (int n = 0; n < 2; ++n) { const int dc = 32 * half + 16 * n + 4 * fq;
                u32x2 o; o.x = pk2(acc[m][n][0] + bs, acc[m][n][1] + bs); o.y = pk2(acc[m][n][2] + bs, acc[m][n][3] + bs);
                *(LAS u32x2*)(vt + (16 * m + fr) * VT_PITCH + dc * 2) = o; } }
    }
    asm volatile("s_waitcnt lgkmcnt(0)" ::: "memory");
    LAS float* exch = (LAS float*)(F.lds + MIX_EXCH);
    {
        const int d8 = 8 * (l & 7);
#pragma unroll
        for (int it = 0; it < 16; ++it) { const int sidx = 8 * it + (l >> 3);
            const u32x2 lo = *(const LAS u32x2*)(vt + sidx * VT_PITCH + d8 * 2), hi = *(const LAS u32x2*)(vt + sidx * VT_PITCH + d8 * 2 + 8);
            float uf[8]; unpack8(uraw[it], uf);
            const float y0 = uf[0] * bf_lo(lo.x), y1 = uf[1] * bf_hi(lo.x), y2 = uf[2] * bf_lo(lo.y), y3 = uf[3] * bf_hi(lo.y), y4 = uf[4] * bf_lo(hi.x), y5 = uf[5] * bf_hi(hi.x), y6 = uf[6] * bf_lo(hi.y), y7 = uf[7] * bf_hi(hi.y);
            float sq = ((y0 * y0 + y1 * y1) + (y2 * y2 + y3 * y3)) + ((y4 * y4 + y5 * y5) + (y6 * y6 + y7 * y7));
            sq += __shfl_xor(sq, 1); sq += __shfl_xor(sq, 2); sq += __shfl_xor(sq, 4);
            if ((l & 7) == 0) exch[h * CHUNK + sidx] = sq;
            uraw[it] = (u32x4){pk2(y0, y1), pk2(y2, y3), pk2(y4, y5), pk2(y6, y7)}; }
    }
    __syncthreads();
    {
        const int d8 = 8 * (l & 7); float gg[8];
#pragma unroll
        for (int j = 0; j < 8; ++j) gg[j] = a.in[IN_G_OUT_GMLP][h * 64 + d8 + j];
#pragma unroll
        for (int it = 0; it < 16; ++it) { const int sidx = 8 * it + (l >> 3); float tot = 0.f;
#pragma unroll
            for (int hh = 0; hh < 8; ++hh) tot += exch[hh * CHUNK + sidx];
            const float rs = rsqrtf(tot * (1.f / 512.f) + EPS);
            float yf[8]; unpack8(uraw[it], yf);
            u32x4 o; o.x = pk2(yf[0] * rs * gg[0], yf[1] * rs * gg[1]); o.y = pk2(yf[2] * rs * gg[2], yf[3] * rs * gg[3]); o.z = pk2(yf[4] * rs * gg[4], yf[5] * rs * gg[5]); o.w = pk2(yf[6] * rs * gg[6], yf[7] * rs * gg[7]);
            *(u32x4*)(Y + (size_t)(t0 + sidx) * 1024 + 512 + h * 64 + d8) = o; }
    }
}

constexpr int RT_XS_PITCH = 272;
constexpr int RT_XS_WAVE = 16 * RT_XS_PITCH;
constexpr int RT_SLAB_OFF = 8 * RT_XS_WAVE;
constexpr int RT_LG_OFF = RT_SLAB_OFF + 2 * 24576;
__device__ __forceinline__ void router_block(const Frame& F, const Args& a, int blk) {
    const int l = lane_id_fresh(), w = F.wave, fr = l & 15, fq = l >> 4, tid = w * 64 + l;
    unsigned char* ws = F.ws;
    LAS unsigned char* xs = F.lds + w * RT_XS_WAVE;
    LAS float* slab = (LAS float*)(F.lds + RT_SLAB_OFF);
    LAS float* lg = (LAS float*)(F.lds + RT_LG_OFF);
    LAS float* biasl = lg + 128 * 48;
    LAS int* histl = (LAS int*)(biasl + 64);
    __syncthreads();
    if (tid < 32) histl[tid] = 0;
    if (tid >= 64 && tid < 64 + 36) { const int n = tid - 64; biasl[n] = n < 4 ? a.in[IN_B_GRP][n] : a.in[IN_B_RT][n - 4]; }
    bf16x8 bh[4][3], bl[4][3];
    { const bf16_t* wh = (const bf16_t*)(ws + WS_WR) + (size_t)fr * 1024 + 128 * w + 8 * fq; const bf16_t* wl = wh + 48 * 1024;
#pragma unroll
      for (int ks = 0; ks < 4; ++ks)
#pragma unroll
          for (int nt = 0; nt < 3; ++nt) { bh[ks][nt] = *(const bf16x8*)(wh + (size_t)nt * 16 * 1024 + 32 * ks); bl[ks][nt] = *(const bf16x8*)(wl + (size_t)nt * 16 * 1024 + 32 * ks); } }
    const bf16_t* xg = (const bf16_t*)(ws + WS_X2B) + (size_t)(blk * 128 + fq) * D + 128 * w + 8 * fr;
    u32x4 bufA[4], bufB[4];
#define RT_LOAD(buf, tg) do { _Pragma("unroll") for (int j = 0; j < 4; ++j) buf[j] = *(const u32x4*)(xg + (size_t)(16 * (tg) + 4 * j) * D); } while (0)
#define RT_GROUP(buf, tg) do { \
        float sq[4]; \
        _Pragma("unroll") for (int j = 0; j < 4; ++j) { const u32x4 v = buf[j]; float f[8]; unpack8(v, f); \
            sq[j] = ((f[0] * f[0] + f[1] * f[1]) + (f[2] * f[2] + f[3] * f[3])) + ((f[4] * f[4] + f[5] * f[5]) + (f[6] * f[6] + f[7] * f[7])); \
            *(LAS u32x4*)(xs + (4 * j + fq) * RT_XS_PITCH + 16 * fr) = v; } \
        asm volatile("s_waitcnt lgkmcnt(0)" ::: "memory"); \
        f32x4 acc[3] = {(f32x4){0.f, 0.f, 0.f, 0.f}, (f32x4){0.f, 0.f, 0.f, 0.f}, (f32x4){0.f, 0.f, 0.f, 0.f}}; \
        _Pragma("unroll") for (int ks = 0; ks < 4; ++ks) { \
            const bf16x8 ah = *(const LAS bf16x8*)(xs + fr * RT_XS_PITCH + (32 * ks + 8 * fq) * 2); \
            _Pragma("unroll") for (int nt = 0; nt < 3; ++nt) { \
                acc[nt] = __builtin_amdgcn_mfma_f32_16x16x32_bf16(ah, bh[ks][nt], acc[nt], 0, 0, 0); \
                acc[nt] = __builtin_amdgcn_mfma_f32_16x16x32_bf16(ah, bl[ks][nt], acc[nt], 0, 0, 0); } } \
        LAS float* sl = slab + ((tg) & 1) * 6144 + w * 768;                    \
        _Pragma("unroll") for (int nt = 0; nt < 3; ++nt) { if (nt < 2 || fr < 4) { _Pragma("unroll") for (int r = 0; r < 4; ++r) sl[(4 * fq + r) * 48 + 16 * nt + fr] = acc[nt][r]; } } \
        _Pragma("unroll") for (int j = 0; j < 4; ++j) { float v = sq[j]; \
            _Pragma("unroll") for (int o = 1; o < 16; o <<= 1) v += __shfl_xor(v, o); \
            if (fr == 0) sl[(4 * j + fq) * 48 + 36] = v; } \
        asm volatile("s_waitcnt lgkmcnt(0)" ::: "memory"); __builtin_amdgcn_s_barrier(); asm volatile("" ::: "memory"); \
        for (int o = tid; o < 16 * 37; o += NTHREADS) { const int tk = o / 37, c = o - tk * 37; const LAS float* sp = slab + ((tg) & 1) * 6144 + tk * 48 + c; \
            float s8 = 0.f; _Pragma("unroll") for (int ww = 0; ww < 8; ++ww) s8 += sp[ww * 768]; lg[(16 * (tg) + tk) * 48 + c] = s8; } \
    } while (0)
    RT_LOAD(bufA, 0);
#pragma unroll 1
    for (int tg = 0; tg < 8; tg += 2) {
        RT_LOAD(bufB, tg + 1);
        RT_GROUP(bufA, tg);
        if (tg + 2 < 8) RT_LOAD(bufA, tg + 2);
        RT_GROUP(bufB, tg + 1);
    }
#undef RT_LOAD
#undef RT_GROUP
    __syncthreads();
    if (tid < 128) {
        const int tl = tid, t = blk * 128 + tl; const LAS float* L = lg + tl * 48; const float rs = rsqrtf(L[36] * (1.f / 1024.f) + EPS);
        float g4[4];
#pragma unroll
        for (int i = 0; i < 4; ++i) g4[i] = L[i] * rs + biasl[i];
        int g = 0; float mx = g4[0];
#pragma unroll
        for (int i = 1; i < 4; ++i) if (g4[i] > mx) { mx = g4[i]; g = i; }
        float den = 0.f;
#pragma unroll
        for (int i = 0; i < 4; ++i) den += __expf(g4[i] - mx);
        const float gp = 1.f / den;
        float e8[8];
#pragma unroll
        for (int i = 0; i < 8; ++i) e8[i] = L[4 + g * 8 + i] * rs + biasl[4 + g * 8 + i];
        int i0 = 0; float v0 = e8[0];
#pragma unroll
        for (int i = 1; i < 8; ++i) if (e8[i] > v0) { v0 = e8[i]; i0 = i; }
        int i1 = -1; float v1 = -3.0e38f;
#pragma unroll
        for (int i = 0; i < 8; ++i) if (i != i0 && e8[i] > v1) { v1 = e8[i]; i1 = i; }
        const float ex = __expf(v1 - v0);
        const float g0 = gp / (1.f + ex), g1 = gp * ex / (1.f + ex);
        const int ex0 = g * 8 + i0, ex1 = g * 8 + i1;
        const int r0 = __hip_atomic_fetch_add((int*)(histl + ex0), 1, __ATOMIC_RELAXED, __HIP_MEMORY_SCOPE_WORKGROUP), r1 = __hip_atomic_fetch_add((int*)(histl + ex1), 1, __ATOMIC_RELAXED, __HIP_MEMORY_SCOPE_WORKGROUP);
        *(int2*)((int*)(ws + RT_TOK_E) + 2 * t) = make_int2(ex0, ex1); *(float2*)((float*)(ws + RT_TOK_G) + 2 * t) = make_float2(g0, g1);
        *(int2*)((int*)(ws + RT_TOK_R) + 2 * t) = make_int2(r0, r1); ((float*)(ws + RT_RS2))[t] = rs;
    }
    __syncthreads();
    if (tid < 32) ((int*)(ws + RT_HIST))[blk * 32 + tid] = histl[tid];
}
__device__ __forceinline__ void assign_block(const Frame& F, const Args& a, int blk) {
    const int l = lane_id_fresh(), w = F.wave, tid = w * 64 + l;
    unsigned char* ws = F.ws;
    LAS int* ptot = (LAS int*)F.lds;
    LAS int* ppre = ptot + 512;
    LAS int* base = ppre + 512;
    LAS int* ebase = base + 32;
    __syncthreads();
    { const int e = tid & 31, part = tid >> 5; const int* H = (const int*)(ws + RT_HIST); int st = 0, sp = 0; int hv[16];
#pragma unroll
      for (int i = 0; i < 16; ++i) hv[i] = H[(part * 16 + i) * 32 + e];
#pragma unroll
      for (int i = 0; i < 16; ++i) { st += hv[i]; sp += (part * 16 + i < blk) ? hv[i] : 0; }
      ptot[part * 32 + e] = st; ppre[part * 32 + e] = sp; }
    __syncthreads();
    if (tid < 32) { int st = 0, sp = 0; for (int p = 0; p < 16; ++p) { st += ptot[p * 32 + tid]; sp += ppre[p * 32 + tid]; } ptot[tid] = st; ppre[tid] = sp; }
    __syncthreads();
    if (tid == 0) { int run = 0;
        for (int e = 0; e < 32; ++e) { base[e] = run * 256 + ppre[e]; ebase[e] = run * 256 + ptot[e]; ebase[64 + e] = run; run += (ptot[e] + 255) >> 8; ebase[32 + e] = run * 256; }
        if (blk == 0) ((int*)(ws + RT_TILE_E))[0] = run; }
    __syncthreads();
    if (blk == 0 && tid < 32) { int* te = (int*)(ws + RT_TILE_E); const int r0 = ebase[64 + tid], nt = (ebase[32 + tid] >> 8) - r0; for (int i = 0; i < nt; ++i) te[16 + r0 + i] = tid; }
    int* tos = (int*)(ws + RT_TOK_OF_SLOT); float* rss = (float*)(ws + RT_RS_SLOT); float* gts = (float*)(ws + RT_GATE_SLOT);
    if (tid < 256) { const int t = blk * 128 + (tid >> 1), k = tid & 1;
        const int e = ((const int*)(ws + RT_TOK_E))[2 * t + k], r = ((const int*)(ws + RT_TOK_R))[2 * t + k];
        const int slot = base[e] + r;
        ((int*)(ws + RT_SLOT_OF))[2 * t + k] = slot; tos[slot] = t; rss[slot] = ((const float*)(ws + RT_RS2))[t]; gts[slot] = ((const float*)(ws + RT_TOK_G))[2 * t + k]; }
    if (blk < 32) {
        for (int sl = ebase[blk] + tid; sl < ebase[32 + blk]; sl += NTHREADS) { tos[sl] = 0; rss[sl] = 0.f; gts[sl] = 0.f; } }
}
__device__ __forceinline__ void combine_rows(const Frame& F, const Args& a, float* outp) {
    const int l = lane_id_fresh();
    unsigned char* ws = F.ws;
    const int gw = F.vcu * NWAVES + F.wave, NGW = F.G * NWAVES;
    const f32x4* gfin = (const f32x4*)a.in[IN_G_FINAL] + l;
    f32x4 gf4[4];
#pragma unroll
    for (int j = 0; j < 4; ++j) gf4[j] = gfin[64 * j];
    const int* slot_of = (const int*)(ws + RT_SLOT_OF); const bf16_t* Y = (const bf16_t*)(ws + WS_YSLOT); const bf16_t* XB = (const bf16_t*)(ws + WS_X2B);
    for (int t = gw; t < T; t += 2 * NGW) {
        const int tb = t + NGW; const bool hb = tb < T; const int t2 = hb ? tb : t;
        const int2 sa = *(const int2*)(slot_of + 2 * t), sb = *(const int2*)(slot_of + 2 * t2);
        const u32x2* xa = (const u32x2*)(XB + (size_t)t * D) + l; const u32x2* xb = (const u32x2*)(XB + (size_t)t2 * D) + l;
        const u32x2* ya0 = (const u32x2*)(Y + (size_t)sa.x * D) + l; const u32x2* ya1 = (const u32x2*)(Y + (size_t)sa.y * D) + l;
        const u32x2* yb0 = (const u32x2*)(Y + (size_t)sb.x * D) + l; const u32x2* yb1 = (const u32x2*)(Y + (size_t)sb.y * D) + l;
        f32x4 va[4], vb[4]; u32x2 ra[4], pa[4], qa[4], rb[4], pb[4], qb[4];
#pragma unroll
        for (int j = 0; j < 4; ++j) { ra[j] = __builtin_nontemporal_load(xa + 64 * j); pa[j] = __builtin_nontemporal_load(ya0 + 64 * j); qa[j] = __builtin_nontemporal_load(ya1 + 64 * j); rb[j] = __builtin_nontemporal_load(xb + 64 * j); pb[j] = __builtin_nontemporal_load(yb0 + 64 * j); qb[j] = __builtin_nontemporal_load(yb1 + 64 * j); }
        float sqa = 0.f, sqb = 0.f;
#pragma unroll
        for (int j = 0; j < 4; ++j) {
            va[j].x = bf_lo(ra[j].x) + bf_lo(pa[j].x) + bf_lo(qa[j].x); va[j].y = bf_hi(ra[j].x) + bf_hi(pa[j].x) + bf_hi(qa[j].x); va[j].z = bf_lo(ra[j].y) + bf_lo(pa[j].y) + bf_lo(qa[j].y); va[j].w = bf_hi(ra[j].y) + bf_hi(pa[j].y) + bf_hi(qa[j].y);
            vb[j].x = bf_lo(rb[j].x) + bf_lo(pb[j].x) + bf_lo(qb[j].x); vb[j].y = bf_hi(rb[j].x) + bf_hi(pb[j].x) + bf_hi(qb[j].x); vb[j].z = bf_lo(rb[j].y) + bf_lo(pb[j].y) + bf_lo(qb[j].y); vb[j].w = bf_hi(rb[j].y) + bf_hi(pb[j].y) + bf_hi(qb[j].y);
            sqa += (va[j].x * va[j].x + va[j].y * va[j].y) + (va[j].z * va[j].z + va[j].w * va[j].w); sqb += (vb[j].x * vb[j].x + vb[j].y * vb[j].y) + (vb[j].z * vb[j].z + vb[j].w * vb[j].w); }
        const float rsa = rsqrtf(wave_sum(sqa) * (1.f / 1024.f) + EPS), rsb = rsqrtf(wave_sum(sqb) * (1.f / 1024.f) + EPS);
        f32x4* oa = (f32x4*)(outp + (size_t)t * D) + l; f32x4* ob = (f32x4*)(outp + (size_t)t2 * D) + l;
#pragma unroll
        for (int j = 0; j < 4; ++j) { __builtin_nontemporal_store(va[j] * rsa * gf4[j], oa + 64 * j); if (hb) __builtin_nontemporal_store(vb[j] * rsb * gf4[j], ob + 64 * j); }
    }
}

#define XB_TMO      128
#define XB_XCNT(j)  (256  + 64 * (j))
#define XB_XSUB(j)  (1280 + 64 * (j))
#define XB_XGEN(j)  (2304 + 64 * (j))
#define XB_TOP      3328
#define XB_TOPGEN   3392
#define XCD_BAR_WORDS 3456
#define XB_SPIN_CAP (1u << 20)
__device__ __forceinline__ unsigned xb_ld(unsigned* p)              { return __hip_atomic_load(p, __ATOMIC_RELAXED, __HIP_MEMORY_SCOPE_AGENT); }
__device__ __forceinline__ unsigned xb_add(unsigned* p, unsigned v) { return __hip_atomic_fetch_add(p, v, __ATOMIC_RELAXED, __HIP_MEMORY_SCOPE_AGENT); }
__device__ __forceinline__ unsigned xb_xcc_id() { return (unsigned)__builtin_amdgcn_s_getreg((3 << 11) | 20) & 0xFu; }
#define XB_SPIN(cond, bar) do { unsigned _sp = 0; while (cond) { __builtin_amdgcn_s_sleep(1); \
    if ((++_sp & 255u) == 0u) { if (xb_ld(&(bar)[XB_TMO])) break; if (_sp > XB_SPIN_CAP) { atomicAdd(&(bar)[XB_TMO], 1u); break; } } } } while (0)
struct XcdBarrier { unsigned* bar; unsigned x; volatile LAS unsigned* st; };
__device__ __forceinline__ XcdBarrier xcd_barrier_post(unsigned* bar, volatile LAS unsigned* st) {
    XcdBarrier b; b.bar = bar; b.x = xb_xcc_id(); b.st = st;
    if (threadIdx.x == 0) (void)xb_add(&bar[XB_XCNT(b.x)], 1u);
    return b;
}
__device__ __forceinline__ void xcd_barrier_complete(unsigned* bar, unsigned x, unsigned& nloc, unsigned& nx) {
    const unsigned G = gridDim.x * gridDim.y * gridDim.z;
    unsigned sum, cnt, mine, sp = 0u;
    for (;;) {
        sum = 0u; cnt = 0u; mine = 0u;
#pragma unroll
        for (unsigned j = 0; j < 16; ++j) { const unsigned c = xb_ld(&bar[XB_XCNT(j)]); sum += c; cnt += (c > 0u) ? 1u : 0u; mine = (j == x) ? c : mine; }
        if (sum == G) break;
        __builtin_amdgcn_s_sleep(1);
        if ((++sp & 255u) == 0u) { if (xb_ld(&bar[XB_TMO])) break; if (sp > XB_SPIN_CAP) { atomicAdd(&bar[XB_TMO], 1u); break; } }
    }
    nloc = mine > 0u ? mine : 1u; nx = cnt > 0u ? cnt : 1u;
}
__device__ __forceinline__ void xcd_barrier(const XcdBarrier& b, const int wave) {
    asm volatile("s_waitcnt vmcnt(0)" ::: "memory");
    __syncthreads();
    if (wave == 0 && lane_id_fresh() == 0) {
        unsigned* bar = b.bar;
        __builtin_amdgcn_s_waitcnt(0);
        unsigned nloc = b.st[0], nx = b.st[1];
        if (nloc == 0u) { xcd_barrier_complete(bar, b.x, nloc, nx); b.st[0] = nloc; b.st[1] = nx; }
        const unsigned old = xb_add(&bar[XB_XSUB(b.x)], 1u);
        const unsigned gen = old / nloc;
        if (old + 1u == (gen + 1u) * nloc) {
            __builtin_amdgcn_fence(__ATOMIC_RELEASE, "agent");
            asm volatile("s_waitcnt vmcnt(0)" ::: "memory");
            const unsigned og = xb_add(&bar[XB_TOP], 1u);
            const unsigned tg = og / nx;
            if (og + 1u == (tg + 1u) * nx) xb_add(&bar[XB_TOPGEN], 1u);
            else XB_SPIN(xb_ld(&bar[XB_TOPGEN]) == tg, bar);
            __builtin_amdgcn_fence(__ATOMIC_ACQUIRE, "agent");
            xb_add(&bar[XB_XGEN(b.x)], 1u);
            asm volatile("s_waitcnt vmcnt(0)" ::: "memory");
        } else {
            XB_SPIN(xb_ld(&bar[XB_XGEN(b.x)]) == gen, bar);
            __builtin_amdgcn_fence(__ATOMIC_ACQUIRE, "agent");
            asm volatile("s_waitcnt vmcnt(0)" ::: "memory");
        }
    }
    __syncthreads();
}

__global__ void __launch_bounds__(NTHREADS, 2) mk_fwd(Args args) {
    extern __shared__ __attribute__((aligned(16))) unsigned char lds_raw[];
    Frame F;
    F.lds = (LAS unsigned char*)lds_raw;
    F.wave = __builtin_amdgcn_readfirstlane((int)threadIdx.x >> 6);
    F.G = gridDim.x; { const int bx = blockIdx.x; F.vcu = (F.G % 8 == 0) ? (bx % 8) * (F.G / 8) + bx / 8 : bx; }
    F.ws = args.ws; F.out = args.out;
    unsigned char* ws = args.ws;
    const int lo = args.ph_lo, hi = args.ph_hi;
    if (threadIdx.x < 64) ((LAS unsigned*)(F.lds + LDS_MISC))[threadIdx.x] = 0u;
    __syncthreads();
    XcdBarrier xbar; xbar.bar = (unsigned*)(ws + WS_CTL) + 4096; xbar.x = 0; xbar.st = nullptr;
    if (hi - lo > 1) xbar = xcd_barrier_post((unsigned*)(ws + WS_CTL) + 4096, (volatile LAS unsigned*)(F.lds + LDS_MISC) + 8);
#define IN(k) (lo <= (k) && (k) < hi)
#define SEAM(k) do { if (IN(k) && IN((k) + 1)) xcd_barrier(xbar, F.wave); } while (0)
    if (IN(0)) p0_prologue(F, args);
    SEAM(0);
    if (IN(1)) {
        { pg8::DenseOrder S; S.init(T, INC, F.G, (int)blockIdx.x, ws + WS_HB, D, ws + WS_WIN_T, D);
          EpiInProj E{(bf16_t*)(ws + WS_GB), (bf16_t*)(ws + WS_Z), (bf16_t*)(ws + WS_UG), (bf16_t*)(ws + WS_VG)};
          pg8::gemm_phase<D, D, D>(F.lds, F.wave, S, E); }
        { pg8::DenseOrder S; S.init(B * ML, 2 * D, F.G, (int)blockIdx.x, ws + WS_MEMN, D, ws + WS_WKV_T, D);
          EpiBf16 E{(bf16_t*)(ws + WS_KV), 2 * D};
          pg8::gemm_phase<D, D, D>(F.lds, F.wave, S, E); }
    }
    SEAM(1);
    if (IN(2)) {
        for (int ch = F.vcu; ch < T / CHUNK; ch += F.G) mixer_unit(F, args, ch);
    }
    SEAM(2);
    if (IN(3)) {
        { WqkOrder S{F.G, (int)blockIdx.x, (const char*)(ws + WS_KV), (const char*)(ws + WS_WQ_NAT)}; EpiBf16Aux E{(bf16_t*)(ws + WS_WQK_T), 1024};
          pg8::gemm_phase<2 * D, D, XD>(F.lds, F.wave, S, E); }
        { VwOrder S{F.G, (int)((blockIdx.x + F.G / 2) % F.G), (const char*)(ws + WS_KV), (const char*)(ws + WS_WO_T)}; EpiBf16Aux E{(bf16_t*)(ws + WS_VW_T), 1024};
          pg8::gemm_phase<D, 2 * D, XD>(F.lds, F.wave, S, E); }
        pg8::DenseOrder S; S.init(T, D, F.G, (int)blockIdx.x, ws + WS_Y, D, ws + WS_WOUT_T, D);
        EpiResidA E{args.in[IN_X], (bf16_t*)(ws + WS_X1B), (float*)(ws + WS_SSQ1)};
        pg8::gemm_phase<D, D, D>(F.lds, F.wave, S, E);
    }
    SEAM(3);
    if (IN(4)) {
        pg8::DenseOrder S; S.init(T, D, F.G, (int)blockIdx.x, ws + WS_X1B, D, ws + WS_WQK_T, D, S_TILES, (size_t)D * D * 2);
        EpiSoftmax E{(const float*)(ws + WS_SSQ1), (bf16_t*)(ws + WS_P)};
        pg8::gemm_phase<D, D, D>(F.lds, F.wave, S, E);
    }
    SEAM(4);
    if (IN(5)) {
        pg8::DenseOrder S; S.init(T, D, F.G, (int)blockIdx.x, ws + WS_P, D, ws + WS_VW_T, D, S_TILES, (size_t)D * D * 2);
        EpiResidB E{(const bf16_t*)(ws + WS_X1B), (bf16_t*)(ws + WS_X2B)};
        pg8::gemm_phase<D, D, D>(F.lds, F.wave, S, E);
    }
    SEAM(5);
    if (IN(6)) { for (int blk = F.vcu; blk < T / 128; blk += F.G) router_block(F, args, blk); }
    SEAM(6);
    if (IN(7)) { for (int blk = F.vcu; blk < T / 128; blk += F.G) assign_block(F, args, blk); }
    SEAM(7);
    if (IN(8)) {
        GroupedOrder S; S.init(F.G, (int)blockIdx.x, (const int*)(ws + RT_TILE_E), ws + WS_X2B, D, ws + WS_WGU_T, D, (size_t)1024 * 1024 * 2, true);
        EpiSwiGLU E{(bf16_t*)(ws + WS_HID), (const float*)(ws + RT_RS_SLOT)};
        pg8::gemm_phase<D, D, D, true>(F.lds, F.wave, S, E, (const int*)(ws + RT_TOK_OF_SLOT));
    }
    SEAM(8);
    if (IN(9)) {
        GroupedOrder S; S.init(F.G, (int)blockIdx.x, (const int*)(ws + RT_TILE_E), ws + WS_HID, DE, ws + WS_WD_T, DE, (size_t)1024 * 512 * 2);
        EpiDown E{(bf16_t*)(ws + WS_YSLOT), (const float*)(ws + RT_GATE_SLOT)};
        pg8::gemm_phase<DE, DE, DE>(F.lds, F.wave, S, E);
    }
    SEAM(9);
    if (IN(10)) { combine_rows(F, args, F.out); }
#undef IN
#undef SEAM
}
extern "C" void kernel_launch(void* const* d_in, const int* in_sizes, int n_in, void* d_out, int out_size, void* d_ws, size_t ws_size, hipStream_t stream) {
    if (n_in != 26 || out_size != T * D || ws_size < 500 * MiB) { fprintf(stderr, "kernel_launch: unexpected shapes n_in %d out %d ws %zu\n", n_in, out_size, ws_size); return; }
    float* xres = (float*)d_out;
    static int grid = 0;
    if (grid == 0) {
        int dev = 0, cus = 0, per_cu = 0;
        if (hipGetDevice(&dev) != hipSuccess || hipDeviceGetAttribute(&cus, hipDeviceAttributeMultiprocessorCount, dev) != hipSuccess) { fprintf(stderr, "kernel_launch: device query failed\n"); grid = -1; return; }
        if (hipFuncSetAttribute((const void*)mk_fwd, hipFuncAttributeMaxDynamicSharedMemorySize, LDS_BYTES) != hipSuccess) { fprintf(stderr, "kernel_launch: hipFuncSetAttribute failed\n"); grid = -1; return; }
        if (hipOccupancyMaxActiveBlocksPerMultiprocessor(&per_cu, (const void*)mk_fwd, NTHREADS, LDS_BYTES) != hipSuccess || per_cu < 1) { fprintf(stderr, "kernel_launch: occupancy query says %d blocks per CU\n", per_cu); (void)hipGetLastError(); grid = -1; return; }
        grid = cus;
        if (grid != 256) fprintf(stderr, "kernel_launch: note: %d CUs (built and tuned for 256)\n", grid);
    }
    if (grid < 0) return;
    Args a{};
    for (int i = 0; i < 26; ++i) a.in[i] = (const float*)d_in[i];
    a.out = xres; a.ws = (unsigned char*)d_ws;
    if (hipMemsetAsync((char*)d_ws + WS_CTL + 4096 * 4, 0, XCD_BAR_WORDS * 4, stream) != hipSuccess) { fprintf(stderr, "kernel_launch: memset failed\n"); return; }
#if defined(MK_PER_PHASE)
    for (int ph = 0; ph < 11; ++ph) { a.ph_lo = ph; a.ph_hi = ph + 1; hipLaunchKernelGGL(mk_fwd, dim3(grid), dim3(NTHREADS), LDS_BYTES, stream, a); }
#else
    a.ph_lo = 0; a.ph_hi = 11;
    hipLaunchKernelGGL(mk_fwd, dim3(grid), dim3(NTHREADS), LDS_BYTES, stream, a);
    const hipError_t le = hipPeekAtLastError();
    if (le != hipSuccess) fprintf(stderr, "kernel_launch: launch failed: %s (grid %d)\n", hipGetErrorString(le), grid);
#endif
}
```

```cpp
#include <hip/hip_runtime.h>
#include <cstdint>
#include <cstdio>

namespace cfg {
constexpr int D = 1024, B = 8, S = 4096, T = B * S;
constexpr int CW = 512, GW = 512, NH = 8, HD = 64, CHUNK = 128, INC = 2560;
constexpr int ML = 256, XH = 4, XD = 256;
constexpr int NG = 4, EPG = 8, NE = 32, DE = 512;
constexpr float EPS = 1e-6f;
}
constexpr size_t MiB = 1u << 20;
using namespace cfg;

#define LAS __attribute__((address_space(3)))
#define GAS __attribute__((address_space(1)))
typedef unsigned short bf16_t;
typedef short bf16x8 __attribute__((ext_vector_type(8)));
typedef short s16x4 __attribute__((ext_vector_type(4)));
typedef float f32x4 __attribute__((ext_vector_type(4)));
typedef float f32x2 __attribute__((ext_vector_type(2)));
typedef unsigned u32x4 __attribute__((ext_vector_type(4)));
typedef unsigned u32x2 __attribute__((ext_vector_type(2)));

constexpr int NWAVES = 8, NTHREADS = 512;
constexpr int S_TILES = cfg::S / 256;
constexpr int LDS_BYTES = 147456;
constexpr int LDS_STAGE = 131072;
constexpr int LDS_EXCH = 131072;
constexpr int LDS_MISC = LDS_BYTES - 256;

constexpr size_t WS_CTL = 0;
constexpr size_t WS_WIN_T = 1 * MiB;
constexpr size_t WS_WOUT_T = 6 * MiB;
constexpr size_t WS_WQ_NAT = 8 * MiB;
constexpr size_t WS_WO_T = 10 * MiB;
constexpr size_t WS_WKV_T = 12 * MiB;
constexpr size_t WS_WS_BF = 16 * MiB;
constexpr size_t WS_MEMN = 17 * MiB;
constexpr size_t WS_KV = 21 * MiB;
constexpr size_t WS_WQK_T = 29 * MiB;
constexpr size_t WS_VW_T = 45 * MiB;
constexpr size_t WS_WGU_T = 61 * MiB;
constexpr size_t WS_WD_T = 125 * MiB;
constexpr size_t WS_WR = 157 * MiB;
constexpr size_t WS_SSQ1 = 158 * MiB;
constexpr size_t WS_ROUTE = 160 * MiB;
constexpr size_t WS_ACT0 = 164 * MiB;
constexpr size_t WS_ACT1 = 228 * MiB;
constexpr size_t WS_GB = WS_ACT1, WS_Z = WS_ACT1 + 32 * MiB, WS_UG = WS_ACT1 + 64 * MiB, WS_VG = WS_ACT1 + 96 * MiB;
constexpr size_t WS_X2B = WS_ACT1 + 64 * MiB;
constexpr size_t WS_HID = WS_ACT0;
constexpr size_t WS_YSLOT = 356 * MiB;
constexpr size_t RT_TOK_E = WS_ROUTE, RT_TOK_G = WS_ROUTE + 256 * 1024, RT_RS2 = WS_ROUTE + 512 * 1024, RT_TOK_R = WS_ROUTE + 640 * 1024, RT_HIST = WS_ROUTE + 896 * 1024,
                 RT_SLOT_OF = WS_ROUTE + 1024 * 1024, RT_GATE_SLOT = WS_ROUTE + 1536 * 1024, RT_TILE_E = WS_ROUTE + 2048 * 1024,
                 RT_TOK_OF_SLOT = WS_ROUTE + 2304 * 1024, RT_RS_SLOT = WS_ROUTE + 2816 * 1024;
constexpr int MAX_TILES = 288;
constexpr size_t WS_HB = WS_ACT0, WS_Y = WS_ACT0, WS_P = WS_ACT0, WS_X1B = WS_ACT1;

__device__ __forceinline__ unsigned f2bf(float f) { unsigned u = __builtin_bit_cast(unsigned, f); return (u + 0x7fffu + ((u >> 16) & 1u)) >> 16; }
__device__ __forceinline__ unsigned pk2(float lo, float hi) { unsigned r; asm("v_cvt_pk_bf16_f32 %0, %1, %2" : "=v"(r) : "v"(lo), "v"(hi)); return r; }
__device__ __forceinline__ unsigned cvt_pk_bf16(float lo, float hi) { unsigned r; asm volatile("v_cvt_pk_bf16_f32 %0, %1, %2" : "=v"(r) : "v"(lo), "v"(hi)); return r; }
__device__ __forceinline__ float bf_lo(unsigned w) { return __uint_as_float(w << 16); }
__device__ __forceinline__ float bf_hi(unsigned w) { return __uint_as_float(w & 0xffff0000u); }
__device__ __forceinline__ float wave_sum(float v) {
#pragma unroll
    for (int o = 1; o < 64; o <<= 1) v += __shfl_xor(v, o);
    return v;
}
__device__ __forceinline__ float gelu_fast(float x) {
    const float t = x * (1.0f + 0.044715f * x * x) * 2.302208198f;
    return x * __builtin_amdgcn_rcpf(1.0f + __builtin_amdgcn_exp2f(-t));
}
__device__ __forceinline__ int lane_id_fresh() { int l; asm volatile("v_mbcnt_lo_u32_b32 %0, -1, 0\n\tv_mbcnt_hi_u32_b32 %0, -1, %0" : "=v"(l)); return l; }
#define LDS_WAIT() asm volatile("s_waitcnt lgkmcnt(0)" ::: "memory")
#define VM_WAIT() asm volatile("s_waitcnt vmcnt(0)" ::: "memory")

namespace pg8 {
constexpr int BM = 256, BK = 64, HALF = 128, HTB = HALF * BK * 2, STAGE_BYTES = 8 * HTB, NXCD = 8, WGM = 8;
__host__ __device__ __forceinline__ int lds_byte(int r, int c) { const int st = (r >> 4) * 2 + (c >> 5), rr = r & 15, cc = c & 31, ob = rr * 64 + cc * 2; return st * 1024 + (ob ^ (((ob >> 9) & 1) << 5)); }
__host__ __device__ __forceinline__ void stage_rc(int b, int& R, int& C) { const int st = b / 1024, sb = b % 1024, swz = sb ^ (((sb >> 9) & 1) << 5); R = (st >> 1) * 16 + swz / 64; C = (st & 1) * 32 + (swz % 64) / 2; }
__host__ __device__ __forceinline__ int perm32(int rho) { const int n = rho >> 4, i = rho & 15; return 8 * (i >> 2) + 4 * n + (i & 3); }

__device__ __forceinline__ const char* uni(const char* p) { const unsigned long long v = (unsigned long long)p;
    const unsigned lo = __builtin_amdgcn_readfirstlane((unsigned)v), hi = __builtin_amdgcn_readfirstlane((unsigned)(v >> 32)); return (const char*)(((unsigned long long)hi << 32) | lo); }
struct Unit { int pm, pn, aux; const char* a; const char* b; };

typedef f32x4 Acc[2][2][4][2];

template <int lda, int ldb, int K, bool GATHER = false, class Epi, class Sched>
__device__ __forceinline__ void gemm_phase(LAS unsigned char* lds, const int wid, const Sched& S, const Epi& E, const int* gidx = nullptr) {
    const int lane = lane_id_fresh(), tid = wid * 64 + lane, wr = wid >> 2, wc = wid & 3, fr = lane & 15, fq = lane >> 4;
    constexpr int nt = K / BK;
    unsigned voffA, voffB;
    { int R, C; stage_rc(tid * 16, R, C); const int Rb = (R & ~31) + perm32(R & 31); voffA = (unsigned)(R * lda + C) * 2u; voffB = (unsigned)(Rb * ldb + C) * 2u; }
    constexpr size_t pstepA = (size_t)64 * lda * 2, pstepB = (size_t)64 * ldb * 2;
    constexpr size_t kstep = (size_t)(BK * 2);
    constexpr size_t hstepA = (size_t)HALF * lda * 2, hstepB = (size_t)HALF * ldb * 2;
    const unsigned ldsw = (unsigned)wid * 1024u;
    const int aoff = lds_byte(wr * 64 + fr, fq * 8), boff = lds_byte(wc * 32 + fr, fq * 8);
#define PG8_SA(b, h) (((b) * 2 + (h)) * HTB)
#define PG8_SB(b, h) ((4 + (b) * 2 + (h)) * HTB)
#define PG8_STAGE(bufoff, gbase, X) do { _Pragma("unroll") for (int _i = 0; _i < 2; ++_i) \
        __builtin_amdgcn_global_load_lds((const unsigned*)(uni((const char*)(gbase) + (size_t)_i * pstep##X) + voff##X), (LAS unsigned*)(lds + (bufoff) + ldsw + _i * 8192), 16, 0, 0); } while (0)
#define PG8_STAGE_A(bufoff, kp, h, OFF) do { _Pragma("unroll") for (int _i = 0; _i < 2; ++_i) { \
        if constexpr (GATHER) __builtin_amdgcn_global_load_lds((const unsigned*)(uni((const char*)(kp)) + OFF[h][_i]), (LAS unsigned*)(lds + (bufoff) + ldsw + _i * 8192), 16, 0, 0); \
        else __builtin_amdgcn_global_load_lds((const unsigned*)(uni((const char*)(kp) + (size_t)(h) * hstepA + (size_t)_i * pstepA) + voffA), (LAS unsigned*)(lds + (bufoff) + ldsw + _i * 8192), 16, 0, 0); } } while (0)
#define PG8_LDA(dst, b, h) do { _Pragma("unroll") for (int m = 0; m < 4; ++m) _Pragma("unroll") for (int k = 0; k < 2; ++k) dst[m][k] = *(const LAS bf16x8*)(lds + PG8_SA(b, h) + aoff + m * 2048 + k * 1024); } while (0)
#define PG8_LDB(dst, b, h) do { _Pragma("unroll") for (int n = 0; n < 2; ++n) _Pragma("unroll") for (int k = 0; k < 2; ++k) dst[n][k] = *(const LAS bf16x8*)(lds + PG8_SB(b, h) + boff + n * 2048 + k * 1024); } while (0)
#define PG8_MMA(ai, bj, At, Bt) do { __builtin_amdgcn_s_setprio(1); _Pragma("unroll") for (int m = 0; m < 4; ++m) _Pragma("unroll") for (int n = 0; n < 2; ++n) _Pragma("unroll") for (int k = 0; k < 2; ++k) \
        acc[ai][bj][m][n] = __builtin_amdgcn_mfma_f32_16x16x32_bf16(Bt[n][k], At[m][k], acc[ai][bj][m][n], 0, 0, 0); __builtin_amdgcn_s_setprio(0); } while (0)
#define PG8_WAIT_V(n) asm volatile("s_waitcnt vmcnt(" #n ")" ::: "memory")
#define PG8_WAIT_L(n) asm volatile("s_waitcnt lgkmcnt(" #n ")" ::: "memory")
#define PG8_BAR __builtin_amdgcn_s_barrier()
#define PG8_SCHED __builtin_amdgcn_sched_barrier(0)
    Unit cur, nxt; int ui = 0;
    if (!S.next(0, cur)) return;
    Acc acc;
#pragma unroll
    for (int a = 0; a < 2; ++a)
#pragma unroll
        for (int b = 0; b < 2; ++b)
#pragma unroll
            for (int m = 0; m < 4; ++m)
#pragma unroll
                for (int n = 0; n < 2; ++n) acc[a][b][m][n] = (f32x4){0.f, 0.f, 0.f, 0.f};
    bf16x8 At[4][2], B0[2][2], B1[2][2];
    const char* cA = cur.a; const char* cB = cur.b;
    unsigned go[2][2], gn[2][2];
    LAS const unsigned* lidx = (LAS const unsigned*)(lds + STAGE_BYTES);
    if constexpr (GATHER) {
        { Unit uu; for (int i = 0; S.next(i, uu); ++i) if (tid < 256) ((LAS unsigned*)lidx)[i * 256 + tid] = (unsigned)gidx[uu.pm * 256 + tid] * (unsigned)(lda * 2); }
        asm volatile("s_waitcnt vmcnt(0) lgkmcnt(0)" ::: "memory"); PG8_BAR; asm volatile("" ::: "memory");
        int R, C; stage_rc(tid * 16, R, C);
#pragma unroll
        for (int h = 0; h < 2; ++h)
#pragma unroll
            for (int i = 0; i < 2; ++i) { go[h][i] = lidx[h * 128 + i * 64 + R] + (unsigned)(C * 2); gn[h][i] = go[h][i]; }
    }
    PG8_STAGE(PG8_SB(0, 0), cB, B); PG8_STAGE(PG8_SB(0, 1), cB + hstepB, B); PG8_STAGE_A(PG8_SA(0, 0), cA, 0, go); PG8_STAGE_A(PG8_SA(0, 1), cA, 1, go);
    if (wr == 1) PG8_BAR;
    PG8_WAIT_V(2); PG8_BAR;
    PG8_STAGE(PG8_SB(1, 0), cB + kstep, B); PG8_STAGE_A(PG8_SA(1, 0), cA + kstep, 0, go); PG8_STAGE(PG8_SB(1, 1), cB + hstepB + kstep, B);
    PG8_WAIT_V(6); PG8_BAR;
    for (;;) {
        const bool has_next = S.next(ui + 1, nxt);
        const char* nA = has_next ? nxt.a : cA; const char* nB = has_next ? nxt.b : cB;
        for (int t = 0; t < nt; t += 2) {
            const bool last = (t == nt - 2);
            const char* a1 = cA + (size_t)(t + 1) * kstep;
            const char* a2 = last ? nA : cA + (size_t)(t + 2) * kstep; const char* b2 = last ? nB : cB + (size_t)(t + 2) * kstep;
            const char* a3 = a2 + kstep; const char* b3 = b2 + kstep;
            if constexpr (GATHER) { if (last && has_next) { int R, C; stage_rc(tid * 16, R, C);
#pragma unroll
                for (int h = 0; h < 2; ++h)
#pragma unroll
                    for (int i = 0; i < 2; ++i) gn[h][i] = lidx[(ui + 1) * 256 + h * 128 + i * 64 + R] + (unsigned)(C * 2); } }
            unsigned gx[2][2];
#pragma unroll
            for (int h = 0; h < 2; ++h)
#pragma unroll
                for (int i = 0; i < 2; ++i) gx[h][i] = GATHER ? (last ? gn[h][i] : go[h][i]) : 0u;
            PG8_LDB(B0, 0, 0); PG8_LDB(B1, 0, 1); PG8_SCHED; PG8_LDA(At, 0, 0); PG8_STAGE_A(PG8_SA(1, 1), a1, 1, go);
            PG8_WAIT_V(8); PG8_WAIT_L(0); PG8_BAR; PG8_MMA(0, 0, At, B0); PG8_MMA(0, 1, At, B1); PG8_BAR; PG8_SCHED;
            PG8_LDA(At, 0, 1); PG8_STAGE(PG8_SB(0, 0), b2, B); PG8_STAGE(PG8_SB(0, 1), b2 + hstepB, B); PG8_STAGE_A(PG8_SA(0, 0), a2, 0, gx);
            PG8_WAIT_V(8); PG8_WAIT_L(0); PG8_BAR; PG8_MMA(1, 0, At, B0); PG8_MMA(1, 1, At, B1); PG8_BAR; PG8_SCHED;
            PG8_LDB(B0, 1, 0); PG8_LDB(B1, 1, 1); PG8_SCHED; PG8_LDA(At, 1, 0); PG8_STAGE_A(PG8_SA(0, 1), a2, 1, gx);
            PG8_WAIT_V(8); PG8_WAIT_L(0); PG8_BAR; PG8_MMA(0, 0, At, B0); PG8_MMA(0, 1, At, B1); PG8_BAR; PG8_SCHED;
            PG8_LDA(At, 1, 1); PG8_STAGE(PG8_SB(1, 0), b3, B); PG8_STAGE(PG8_SB(1, 1), b3 + hstepB, B); PG8_STAGE_A(PG8_SA(1, 0), a3, 0, gx);
            PG8_WAIT_V(8); PG8_WAIT_L(0); PG8_BAR; PG8_MMA(1, 0, At, B0); PG8_MMA(1, 1, At, B1); PG8_BAR; PG8_SCHED;
            if constexpr (GATHER) { if (last) {
#pragma unroll
                for (int h = 0; h < 2; ++h)
#pragma unroll
                    for (int i = 0; i < 2; ++i) go[h][i] = gn[h][i]; } }
        }
        if (wr == 0) PG8_BAR;
        { const int le = lane_id_fresh();
          E(acc, cur, wr, wc, le & 15, le >> 4, lds + STAGE_BYTES, wid, le); }
        if (!has_next) break;
#pragma unroll
        for (int a = 0; a < 2; ++a)
#pragma unroll
            for (int b = 0; b < 2; ++b)
#pragma unroll
                for (int m = 0; m < 4; ++m)
#pragma unroll
                    for (int n = 0; n < 2; ++n) acc[a][b][m][n] = (f32x4){0.f, 0.f, 0.f, 0.f};
        cur = nxt; cA = nA; cB = nB; ++ui;
        if (wr == 1) PG8_BAR;
    }
    PG8_WAIT_V(0);
    PG8_BAR;
#undef PG8_SA
#undef PG8_SB
#undef PG8_STAGE
#undef PG8_STAGE_A
#undef PG8_LDA
#undef PG8_LDB
#undef PG8_MMA
#undef PG8_WAIT_V
#undef PG8_WAIT_L
#undef PG8_BAR
#undef PG8_SCHED
}

struct DenseOrder {
    int nM, nN, nwg, G, c; const char* A; const char* Bt; size_t tA, tB; int bdiv; size_t bstride;
    __device__ __forceinline__ void init(int M, int N, int G_, int c_, const void* A_, int lda, const void* Bt_, int ldb, int bdiv_ = 0, size_t bstride_ = 0) {
        nM = M / BM; nN = N / BM; nwg = nM * nN; G = G_; c = c_; A = (const char*)A_; Bt = (const char*)Bt_; tA = (size_t)BM * lda * 2; tB = (size_t)BM * ldb * 2; bdiv = bdiv_; bstride = bstride_; }
    __device__ __forceinline__ bool next(int i, Unit& u) const {
        const long L = (long)i * G + c; if (L >= nwg) return false;
        int wgid = (int)L; { const int q = nwg / NXCD, r = nwg % NXCD, xcd = wgid % NXCD, off = wgid / NXCD; wgid = (xcd < r ? xcd * (q + 1) : r * (q + 1) + (xcd - r) * q) + off; }
        const int nig = WGM * nN, gid = wgid / nig, fm = gid * WGM, gsz = (nM - fm) < WGM ? (nM - fm) : WGM;
        u.pm = fm + ((wgid % nig) % gsz); u.pn = (wgid % nig) / gsz; u.aux = 0;
        u.a = A + (size_t)u.pm * tA; u.b = Bt + (size_t)u.pn * tB + (bdiv ? (size_t)(u.pm / bdiv) * bstride : 0);
        return true;
    }
};
}

using pg8::Acc; using pg8::Unit;
#define EPI_ARGS Acc& acc, const Unit& u, int wr, int wc, int fr, int fq, LAS unsigned char* ldsx, int wid, int lane
struct EpiBf16 {
    bf16_t* O; int ldc;
    __device__ __forceinline__ void operator()(EPI_ARGS) const {
        bf16_t* base = O + (size_t)(u.pm * 256 + wr * 64 + fr) * ldc + u.pn * 256 + wc * 32 + 8 * fq;
#pragma unroll
        for (int ai = 0; ai < 2; ++ai)
#pragma unroll
            for (int m = 0; m < 4; ++m)
#pragma unroll
                for (int bj = 0; bj < 2; ++bj) { const f32x4 v0 = acc[ai][bj][m][0], v1 = acc[ai][bj][m][1]; u32x4 w;
                    w.x = cvt_pk_bf16(v0[0], v0[1]); w.y = cvt_pk_bf16(v0[2], v0[3]); w.z = cvt_pk_bf16(v1[0], v1[1]); w.w = cvt_pk_bf16(v1[2], v1[3]);
                    *(u32x4*)(base + (size_t)(ai * 128 + m * 16) * ldc + bj * 128) = w; }
    }
};
struct EpiBf16Aux {
    bf16_t* O; int ldc;
    __device__ __forceinline__ void operator()(EPI_ARGS) const {
        bf16_t* base = O + (size_t)(unsigned)u.aux + (size_t)(wr * 64 + fr) * ldc + wc * 32 + 8 * fq;
#pragma unroll
        for (int ai = 0; ai < 2; ++ai)
#pragma unroll
            for (int m = 0; m < 4; ++m)
#pragma unroll
                for (int bj = 0; bj < 2; ++bj) { const f32x4 v0 = acc[ai][bj][m][0], v1 = acc[ai][bj][m][1]; u32x4 w;
                    w.x = cvt_pk_bf16(v0[0], v0[1]); w.y = cvt_pk_bf16(v0[2], v0[3]); w.z = cvt_pk_bf16(v1[0], v1[1]); w.w = cvt_pk_bf16(v1[2], v1[3]);
                    *(u32x4*)(base + (size_t)(ai * 128 + m * 16) * ldc + bj * 128) = w; }
    }
};
struct EpiInProj {
    bf16_t *GB, *Z, *UG, *VG;
    __device__ __forceinline__ void operator()(EPI_ARGS) const {
        const int pn = u.pn; const size_t row0 = (size_t)(u.pm * 256 + wr * 64 + fr); const int cl = wc * 32 + 8 * fq;
        if (pn >= 2 && pn < 6) {
            bf16_t* base = Z + row0 * 512 + (pn - 2) * 128 + cl;
#pragma unroll
            for (int ai = 0; ai < 2; ++ai)
#pragma unroll
                for (int m = 0; m < 4; ++m) { const f32x4 z0 = acc[ai][0][m][0] * acc[ai][1][m][0], z1 = acc[ai][0][m][1] * acc[ai][1][m][1]; u32x4 w;
                    w.x = cvt_pk_bf16(z0[0], z0[1]); w.y = cvt_pk_bf16(z0[2], z0[3]); w.z = cvt_pk_bf16(z1[0], z1[1]); w.w = cvt_pk_bf16(z1[2], z1[3]);
                    *(u32x4*)(base + (size_t)(ai * 128 + m * 16) * 512) = w; }
        } else {
            const bool act = pn >= 6;
            const int sel = pn < 2 ? 0 : (pn < 8 ? 2 : 3), ct = pn < 2 ? pn : (pn < 8 ? pn - 6 : pn - 8);
            bf16_t* base = GB + (size_t)sel * (16u << 20) + row0 * 512 + ct * 256 + cl;
#pragma unroll
            for (int ai = 0; ai < 2; ++ai)
#pragma unroll
                for (int m = 0; m < 4; ++m)
#pragma unroll
                    for (int bj = 0; bj < 2; ++bj) { f32x4 v0 = acc[ai][bj][m][0], v1 = acc[ai][bj][m][1];
                        if (act) {
#pragma unroll
                            for (int i = 0; i < 4; ++i) { v0[i] = gelu_fast(v0[i]); v1[i] = gelu_fast(v1[i]); } }
                        u32x4 w; w.x = cvt_pk_bf16(v0[0], v0[1]); w.y = cvt_pk_bf16(v0[2], v0[3]); w.z = cvt_pk_bf16(v1[0], v1[1]); w.w = cvt_pk_bf16(v1[2], v1[3]);
                        *(u32x4*)(base + (size_t)(ai * 128 + m * 16) * 512 + bj * 128) = w; }
        }
    }
};
struct EpiResidA {
    const float* R; bf16_t* XB; float* SSQ;
    __device__ __forceinline__ void operator()(EPI_ARGS) const {
        const size_t row0 = (size_t)(u.pm * 256 + wr * 64 + fr); const int col0 = u.pn * 256 + wc * 32 + 8 * fq;
#pragma unroll
        for (int ai = 0; ai < 2; ++ai)
#pragma unroll
            for (int m = 0; m < 4; ++m) { const size_t off = (row0 + ai * 128 + m * 16) * 1024 + col0; float sq = 0.f;
#pragma unroll
                for (int bj = 0; bj < 2; ++bj) { const f32x4 r0 = __builtin_nontemporal_load((const f32x4*)(R + off + bj * 128)), r1 = __builtin_nontemporal_load((const f32x4*)(R + off + bj * 128 + 4));
                    const f32x4 v0 = r0 + acc[ai][bj][m][0], v1 = r1 + acc[ai][bj][m][1];
                    u32x4 w; w.x = cvt_pk_bf16(v0[0], v0[1]); w.y = cvt_pk_bf16(v0[2], v0[3]); w.z = cvt_pk_bf16(v1[0], v1[1]); w.w = cvt_pk_bf16(v1[2], v1[3]); *(u32x4*)(XB + off + bj * 128) = w;
                    sq += (v0[0] * v0[0] + v0[1] * v0[1]) + (v0[2] * v0[2] + v0[3] * v0[3]) + (v1[0] * v1[0] + v1[1] * v1[1]) + (v1[2] * v1[2] + v1[3] * v1[3]); }
                sq += __shfl_xor(sq, 16); sq += __shfl_xor(sq, 32); if (fq == 0) SSQ[(row0 + ai * 128 + m * 16) * 16 + u.pn * 4 + wc] = sq;
                if (m & 1) asm volatile("" ::: "memory"); }
    }
};
struct EpiResidB {
    const bf16_t* RB; bf16_t* XB;
    __device__ __forceinline__ void operator()(EPI_ARGS) const {
        const size_t row0 = (size_t)(u.pm * 256 + wr * 64 + fr); const int col0 = u.pn * 256 + wc * 32 + 8 * fq;
#pragma unroll
        for (int ai = 0; ai < 2; ++ai)
#pragma unroll
            for (int m = 0; m < 4; ++m) { const size_t off = (row0 + ai * 128 + m * 16) * 1024 + col0;
#pragma unroll
                for (int bj = 0; bj < 2; ++bj) { const u32x4 r = __builtin_nontemporal_load((const u32x4*)(RB + off + bj * 128));
                    const f32x4 v0 = (f32x4){bf_lo(r.x), bf_hi(r.x), bf_lo(r.y), bf_hi(r.y)} + acc[ai][bj][m][0], v1 = (f32x4){bf_lo(r.z), bf_hi(r.z), bf_lo(r.w), bf_hi(r.w)} + acc[ai][bj][m][1];
                    u32x4 w; w.x = cvt_pk_bf16(v0[0], v0[1]); w.y = cvt_pk_bf16(v0[2], v0[3]); w.z = cvt_pk_bf16(v1[0], v1[1]); w.w = cvt_pk_bf16(v1[2], v1[3]); *(u32x4*)(XB + off + bj * 128) = w; }
                if (m & 1) asm volatile("" ::: "memory"); }
    }
};
struct EpiSoftmax {
    const float* SSQ; bf16_t* P;
    __device__ __forceinline__ void operator()(EPI_ARGS) const {
        const size_t row0 = (size_t)(u.pm * 256 + wr * 64 + fr);
        LAS f32x2* ex = (LAS f32x2*)ldsx;
        float mw[2][4];
#pragma unroll
        for (int ai = 0; ai < 2; ++ai)
#pragma unroll
            for (int m = 0; m < 4; ++m) {
                const f32x4* q = (const f32x4*)(SSQ + (row0 + ai * 128 + m * 16) * 16);
                const f32x4 q0 = q[0], q1 = q[1], q2 = q[2], q3 = q[3];
                const float ss = ((q0[0] + q0[1]) + (q0[2] + q0[3])) + ((q1[0] + q1[1]) + (q1[2] + q1[3])) + ((q2[0] + q2[1]) + (q2[2] + q2[3])) + ((q3[0] + q3[1]) + (q3[2] + q3[3]));
                const float rs = rsqrtf(ss * (1.f / 1024.f) + EPS);
                float mx = -3.0e38f;
#pragma unroll
                for (int bj = 0; bj < 2; ++bj)
#pragma unroll
                    for (int n = 0; n < 2; ++n) { f32x4 v = acc[ai][bj][m][n] * rs; acc[ai][bj][m][n] = v; mx = fmaxf(fmaxf(mx, fmaxf(v[0], v[1])), fmaxf(v[2], v[3])); }
                mx = fmaxf(mx, __shfl_xor(mx, 16)); mx = fmaxf(mx, __shfl_xor(mx, 32));
                float sum = 0.f;
#pragma unroll
                for (int bj = 0; bj < 2; ++bj)
#pragma unroll
                    for (int n = 0; n < 2; ++n) { f32x4 v = acc[ai][bj][m][n];
#pragma unroll
                        for (int i = 0; i < 4; ++i) v[i] = __builtin_amdgcn_exp2f(v[i] - mx);
                        acc[ai][bj][m][n] = v; sum += (v[0] + v[1]) + (v[2] + v[3]); }
                sum += __shfl_xor(sum, 16); sum += __shfl_xor(sum, 32);
                mw[ai][m] = mx;
                if (fq == 0) ex[(ai * 128 + wr * 64 + m * 16 + fr) * 4 + wc] = (f32x2){mx, sum};
            }
        asm volatile("s_waitcnt lgkmcnt(0)" ::: "memory"); __builtin_amdgcn_s_barrier(); asm volatile("" ::: "memory");
        bf16_t* base = P + row0 * 1024 + u.pn * 256 + wc * 32 + 8 * fq;
#pragma unroll
        for (int ai = 0; ai < 2; ++ai)
#pragma unroll
            for (int m = 0; m < 4; ++m) {
                const LAS f32x2* e4 = ex + (ai * 128 + wr * 64 + m * 16 + fr) * 4;
                const f32x2 e0 = e4[0], e1 = e4[1], e2 = e4[2], e3 = e4[3];
                const float M = fmaxf(fmaxf(e0.x, e1.x), fmaxf(e2.x, e3.x));
                const float L = e0.y * __builtin_amdgcn_exp2f(e0.x - M) + e1.y * __builtin_amdgcn_exp2f(e1.x - M) + e2.y * __builtin_amdgcn_exp2f(e2.x - M) + e3.y * __builtin_amdgcn_exp2f(e3.x - M);
                const float f = __builtin_amdgcn_exp2f(mw[ai][m] - M) / L;
#pragma unroll
                for (int bj = 0; bj < 2; ++bj) { const f32x4 v0 = acc[ai][bj][m][0] * f, v1 = acc[ai][bj][m][1] * f; u32x4 w;
                    w.x = cvt_pk_bf16(v0[0], v0[1]); w.y = cvt_pk_bf16(v0[2], v0[3]); w.z = cvt_pk_bf16(v1[0], v1[1]); w.w = cvt_pk_bf16(v1[2], v1[3]);
                    *(u32x4*)(base + (size_t)(ai * 128 + m * 16) * 1024 + bj * 128) = w; }
            }
    }
};
struct WqkOrder {
    int G, c; const char* KV; const char* WQ;
    __device__ __forceinline__ bool next(int i, Unit& u) const {
        const int L = i * G + c; if (L >= 128) return false;
        const int b = L >> 4, h = (L >> 2) & 3, pn = L & 3;
        u.pm = 0; u.pn = pn; u.a = KV + ((size_t)(b * 256) * 2048 + h * 256) * 2; u.b = WQ + ((size_t)(pn * 256) * 1024 + h * 256) * 2;
        u.aux = b * (1024 * 1024) + (h * 256) * 1024 + pn * 256; return true; }
};
struct VwOrder {
    int G, c; const char* KV; const char* WO;
    __device__ __forceinline__ bool next(int i, Unit& u) const {
        const int L = i * G + c; if (L >= 128) return false;
        const int b = L >> 4, h = (L >> 2) & 3, pm = L & 3;
        u.pm = pm; u.pn = 0; u.a = WO + ((size_t)(pm * 256) * 1024 + h * 256) * 2; u.b = KV + ((size_t)(b * 256) * 2048 + 1024 + h * 256) * 2;
        u.aux = b * (1024 * 1024) + (pm * 256) * 1024 + h * 256; return true; }
};

struct EpiSwiGLU {
    bf16_t* H; const float* rs_slot;
    __device__ __forceinline__ void operator()(EPI_ARGS) const {
        const size_t row0 = (size_t)(u.pm * 256 + wr * 64 + fr);
        bf16_t* base = H + row0 * 512 + u.pn * 128 + wc * 32 + 8 * fq;
#pragma unroll
        for (int ai = 0; ai < 2; ++ai)
#pragma unroll
            for (int m = 0; m < 4; ++m) { const float rs = rs_slot[row0 + ai * 128 + m * 16]; f32x4 h0, h1;
#pragma unroll
                for (int i = 0; i < 4; ++i) { const float g0 = acc[ai][0][m][0][i] * rs, g1 = acc[ai][0][m][1][i] * rs;
                    h0[i] = g0 * __builtin_amdgcn_rcpf(1.0f + __builtin_amdgcn_exp2f(-1.4426950408889634f * g0)) * (acc[ai][1][m][0][i] * rs);
                    h1[i] = g1 * __builtin_amdgcn_rcpf(1.0f + __builtin_amdgcn_exp2f(-1.4426950408889634f * g1)) * (acc[ai][1][m][1][i] * rs); }
                u32x4 w; w.x = cvt_pk_bf16(h0[0], h0[1]); w.y = cvt_pk_bf16(h0[2], h0[3]); w.z = cvt_pk_bf16(h1[0], h1[1]); w.w = cvt_pk_bf16(h1[2], h1[3]);
                *(u32x4*)(base + (size_t)(ai * 128 + m * 16) * 512) = w; }
    }
};
struct EpiDown {
    bf16_t* Y; const float* gate;
    __device__ __forceinline__ void operator()(EPI_ARGS) const {
        const size_t row0 = (size_t)(u.pm * 256 + wr * 64 + fr);
        bf16_t* base = Y + row0 * 1024 + u.pn * 256 + wc * 32 + 8 * fq;
#pragma unroll
        for (int ai = 0; ai < 2; ++ai)
#pragma unroll
            for (int m = 0; m < 4; ++m) { const float g = gate[row0 + ai * 128 + m * 16];
#pragma unroll
                for (int bj = 0; bj < 2; ++bj) { const f32x4 v0 = acc[ai][bj][m][0] * g, v1 = acc[ai][bj][m][1] * g; u32x4 w;
                    w.x = cvt_pk_bf16(v0[0], v0[1]); w.y = cvt_pk_bf16(v0[2], v0[3]); w.z = cvt_pk_bf16(v1[0], v1[1]); w.w = cvt_pk_bf16(v1[2], v1[3]);
                    *(u32x4*)(base + (size_t)(ai * 128 + m * 16) * 1024 + bj * 128) = w; } }
    }
};
struct GroupedOrder {
    int G, c, nunits; const int* tile_e; const char* A; const char* W; size_t tA, wE, tB;
    __device__ __forceinline__ void init(int G_, int c_, const int* tbl, const void* A_, int lda, const void* W_, int ldb, size_t expert_bytes, bool gather = false) {
        G = G_; c = c_; tile_e = tbl + 16; nunits = 4 * __builtin_amdgcn_readfirstlane(__hip_atomic_load(tbl, __ATOMIC_RELAXED, __HIP_MEMORY_SCOPE_AGENT)); A = (const char*)A_; W = (const char*)W_; tA = gather ? 0 : (size_t)256 * lda * 2; tB = (size_t)256 * ldb * 2; wE = expert_bytes; }
    __device__ __forceinline__ bool next(int i, Unit& u) const {
        const int L = i * G + c; if (L >= nunits) return false;
        int wgid = L; { const int q = nunits / 8, r = nunits % 8, xcd = wgid % 8, off = wgid / 8; wgid = (xcd < r ? xcd * (q + 1) : r * (q + 1) + (xcd - r) * q) + off; }
        const int tile = wgid >> 2, pn = wgid & 3, e = __builtin_amdgcn_readfirstlane(__hip_atomic_load(tile_e + tile, __ATOMIC_RELAXED, __HIP_MEMORY_SCOPE_AGENT));
        u.pm = tile; u.pn = pn; u.aux = e; u.a = A + (size_t)tile * tA; u.b = W + (size_t)e * wE + (size_t)pn * tB; return true; }
};

struct Args {
    const float* in[26]; float* out; unsigned char* ws; int ph_lo, ph_hi;
};
struct Frame {
    LAS unsigned char* lds; int wave, vcu, G; unsigned char* ws; float* out;
};
#define IN_X 0
#define IN_MEM 1
#define IN_G_MIX 2
#define IN_W_IN 3
#define IN_CONV_W 4
#define IN_G_V 5
#define IN_W_S 6
#define IN_B_S 7
#define IN_G_OUT_CONV 8
#define IN_G_OUT_GMLP 9
#define IN_W_OUT 10
#define IN_G_XATTN 11
#define IN_G_MEM 12
#define IN_W_Q 13
#define IN_W_K 14
#define IN_W_V 15
#define IN_W_O 16
#define IN_G_FFN 17
#define IN_W_GRP 18
#define IN_B_GRP 19
#define IN_W_RT 20
#define IN_B_RT 21
#define IN_W_GATE 22
#define IN_W_UP 23
#define IN_W_DOWN 24
#define IN_G_FINAL 25

struct TrItem { const float* src; bf16_t* dst; const float* gk; int ldw, K; };
__device__ __forceinline__ void tr_load(const TrItem& t, float (&v)[32], int lane) {
    const float* p = t.src + (size_t)(lane >> 5) * t.ldw + (lane & 31);
#pragma unroll
    for (int i = 0; i < 32; ++i) v[i] = __builtin_nontemporal_load(p + (size_t)(2 * i) * t.ldw);
}
__device__ __forceinline__ void tr_finish(const TrItem& t, const float (&v)[32], LAS float* scr, int lane) {
    float g8[8];
    if (t.gk) { const f32x4 ga = *(const f32x4*)(t.gk + 8 * (lane & 7)), gb = *(const f32x4*)(t.gk + 8 * (lane & 7) + 4); g8[0] = ga[0]; g8[1] = ga[1]; g8[2] = ga[2]; g8[3] = ga[3]; g8[4] = gb[0]; g8[5] = gb[1]; g8[6] = gb[2]; g8[7] = gb[3]; }
    else {
#pragma unroll
        for (int j = 0; j < 8; ++j) g8[j] = 1.f; }
#pragma unroll
    for (int i = 0; i < 32; ++i) scr[(2 * i + (lane >> 5)) * 33 + (lane & 31)] = v[i];
    LDS_WAIT(); asm volatile("" ::: "memory");
    const int c = lane & 7;
#pragma unroll
    for (int j = 0; j < 4; ++j) { const int n = (lane >> 3) + 8 * j; const LAS float* s = scr + (8 * c) * 33 + n;
        u32x4 o; o.x = pk2(s[0 * 33] * g8[0], s[1 * 33] * g8[1]); o.y = pk2(s[2 * 33] * g8[2], s[3 * 33] * g8[3]); o.z = pk2(s[4 * 33] * g8[4], s[5 * 33] * g8[5]); o.w = pk2(s[6 * 33] * g8[6], s[7 * 33] * g8[7]);
        *(u32x4*)(t.dst + (size_t)n * t.K + 8 * c) = o; }
    LDS_WAIT(); asm volatile("" ::: "memory");
}
__device__ __forceinline__ TrItem tr_make(const float* W, int ldw, int K, bf16_t* WT, int dst_row0, int src_col0, int k0, const float* gk = nullptr) {
    TrItem t; t.src = W + (size_t)k0 * ldw + src_col0; t.dst = WT + (size_t)dst_row0 * K + k0; t.gk = gk ? gk + k0 : nullptr; t.ldw = ldw; t.K = K; return t; }
__device__ __forceinline__ int in_map(int n0) {
    if (n0 < 512 || n0 >= 1536) return n0;
    const int j = (n0 - 512) >> 8, r = (n0 - 512) & 255;
    return r < 128 ? 512 + 128 * j + r : 1024 + 128 * j + (r - 128);
}
__device__ __forceinline__ void norm_row_bf16(const float* xrow, const float* g, bf16_t* orow, int lane) {
    const f32x4* xr = (const f32x4*)xrow + lane; const f32x4* gr = (const f32x4*)g + lane;
    f32x4 v[4]; float s = 0.f;
#pragma unroll
    for (int j = 0; j < 4; ++j) { v[j] = xr[64 * j]; s += (v[j].x * v[j].x + v[j].y * v[j].y) + (v[j].z * v[j].z + v[j].w * v[j].w); }
    const float rs = rsqrtf(wave_sum(s) * (1.f / 1024.f) + EPS);
    u32x2* o8 = (u32x2*)orow + lane;
#pragma unroll
    for (int j = 0; j < 4; ++j) { const f32x4 gg = gr[64 * j]; u32x2 w; w.x = pk2(v[j].x * rs * gg.x, v[j].y * rs * gg.y); w.y = pk2(v[j].z * rs * gg.z, v[j].w * rs * gg.w); o8[64 * j] = w; }
}
__device__ __forceinline__ void norm_rows4_bf16(const float* X, const float* g, bf16_t* O, int m, int stride, int M, int lane) {
    f32x4 v[4][4]; float s[4]; const f32x4* gr = (const f32x4*)g + lane;
#pragma unroll
    for (int r = 0; r < 4; ++r) { const int mr = (m + r * stride < M) ? m + r * stride : m; const f32x4* xr = (const f32x4*)(X + (size_t)mr * 1024) + lane;
#pragma unroll
        for (int j = 0; j < 4; ++j) v[r][j] = __builtin_nontemporal_load(xr + 64 * j); }
#pragma unroll
    for (int r = 0; r < 4; ++r) { s[r] = 0.f;
#pragma unroll
        for (int j = 0; j < 4; ++j) s[r] += (v[r][j].x * v[r][j].x + v[r][j].y * v[r][j].y) + (v[r][j].z * v[r][j].z + v[r][j].w * v[r][j].w); }
#pragma unroll
    for (int r = 0; r < 4; ++r) { if (m + r * stride >= M) break; const float rs = rsqrtf(wave_sum(s[r]) * (1.f / 1024.f) + EPS); u32x2* o8 = (u32x2*)(O + (size_t)(m + r * stride) * 1024) + lane;
#pragma unroll
        for (int j = 0; j < 4; ++j) { const f32x4 gg = gr[64 * j]; u32x2 w; w.x = pk2(v[r][j].x * rs * gg.x, v[r][j].y * rs * gg.y); w.y = pk2(v[r][j].z * rs * gg.z, v[r][j].w * rs * gg.w); o8[64 * j] = w; } }
}
constexpr int PRO_I_IN = 16 * 80, PRO_I_SQ = 16 * 32, PRO_I_G = 16 * 16, PRO_I_D = 8 * 32, PRO_NITEMS = PRO_I_IN + 4 * PRO_I_SQ + NE * (2 * PRO_I_G + PRO_I_D);
__device__ __forceinline__ TrItem pro_item(const Args& a, unsigned char* ws, int it) {
    int r = it;
    if (r < PRO_I_IN) { const int kb = r / 80, nb = r % 80; return tr_make(a.in[IN_W_IN], INC, D, (bf16_t*)(ws + WS_WIN_T), 32 * nb, in_map(32 * nb), 64 * kb); } r -= PRO_I_IN;
    if (r < 4 * PRO_I_SQ) { const int q = r / PRO_I_SQ; r -= q * PRO_I_SQ; const int kb = r / 32, nb = r % 32;
        const float* W = a.in[q == 0 ? IN_W_OUT : (q == 1 ? IN_W_O : (q == 2 ? IN_W_K : IN_W_V))];
        bf16_t* WT = (bf16_t*)(ws + (q == 0 ? WS_WOUT_T : (q == 1 ? WS_WO_T : WS_WKV_T)));
        return tr_make(W, D, D, WT, (q == 3 ? 1024 : 0) + 32 * nb, 32 * nb, 64 * kb); }
    r -= 4 * PRO_I_SQ;
    const int e = r / (2 * PRO_I_G + PRO_I_D); r -= e * (2 * PRO_I_G + PRO_I_D);
    if (r < 2 * PRO_I_G) { const int up = r >= PRO_I_G; if (up) r -= PRO_I_G; const int kb = r / 16, nb = r % 16, n0 = 32 * nb;
        const int dst = 256 * (n0 >> 7) + (up ? 128 : 0) + (n0 & 127);
        return tr_make(a.in[up ? IN_W_UP : IN_W_GATE] + (size_t)e * D * DE, DE, D, (bf16_t*)(ws + WS_WGU_T) + (size_t)e * 1024 * 1024, dst, n0, 64 * kb, a.in[IN_G_FFN]); }
    r -= 2 * PRO_I_G;
    const int kb = r / 32, nb = r % 32;
    return tr_make(a.in[IN_W_DOWN] + (size_t)e * DE * D, D, DE, (bf16_t*)(ws + WS_WD_T) + (size_t)e * 1024 * 512, 32 * nb, 32 * nb, 64 * kb);
}
__device__ __forceinline__ void p0_prologue(const Frame& F, const Args& a) {
    LAS float* scr = (LAS float*)(F.lds + F.wave * 16384);
    const int lane = lane_id_fresh(), tid = F.wave * 64 + lane;
    unsigned char* ws = F.ws;
    const int gw = F.vcu * NWAVES + F.wave, NGW = F.G * NWAVES;
    {
        float va[32], vb[32]; TrItem ta, tb;
        int it = gw;
        if (it < PRO_NITEMS) { ta = pro_item(a, ws, it); tr_load(ta, va, lane); }
        while (it < PRO_NITEMS) {
            const int i1 = it + NGW; const bool h1 = i1 < PRO_NITEMS;
            if (h1) { tb = pro_item(a, ws, i1); tr_load(tb, vb, lane); }
            tr_finish(ta, va, scr, lane);
            if (!h1) break;
            const int i2 = i1 + NGW; const bool h2 = i2 < PRO_NITEMS;
            if (h2) { ta = pro_item(a, ws, i2); tr_load(ta, va, lane); }
            tr_finish(tb, vb, scr, lane);
            it = i2;
        }
    }
    for (int m = gw; m < T; m += 4 * NGW) norm_rows4_bf16(a.in[IN_X], a.in[IN_G_MIX], (bf16_t*)(ws + WS_HB), m, NGW, T, lane);
    for (int m = gw; m < B * ML; m += NGW) norm_row_bf16(a.in[IN_MEM] + (size_t)m * D, a.in[IN_G_MEM], (bf16_t*)(ws + WS_MEMN) + (size_t)m * D, lane);
    const int gt = F.vcu * NTHREADS + tid, NGT = F.G * NTHREADS;
    { const float* wq = a.in[IN_W_Q]; const float* gx = a.in[IN_G_XATTN]; bf16_t* o = (bf16_t*)(ws + WS_WQ_NAT);
      for (int i = gt; i < D * D / 2; i += NGT) { const int k = (2 * i) >> 10; const float sc = gx[k] * (1.4426950408889634f * 0.0625f); const f32x2 v = *(const f32x2*)(wq + 2 * i); *(unsigned*)(o + 2 * i) = pk2(v.x * sc, v.y * sc); } }
    { const float* w = a.in[IN_W_S]; bf16_t* o = (bf16_t*)(ws + WS_WS_BF);
      for (int i = gt; i < NH * CHUNK * CHUNK; i += NGT) { const int s = i & 127, t = (i >> 7) & 127; o[i] = (bf16_t)f2bf(s <= t ? w[i] : 0.f); } }
    { const float* wg = a.in[IN_W_GRP]; const float* wr = a.in[IN_W_RT]; const float* gf = a.in[IN_G_FFN]; bf16_t* o = (bf16_t*)(ws + WS_WR);
      for (int i = gt; i < 48 * 1024; i += NGT) { const int n = i >> 10, k = i & 1023; float v = 0.f;
          if (n < 4) v = wg[(size_t)k * NG + n] * gf[k]; else if (n < 36) v = wr[(size_t)k * NE + (n - 4)] * gf[k];
          const unsigned hi = f2bf(v); const float lo = v - __uint_as_float(hi << 16); o[i] = (bf16_t)hi; o[48 * 1024 + i] = (bf16_t)f2bf(lo); } }
}

__device__ __forceinline__ void unpack8(const u32x4 w, float (&f)[8]) { f[0] = bf_lo(w.x); f[1] = bf_hi(w.x); f[2] = bf_lo(w.y); f[3] = bf_hi(w.y); f[4] = bf_lo(w.z); f[5] = bf_hi(w.z); f[6] = bf_lo(w.w); f[7] = bf_hi(w.w); }
constexpr int VT_PITCH = 136, VT_HEAD = 128 * VT_PITCH, MIX_EXCH = 8 * VT_HEAD;
__device__ __forceinline__ void mixer_unit(const Frame& F, const Args& a, int ch) {
    const int t0 = ch * 128, w = F.wave, l = lane_id_fresh();
    unsigned char* ws = F.ws;
    const bf16_t* GBp = (const bf16_t*)(ws + WS_GB); const bf16_t* Zp = (const bf16_t*)(ws + WS_Z); const bf16_t* UGp = (const bf16_t*)(ws + WS_UG); const bf16_t* VGp = (const bf16_t*)(ws + WS_VG);
    bf16_t* Y = (bf16_t*)(ws + WS_Y);
    __syncthreads();
    const int h = w;
    u32x4 vraw[16], uraw[16];
    {
        const int c = 8 * l;
        const int r0 = 16 * w, pos0 = (t0 & (S - 1)) + r0; const unsigned coff = (unsigned)(c * 2);
        u32x4 gbr[4], zr[4], zh1, zh2;
#pragma unroll
        for (int r = 0; r < 4; ++r) { const size_t t = (size_t)(t0 + r0 + r); gbr[r] = __builtin_nontemporal_load((const u32x4*)(pg8::uni((const char*)(GBp + t * 512)) + coff)); zr[r] = __builtin_nontemporal_load((const u32x4*)(pg8::uni((const char*)(Zp + t * 512)) + coff)); }
        if (pos0 >= 2) { zh1 = *(const u32x4*)(Zp + (size_t)(t0 + r0 - 1) * 512 + c); zh2 = *(const u32x4*)(Zp + (size_t)(t0 + r0 - 2) * 512 + c); } else { zh1 = (u32x4){0u, 0u, 0u, 0u}; zh2 = zh1; }
        asm volatile("" ::: "memory");
        { const unsigned voff = (unsigned)((((l >> 3) * 512) + 8 * (l & 7)) * 2);
#pragma unroll
          for (int it = 0; it < 16; ++it) vraw[it] = __builtin_nontemporal_load((const u32x4*)(pg8::uni((const char*)(VGp + (size_t)(t0 + 8 * it) * 512 + h * 64)) + voff));
 }
        asm volatile("" ::: "memory");
        float w0[8], w1[8], w2[8], ga[8], zp1[8], zp2[8];
        const float* cw = a.in[IN_CONV_W]; const float* gc = a.in[IN_G_OUT_CONV];
#pragma unroll
        for (int j = 0; j < 8; ++j) { w0[j] = cw[c + j]; w1[j] = cw[CW + c + j]; w2[j] = cw[2 * CW + c + j]; ga[j] = gc[c + j]; }
        unpack8(zh1, zp1); unpack8(zh2, zp2);
#pragma unroll 1
        for (int bt = 0; bt < 4; ++bt) {
            if (bt >= 1) {
#pragma unroll
                for (int r = 0; r < 4; ++r) { const size_t t = (size_t)(t0 + r0 + 4 * bt + r); gbr[r] = __builtin_nontemporal_load((const u32x4*)(pg8::uni((const char*)(GBp + t * 512)) + coff)); zr[r] = __builtin_nontemporal_load((const u32x4*)(pg8::uni((const char*)(Zp + t * 512)) + coff)); } }
#pragma unroll
            for (int r = 0; r < 4; ++r) {
                const size_t t = (size_t)(t0 + r0 + 4 * bt + r);
                float gb[8], z[8], ya[8]; unpack8(gbr[r], gb); unpack8(zr[r], z);
                float sq = 0.f;
#pragma unroll
                for (int j = 0; j < 8; ++j) { ya[j] = gb[j] * (w2[j] * z[j] + w1[j] * zp1[j] + w0[j] * zp2[j]); sq += ya[j] * ya[j]; zp2[j] = zp1[j]; zp1[j] = z[j]; }
                const float rs = rsqrtf(wave_sum(sq) * (1.f / 512.f) + EPS);
                u32x4 o; o.x = pk2(ya[0] * rs * ga[0], ya[1] * rs * ga[1]); o.y = pk2(ya[2] * rs * ga[2], ya[3] * rs * ga[3]); o.z = pk2(ya[4] * rs * ga[4], ya[5] * rs * ga[5]); o.w = pk2(ya[6] * rs * ga[6], ya[7] * rs * ga[7]);
                *(u32x4*)(const_cast<char*>(pg8::uni((const char*)(Y + t * 1024))) + coff) = o;
            }
            asm volatile("" ::: "memory");
        }
    }
    asm volatile("" ::: "memory");
    { const unsigned voff = (unsigned)((((l >> 3) * 512) + 8 * (l & 7)) * 2);
#pragma unroll
      for (int it = 0; it < 16; ++it) uraw[it] = __builtin_nontemporal_load((const u32x4*)(pg8::uni((const char*)(UGp + (size_t)(t0 + 8 * it) * 512 + h * 64)) + voff)); }
    LAS unsigned char* vt = F.lds + h * VT_HEAD;
    {
        const int d8 = 8 * (l & 7); float gv[8];
#pragma unroll
        for (int j = 0; j < 8; ++j) gv[j] = a.in[IN_G_V][h * 64 + d8 + j];
#pragma unroll
        for (int it = 0; it < 16; ++it) { const int s = 8 * it + (l >> 3); float v[8]; unpack8(vraw[it], v);
            float sq = 0.f;
#pragma unroll
            for (int j = 0; j < 8; ++j) sq += v[j] * v[j];
            sq += __shfl_xor(sq, 1); sq += __shfl_xor(sq, 2); sq += __shfl_xor(sq, 4);
            const float rs = rsqrtf(sq * (1.f / 64.f) + EPS);
            u32x2 lo, hi; lo.x = pk2(v[0] * rs * gv[0], v[1] * rs * gv[1]); lo.y = pk2(v[2] * rs * gv[2], v[3] * rs * gv[3]); hi.x = pk2(v[4] * rs * gv[4], v[5] * rs * gv[5]); hi.y = pk2(v[6] * rs * gv[6], v[7] * rs * gv[7]);
            *(LAS u32x2*)(vt + s * VT_PITCH + d8 * 2) = lo; *(LAS u32x2*)(vt + s * VT_PITCH + d8 * 2 + 8) = hi; }
    }
    __syncthreads();
    const int fr = l & 15, fq = l >> 4, trq = (l & 15) >> 2, trp = l & 3;
    const bf16_t* wsb = (const bf16_t*)(ws + WS_WS_BF) + (size_t)h * CHUNK * CHUNK;
    const unsigned wloff = (unsigned)(fr * CHUNK + 8 * fq);
    const float* bsp = a.in[IN_B_S] + h * CHUNK;
#pragma unroll 1
    for (int half = 0; half < 2; ++half) {
        f32x4 acc[8][2];
#pragma unroll
        for (int m = 0; m < 8; ++m)
#pragma unroll
            for (int n = 0; n < 2; ++n) acc[m][n] = (f32x4){0.f, 0.f, 0.f, 0.f};
#pragma unroll
        for (int ks = 0; ks < 4; ++ks) {
            unsigned wl = wloff; asm volatile("" : "+v"(wl));
            bf16x8 af[2];
#pragma unroll
            for (int n = 0; n < 2; ++n) { const int dc = 32 * half + 16 * n + 4 * trp;
                const s16x4 lo = __builtin_bit_cast(s16x4, __builtin_amdgcn_ds_read_tr16_b64_v4i16((LAS s16x4*)(vt + (32 * ks + 8 * fq + trq) * VT_PITCH + dc * 2)));
                const s16x4 hi = __builtin_bit_cast(s16x4, __builtin_amdgcn_ds_read_tr16_b64_v4i16((LAS s16x4*)(vt + (32 * ks + 8 * fq + 4 + trq) * VT_PITCH + dc * 2)));
                af[n] = (bf16x8){lo[0], lo[1], lo[2], lo[3], hi[0], hi[1], hi[2], hi[3]}; }
#pragma unroll
            for (int m = 2 * ks; m < 8; ++m) {
                const bf16x8 bfr = *(const bf16x8*)(wsb + (16 * m * CHUNK + 32 * ks) + wl);
#pragma unroll
                for (int n = 0; n < 2; ++n) acc[m][n] = __builtin_amdgcn_mfma_f32_16x16x32_bf16(af[n], bfr, acc[m][n], 0, 0, 0);
            }
        }
#pragma unroll
        for (int m = 0; m < 8; ++m) { const float bs = bsp[16 * m + fr];
#pragma unroll
            for (int n = 0; n < 2; ++n) { const int dc = 32 * half + 16 * n + 4 * fq;
                u32x2 o; o.x = pk2(acc[m][n][0] + bs, acc[m][n][1] + bs); o.y = pk2(acc[m][n][2] + bs, acc[m][n][3] + bs);
                *(LAS u32x2*)(vt + (16 * m + fr) * VT_PITCH + dc * 2) = o; } }
    }
    asm volatile("s_waitcnt lgkmcnt(0)" ::: "memory");
    LAS float* exch = (LAS float*)(F.lds + MIX_EXCH);
    {
        const int d8 = 8 * (l & 7);
#pragma unroll
        for (int it = 0; it < 16; ++it) { const int sidx = 8 * it + (l >> 3);
            const u32x2 lo = *(const LAS u32x2*)(vt + sidx * VT_PITCH + d8 * 2), hi = *(const LAS u32x2*)(vt + sidx * VT_PITCH + d8 * 2 + 8);
            float uf[8]; unpack8(uraw[it], uf);
            const float y0 = uf[0] * bf_lo(lo.x), y1 = uf[1] * bf_hi(lo.x), y2 = uf[2] * bf_lo(lo.y), y3 = uf[3] * bf_hi(lo.y), y4 = uf[4] * bf_lo(hi.x), y5 = uf[5] * bf_hi(hi.x), y6 = uf[6] * bf_lo(hi.y), y7 = uf[7] * bf_hi(hi.y);
            float sq = ((y0 * y0 + y1 * y1) + (y2 * y2 + y3 * y3)) + ((y4 * y4 + y5 * y5) + (y6 * y6 + y7 * y7));
            sq += __shfl_xor(sq, 1); sq += __shfl_xor(sq, 2); sq += __shfl_xor(sq, 4);
            if ((l & 7) == 0) exch[h * CHUNK + sidx] = sq;
            uraw[it] = (u32x4){pk2(y0, y1), pk2(y2, y3), pk2(y4, y5), pk2(y6, y7)}; }
    }
    __syncthreads();
    {
        const int d8 = 8 * (l & 7); float gg[8];
#pragma unroll
        for (int j = 0; j < 8; ++j) gg[j] = a.in[IN_G_OUT_GMLP][h * 64 + d8 + j];
#pragma unroll
        for (int it = 0; it < 16; ++it) { const int sidx = 8 * it + (l >> 3); float tot = 0.f;
#pragma unroll
            for (int hh = 0; hh < 8; ++hh) tot += exch[hh * CHUNK + sidx];
            const float rs = rsqrtf(tot * (1.f / 512.f) + EPS);
            float yf[8]; unpack8(uraw[it], yf);
            u32x4 o; o.x = pk2(yf[0] * rs * gg[0], yf[1] * rs * gg[1]); o.y = pk2(yf[2] * rs * gg[2], yf[3] * rs * gg[3]); o.z = pk2(yf[4] * rs * gg[4], yf[5] * rs * gg[5]); o.w = pk2(yf[6] * rs * gg[6], yf[7] * rs * gg[7]);
            *(u32x4*)(Y + (size_t)(t0 + sidx) * 1024 + 512 + h * 64 + d8) = o; }
    }
}

constexpr int RT_XS_PITCH = 272;
constexpr int RT_XS_WAVE = 16 * RT_XS_PITCH;
constexpr int RT_SLAB_OFF = 8 * RT_XS_WAVE;
constexpr int RT_LG_OFF = RT_SLAB_OFF + 2 * 24576;
__device__ __forceinline__ void router_block(const Frame& F, const Args& a, int blk) {
    const int l = lane_id_fresh(), w = F.wave, fr = l & 15, fq = l >> 4, tid = w * 64 + l;
    unsigned char* ws = F.ws;
    LAS unsigned char* xs = F.lds + w * RT_XS_WAVE;
    LAS float* slab = (LAS float*)(F.lds + RT_SLAB_OFF);
    LAS float* lg = (LAS float*)(F.lds + RT_LG_OFF);
    LAS float* biasl = lg + 128 * 48;
    LAS int* histl = (LAS int*)(biasl + 64);
    __syncthreads();
    if (tid < 32) histl[tid] = 0;
    if (tid >= 64 && tid < 64 + 36) { const int n = tid - 64; biasl[n] = n < 4 ? a.in[IN_B_GRP][n] : a.in[IN_B_RT][n - 4]; }
    bf16x8 bh[4][3], bl[4][3];
    { const bf16_t* wh = (const bf16_t*)(ws + WS_WR) + (size_t)fr * 1024 + 128 * w + 8 * fq; const bf16_t* wl = wh + 48 * 1024;
#pragma unroll
      for (int ks = 0; ks < 4; ++ks)
#pragma unroll
          for (int nt = 0; nt < 3; ++nt) { bh[ks][nt] = *(const bf16x8*)(wh + (size_t)nt * 16 * 1024 + 32 * ks); bl[ks][nt] = *(const bf16x8*)(wl + (size_t)nt * 16 * 1024 + 32 * ks); } }
    const bf16_t* xg = (const bf16_t*)(ws + WS_X2B) + (size_t)(blk * 128 + fq) * D + 128 * w + 8 * fr;
    u32x4 bufA[4], bufB[4];
#define RT_LOAD(buf, tg) do { _Pragma("unroll") for (int j = 0; j < 4; ++j) buf[j] = *(const u32x4*)(xg + (size_t)(16 * (tg) + 4 * j) * D); } while (0)
#define RT_GROUP(buf, tg) do { \
        float sq[4]; \
        _Pragma("unroll") for (int j = 0; j < 4; ++j) { const u32x4 v = buf[j]; float f[8]; unpack8(v, f); \
            sq[j] = ((f[0] * f[0] + f[1] * f[1]) + (f[2] * f[2] + f[3] * f[3])) + ((f[4] * f[4] + f[5] * f[5]) + (f[6] * f[6] + f[7] * f[7])); \
            *(LAS u32x4*)(xs + (4 * j + fq) * RT_XS_PITCH + 16 * fr) = v; } \
        asm volatile("s_waitcnt lgkmcnt(0)" ::: "memory"); \
        f32x4 acc[3] = {(f32x4){0.f, 0.f, 0.f, 0.f}, (f32x4){0.f, 0.f, 0.f, 0.f}, (f32x4){0.f, 0.f, 0.f, 0.f}}; \
        _Pragma("unroll") for (int ks = 0; ks < 4; ++ks) { \
            const bf16x8 ah = *(const LAS bf16x8*)(xs + fr * RT_XS_PITCH + (32 * ks + 8 * fq) * 2); \
            _Pragma("unroll") for (int nt = 0; nt < 3; ++nt) { \
                acc[nt] = __builtin_amdgcn_mfma_f32_16x16x32_bf16(ah, bh[ks][nt], acc[nt], 0, 0, 0); \
                acc[nt] = __builtin_amdgcn_mfma_f32_16x16x32_bf16(ah, bl[ks][nt], acc[nt], 0, 0, 0); } } \
        LAS float* sl = slab + ((tg) & 1) * 6144 + w * 768;                    \
        _Pragma("unroll") for (int nt = 0; nt < 3; ++nt) { if (nt < 2 || fr < 4) { _Pragma("unroll") for (int r = 0; r < 4; ++r) sl[(4 * fq + r) * 48 + 16 * nt + fr] = acc[nt][r]; } } \
        _Pragma("unroll") for (int j = 0; j < 4; ++j) { float v = sq[j]; \
            _Pragma("unroll") for (int o = 1; o < 16; o <<= 1) v += __shfl_xor(v, o); \
            if (fr == 0) sl[(4 * j + fq) * 48 + 36] = v; } \
        asm volatile("s_waitcnt lgkmcnt(0)" ::: "memory"); __builtin_amdgcn_s_barrier(); asm volatile("" ::: "memory"); \
        for (int o = tid; o < 16 * 37; o += NTHREADS) { const int tk = o / 37, c = o - tk * 37; const LAS float* sp = slab + ((tg) & 1) * 6144 + tk * 48 + c; \
            float s8 = 0.f; _Pragma("unroll") for (int ww = 0; ww < 8; ++ww) s8 += sp[ww * 768]; lg[(16 * (tg) + tk) * 48 + c] = s8; } \
    } while (0)
    RT_LOAD(bufA, 0);
#pragma unroll 1
    for (int tg = 0; tg < 8; tg += 2) {
        RT_LOAD(bufB, tg + 1);
        RT_GROUP(bufA, tg);
        if (tg + 2 < 8) RT_LOAD(bufA, tg + 2);
        RT_GROUP(bufB, tg + 1);
    }
#undef RT_LOAD
#undef RT_GROUP
    __syncthreads();
    if (tid < 128) {
        const int tl = tid, t = blk * 128 + tl; const LAS float* L = lg + tl * 48; const float rs = rsqrtf(L[36] * (1.f / 1024.f) + EPS);
        float g4[4];
#pragma unroll
        for (int i = 0; i < 4; ++i) g4[i] = L[i] * rs + biasl[i];
        int g = 0; float mx = g4[0];
#pragma unroll
        for (int i = 1; i < 4; ++i) if (g4[i] > mx) { mx = g4[i]; g = i; }
        float den = 0.f;
#pragma unroll
        for (int i = 0; i < 4; ++i) den += __expf(g4[i] - mx);
        const float gp = 1.f / den;
        float e8[8];
#pragma unroll
        for (int i = 0; i < 8; ++i) e8[i] = L[4 + g * 8 + i] * rs + biasl[4 + g * 8 + i];
        int i0 = 0; float v0 = e8[0];
#pragma unroll
        for (int i = 1; i < 8; ++i) if (e8[i] > v0) { v0 = e8[i]; i0 = i; }
        int i1 = -1; float v1 = -3.0e38f;
#pragma unroll
        for (int i = 0; i < 8; ++i) if (i != i0 && e8[i] > v1) { v1 = e8[i]; i1 = i; }
        const float ex = __expf(v1 - v0);
        const float g0 = gp / (1.f + ex), g1 = gp * ex / (1.f + ex);
        const int ex0 = g * 8 + i0, ex1 = g * 8 + i1;
        const int r0 = __hip_atomic_fetch_add((int*)(histl + ex0), 1, __ATOMIC_RELAXED, __HIP_MEMORY_SCOPE_WORKGROUP), r1 = __hip_atomic_fetch_add((int*)(histl + ex1), 1, __ATOMIC_RELAXED, __HIP_MEMORY_SCOPE_WORKGROUP);
        *(int2*)((int*)(ws + RT_TOK_E) + 2 * t) = make_int2(ex0, ex1); *(float2*)((float*)(ws + RT_TOK_G) + 2 * t) = make_float2(g0, g1);
        *(int2*)((int*)(ws + RT_TOK_R) + 2 * t) = make_int2(r0, r1); ((float*)(ws + RT_RS2))[t] = rs;
    }
    __syncthreads();
    if (tid < 32) ((int*)(ws + RT_HIST))[blk * 32 + tid] = histl[tid];
}
__device__ __forceinline__ void assign_block(const Frame& F, const Args& a, int blk) {
    const int l = lane_id_fresh(), w = F.wave, tid = w * 64 + l;
    unsigned char* ws = F.ws;
    LAS int* ptot = (LAS int*)F.lds;
    LAS int* ppre = ptot + 512;
    LAS int* base = ppre + 512;
    LAS int* ebase = base + 32;
    __syncthreads();
    { const int e = tid & 31, part = tid >> 5; const int* H = (const int*)(ws + RT_HIST); int st = 0, sp = 0; int hv[16];
#pragma unroll
      for (int i = 0; i < 16; ++i) hv[i] = H[(part * 16 + i) * 32 + e];
#pragma unroll
      for (int i = 0; i < 16; ++i) { st += hv[i]; sp += (part * 16 + i < blk) ? hv[i] : 0; }
      ptot[part * 32 + e] = st; ppre[part * 32 + e] = sp; }
    __syncthreads();
    if (tid < 32) { int st = 0, sp = 0; for (int p = 0; p < 16; ++p) { st += ptot[p * 32 + tid]; sp += ppre[p * 32 + tid]; } ptot[tid] = st; ppre[tid] = sp; }
    __syncthreads();
    if (tid == 0) { int run = 0;
        for (int e = 0; e < 32; ++e) { base[e] = run * 256 + ppre[e]; ebase[e] = run * 256 + ptot[e]; ebase[64 + e] = run; run += (ptot[e] + 255) >> 8; ebase[32 + e] = run * 256; }
        if (blk == 0) ((int*)(ws + RT_TILE_E))[0] = run; }
    __syncthreads();
    if (blk == 0 && tid < 32) { int* te = (int*)(ws + RT_TILE_E); const int r0 = ebase[64 + tid], nt = (ebase[32 + tid] >> 8) - r0; for (int i = 0; i < nt; ++i) te[16 + r0 + i] = tid; }
    int* tos = (int*)(ws + RT_TOK_OF_SLOT); float* rss = (float*)(ws + RT_RS_SLOT); float* gts = (float*)(ws + RT_GATE_SLOT);
    if (tid < 256) { const int t = blk * 128 + (tid >> 1), k = tid & 1;
        const int e = ((const int*)(ws + RT_TOK_E))[2 * t + k], r = ((const int*)(ws + RT_TOK_R))[2 * t + k];
        const int slot = base[e] + r;
        ((int*)(ws + RT_SLOT_OF))[2 * t + k] = slot; tos[slot] = t; rss[slot] = ((const float*)(ws + RT_RS2))[t]; gts[slot] = ((const float*)(ws + RT_TOK_G))[2 * t + k]; }
    if (blk < 32) {
        for (int sl = ebase[blk] + tid; sl < ebase[32 + blk]; sl += NTHREADS) { tos[sl] = 0; rss[sl] = 0.f; gts[sl] = 0.f; } }
}
__device__ __forceinline__ void combine_rows(const Frame& F, const Args& a, float* outp) {
    const int l = lane_id_fresh();
    unsigned char* ws = F.ws;
    const int gw = F.vcu * NWAVES + F.wave, NGW = F.G * NWAVES;
    const f32x4* gfin = (const f32x4*)a.in[IN_G_FINAL] + l;
    f32x4 gf4[4];
#pragma unroll
    for (int j = 0; j < 4; ++j) gf4[j] = gfin[64 * j];
    const int* slot_of = (const int*)(ws + RT_SLOT_OF); const bf16_t* Y = (const bf16_t*)(ws + WS_YSLOT); const bf16_t* XB = (const bf16_t*)(ws + WS_X2B);
    for (int t = gw; t < T; t += 2 * NGW) {
        const int tb = t + NGW; const bool hb = tb < T; const int t2 = hb ? tb : t;
        const int2 sa = *(const int2*)(slot_of + 2 * t), sb = *(const int2*)(slot_of + 2 * t2);
        const u32x2* xa = (const u32x2*)(XB + (size_t)t * D) + l; const u32x2* xb = (const u32x2*)(XB + (size_t)t2 * D) + l;
        const u32x2* ya0 = (const u32x2*)(Y + (size_t)sa.x * D) + l; const u32x2* ya1 = (const u32x2*)(Y + (size_t)sa.y * D) + l;
        const u32x2* yb0 = (const u32x2*)(Y + (size_t)sb.x * D) + l; const u32x2* yb1 = (const u32x2*)(Y + (size_t)sb.y * D) + l;
        f32x4 va[4], vb[4]; u32x2 ra[4], pa[4], qa[4], rb[4], pb[4], qb[4];
#pragma unroll
        for (int j = 0; j < 4; ++j) { ra[j] = __builtin_nontemporal_load(xa + 64 * j); pa[j] = __builtin_nontemporal_load(ya0 + 64 * j); qa[j] = __builtin_nontemporal_load(ya1 + 64 * j); rb[j] = __builtin_nontemporal_load(xb + 64 * j); pb[j] = __builtin_nontemporal_load(yb0 + 64 * j); qb[j] = __builtin_nontemporal_load(yb1 + 64 * j); }
        float sqa = 0.f, sqb = 0.f;
#pragma unroll
        for (int j = 0; j < 4; ++j) {
            va[j].x = bf_lo(ra[j].x) + bf_lo(pa[j].x) + bf_lo(qa[j].x); va[j].y = bf_hi(ra[j].x) + bf_hi(pa[j].x) + bf_hi(qa[j].x); va[j].z = bf_lo(ra[j].y) + bf_lo(pa[j].y) + bf_lo(qa[j].y); va[j].w = bf_hi(ra[j].y) + bf_hi(pa[j].y) + bf_hi(qa[j].y);
            vb[j].x = bf_lo(rb[j].x) + bf_lo(pb[j].x) + bf_lo(qb[j].x); vb[j].y = bf_hi(rb[j].x) + bf_hi(pb[j].x) + bf_hi(qb[j].x); vb[j].z = bf_lo(rb[j].y) + bf_lo(pb[j].y) + bf_lo(qb[j].y); vb[j].w = bf_hi(rb[j].y) + bf_hi(pb[j].y) + bf_hi(qb[j].y);
            sqa += (va[j].x * va[j].x + va[j].y * va[j].y) + (va[j].z * va[j].z + va[j].w * va[j].w); sqb += (vb[j].x * vb[j].x + vb[j].y * vb[j].y) + (vb[j].z * vb[j].z + vb[j].w * vb[j].w); }
        const float rsa = rsqrtf(wave_sum(sqa) * (1.f / 1024.f) + EPS), rsb = rsqrtf(wave_sum(sqb) * (1.f / 1024.f) + EPS);
        f32x4* oa = (f32x4*)(outp + (size_t)t * D) + l; f32x4* ob = (f32x4*)(outp + (size_t)t2 * D) + l;
#pragma unroll
        for (int j = 0; j < 4; ++j) { __builtin_nontemporal_store(va[j] * rsa * gf4[j], oa + 64 * j); if (hb) __builtin_nontemporal_store(vb[j] * rsb * gf4[j], ob + 64 * j); }
    }
}

#define XB_TMO      128
#define XB_XCNT(j)  (256  + 64 * (j))
#define XB_XSUB(j)  (1280 + 64 * (j))
#define XB_XGEN(j)  (2304 + 64 * (j))
#define XB_TOP      3328
#define XB_TOPGEN   3392
#define XCD_BAR_WORDS 3456
#define XB_SPIN_CAP (1u << 20)
__device__ __forceinline__ unsigned xb_ld(unsigned* p)              { return __hip_atomic_load(p, __ATOMIC_RELAXED, __HIP_MEMORY_SCOPE_AGENT); }
__device__ __forceinline__ unsigned xb_add(unsigned* p, unsigned v) { return __hip_atomic_fetch_add(p, v, __ATOMIC_RELAXED, __HIP_MEMORY_SCOPE_AGENT); }
__device__ __forceinline__ unsigned xb_xcc_id() { return (unsigned)__builtin_amdgcn_s_getreg((3 << 11) | 20) & 0xFu; }
#define XB_SPIN(cond, bar) do { unsigned _sp = 0; while (cond) { __builtin_amdgcn_s_sleep(1); \
    if ((++_sp & 255u) == 0u) { if (xb_ld(&(bar)[XB_TMO])) break; if (_sp > XB_SPIN_CAP) { atomicAdd(&(bar)[XB_TMO], 1u); break; } } } } while (0)
struct XcdBarrier { unsigned* bar; unsigned x; volatile LAS unsigned* st; };
__device__ __forceinline__ XcdBarrier xcd_barrier_post(unsigned* bar, volatile LAS unsigned* st) {
    XcdBarrier b; b.bar = bar; b.x = xb_xcc_id(); b.st = st;
    if (threadIdx.x == 0) (void)xb_add(&bar[XB_XCNT(b.x)], 1u);
    return b;
}
__device__ __forceinline__ void xcd_barrier_complete(unsigned* bar, unsigned x, unsigned& nloc, unsigned& nx) {
    const unsigned G = gridDim.x * gridDim.y * gridDim.z;
    unsigned sum, cnt, mine, sp = 0u;
    for (;;) {
        sum = 0u; cnt = 0u; mine = 0u;
#pragma unroll
        for (unsigned j = 0; j < 16; ++j) { const unsigned c = xb_ld(&bar[XB_XCNT(j)]); sum += c; cnt += (c > 0u) ? 1u : 0u; mine = (j == x) ? c : mine; }
        if (sum == G) break;
        __builtin_amdgcn_s_sleep(1);
        if ((++sp & 255u) == 0u) { if (xb_ld(&bar[XB_TMO])) break; if (sp > XB_SPIN_CAP) { atomicAdd(&bar[XB_TMO], 1u); break; } }
    }
    nloc = mine > 0u ? mine : 1u; nx = cnt > 0u ? cnt : 1u;
}
__device__ __forceinline__ void xcd_barrier(const XcdBarrier& b, const int wave) {
    asm volatile("s_waitcnt vmcnt(0)" ::: "memory");
    __syncthreads();
    if (wave == 0 && lane_id_fresh() == 0) {
        unsigned* bar = b.bar;
        __builtin_amdgcn_s_waitcnt(0);
        unsigned nloc = b.st[0], nx = b.st[1];
        if (nloc == 0u) { xcd_barrier_complete(bar, b.x, nloc, nx); b.st[0] = nloc; b.st[1] = nx; }
        const unsigned old = xb_add(&bar[XB_XSUB(b.x)], 1u);
        const unsigned gen = old / nloc;
        if (old + 1u == (gen + 1u) * nloc) {
            __builtin_amdgcn_fence(__ATOMIC_RELEASE, "agent");
            asm volatile("s_waitcnt vmcnt(0)" ::: "memory");
            const unsigned og = xb_add(&bar[XB_TOP], 1u);
            const unsigned tg = og / nx;
            if (og + 1u == (tg + 1u) * nx) xb_add(&bar[XB_TOPGEN], 1u);
            else XB_SPIN(xb_ld(&bar[XB_TOPGEN]) == tg, bar);
            __builtin_amdgcn_fence(__ATOMIC_ACQUIRE, "agent");
            xb_add(&bar[XB_XGEN(b.x)], 1u);
            asm volatile("s_waitcnt vmcnt(0)" ::: "memory");
        } else {
            XB_SPIN(xb_ld(&bar[XB_XGEN(b.x)]) == gen, bar);
            __builtin_amdgcn_fence(__ATOMIC_ACQUIRE, "agent");
            asm volatile("s_waitcnt vmcnt(0)" ::: "memory");
        }
    }
    __syncthreads();
}

__global__ void __launch_bounds__(NTHREADS, 2) mk_fwd(Args args) {
    extern __shared__ __attribute__((aligned(16))) unsigned char lds_raw[];
    Frame F;
    F.lds = (LAS unsigned char*)lds_raw;
    F.wave = __builtin_amdgcn_readfirstlane((int)threadIdx.x >> 6);
    F.G = gridDim.x; { const int bx = blockIdx.x; F.vcu = (F.G % 8 == 0) ? (bx % 8) * (F.G / 8) + bx / 8 : bx; }
    F.ws = args.ws; F.out = args.out;
    unsigned char* ws = args.ws;
    const int lo = args.ph_lo, hi = args.ph_hi;
    if (threadIdx.x < 64) ((LAS unsigned*)(F.lds + LDS_MISC))[threadIdx.x] = 0u;
    __syncthreads();
    XcdBarrier xbar; xbar.bar = (unsigned*)(ws + WS_CTL) + 4096; xbar.x = 0; xbar.st = nullptr;
    if (hi - lo > 1) xbar = xcd_barrier_post((unsigned*)(ws + WS_CTL) + 4096, (volatile LAS unsigned*)(F.lds + LDS_MISC) + 8);
#define IN(k) (lo <= (k) && (k) < hi)
#define SEAM(k) do { if (IN(k) && IN((k) + 1)) xcd_barrier(xbar, F.wave); } while (0)
    if (IN(0)) p0_prologue(F, args);
    SEAM(0);
    if (IN(1)) {
        { pg8::DenseOrder S; S.init(T, INC, F.G, (int)blockIdx.x, ws + WS_HB, D, ws + WS_WIN_T, D);
          EpiInProj E{(bf16_t*)(ws + WS_GB), (bf16_t*)(ws + WS_Z), (bf16_t*)(ws + WS_UG), (bf16_t*)(ws + WS_VG)};
          pg8::gemm_phase<D, D, D>(F.lds, F.wave, S, E); }
        { pg8::DenseOrder S; S.init(B * ML, 2 * D, F.G, (int)blockIdx.x, ws + WS_MEMN, D, ws + WS_WKV_T, D);
          EpiBf16 E{(bf16_t*)(ws + WS_KV), 2 * D};
          pg8::gemm_phase<D, D, D>(F.lds, F.wave, S, E); }
    }
    SEAM(1);
    if (IN(2)) {
        for (int ch = F.vcu; ch < T / CHUNK; ch += F.G) mixer_unit(F, args, ch);
    }
    SEAM(2);
    if (IN(3)) {
        { WqkOrder S{F.G, (int)blockIdx.x, (const char*)(ws + WS_KV), (const char*)(ws + WS_WQ_NAT)}; EpiBf16Aux E{(bf16_t*)(ws + WS_WQK_T), 1024};
          pg8::gemm_phase<2 * D, D, XD>(F.lds, F.wave, S, E); }
        { VwOrder S{F.G, (int)((blockIdx.x + F.G / 2) % F.G), (const char*)(ws + WS_KV), (const char*)(ws + WS_WO_T)}; EpiBf16Aux E{(bf16_t*)(ws + WS_VW_T), 1024};
          pg8::gemm_phase<D, 2 * D, XD>(F.lds, F.wave, S, E); }
        pg8::DenseOrder S; S.init(T, D, F.G, (int)blockIdx.x, ws + WS_Y, D, ws + WS_WOUT_T, D);
        EpiResidA E{args.in[IN_X], (bf16_t*)(ws + WS_X1B), (float*)(ws + WS_SSQ1)};
        pg8::gemm_phase<D, D, D>(F.lds, F.wave, S, E);
    }
    SEAM(3);
    if (IN(4)) {
        pg8::DenseOrder S; S.init(T, D, F.G, (int)blockIdx.x, ws + WS_X1B, D, ws + WS_WQK_T, D, S_TILES, (size_t)D * D * 2);
        EpiSoftmax E{(const float*)(ws + WS_SSQ1), (bf16_t*)(ws + WS_P)};
        pg8::gemm_phase<D, D, D>(F.lds, F.wave, S, E);
    }
    SEAM(4);
    if (IN(5)) {
        pg8::DenseOrder S; S.init(T, D, F.G, (int)blockIdx.x, ws + WS_P, D, ws + WS_VW_T, D, S_TILES, (size_t)D * D * 2);
        EpiResidB E{(const bf16_t*)(ws + WS_X1B), (bf16_t*)(ws + WS_X2B)};
        pg8::gemm_phase<D, D, D>(F.lds, F.wave, S, E);
    }
    SEAM(5);
    if (IN(6)) { for (int blk = F.vcu; blk < T / 128; blk += F.G) router_block(F, args, blk); }
    SEAM(6);
    if (IN(7)) { for (int blk = F.vcu; blk < T / 128; blk += F.G) assign_block(F, args, blk); }
    SEAM(7);
    if (IN(8)) {
        GroupedOrder S; S.init(F.G, (int)blockIdx.x, (const int*)(ws + RT_TILE_E), ws + WS_X2B, D, ws + WS_WGU_T, D, (size_t)1024 * 1024 * 2, true);
        EpiSwiGLU E{(bf16_t*)(ws + WS_HID), (const float*)(ws + RT_RS_SLOT)};
        pg8::gemm_phase<D, D, D, true>(F.lds, F.wave, S, E, (const int*)(ws + RT_TOK_OF_SLOT));
    }
    SEAM(8);
    if (IN(9)) {
        GroupedOrder S; S.init(F.G, (int)blockIdx.x, (const int*)(ws + RT_TILE_E), ws + WS_HID, DE, ws + WS_WD_T, DE, (size_t)1024 * 512 * 2);
        EpiDown E{(bf16_t*)(ws + WS_YSLOT), (const float*)(ws + RT_GATE_SLOT)};
        pg8::gemm_phase<DE, DE, DE>(F.lds, F.wave, S, E);
    }
    SEAM(9);
    if (IN(10)) { combine_rows(F, args, F.out); }
#undef IN
#undef SEAM
}
extern "C" void kernel_launch(void* const* d_in, const int* in_sizes, int n_in, void* d_out, int out_size, void* d_ws, size_t ws_size, hipStream_t stream) {
    if (n_in != 26 || out_size != T * D || ws_size < 500 * MiB) { fprintf(stderr, "kernel_launch: unexpected shapes n_in %d out %d ws %zu\n", n_in, out_size, ws_size); return; }
    float* xres = (float*)d_out;
    static int grid = 0;
    if (grid == 0) {
        int dev = 0, cus = 0, per_cu = 0;
        if (hipGetDevice(&dev) != hipSuccess || hipDeviceGetAttribute(&cus, hipDeviceAttributeMultiprocessorCount, dev) != hipSuccess) { fprintf(stderr, "kernel_launch: device query failed\n"); grid = -1; return; }
        if (hipFuncSetAttribute((const void*)mk_fwd, hipFuncAttributeMaxDynamicSharedMemorySize, LDS_BYTES) != hipSuccess) { fprintf(stderr, "kernel_launch: hipFuncSetAttribute failed\n"); grid = -1; return; }
        if (hipOccupancyMaxActiveBlocksPerMultiprocessor(&per_cu, (const void*)mk_fwd, NTHREADS, LDS_BYTES) != hipSuccess || per_cu < 1) { fprintf(stderr, "kernel_launch: occupancy query says %d blocks per CU\n", per_cu); (void)hipGetLastError(); grid = -1; return; }
        grid = cus;
        if (grid != 256) fprintf(stderr, "kernel_launch: note: %d CUs (built and tuned for 256)\n", grid);
    }
    if (grid < 0) return;
    Args a{};
    for (int i = 0; i < 26; ++i) a.in[i] = (const float*)d_in[i];
    a.out = xres; a.ws = (unsigned char*)d_ws;
    if (hipMemsetAsync((char*)d_ws + WS_CTL + 4096 * 4, 0, XCD_BAR_WORDS * 4, stream) != hipSuccess) { fprintf(stderr, "kernel_launch: memset failed\n"); return; }
#if defined(MK_PER_PHASE)
    for (int ph = 0; ph < 11; ++ph) { a.ph_lo = ph; a.ph_hi = ph + 1; hipLaunchKernelGGL(mk_fwd, dim3(grid), dim3(NTHREADS), LDS_BYTES, stream, a); }
#else
    a.ph_lo = 0; a.ph_hi = 11;
    hipLaunchKernelGGL(mk_fwd, dim3(grid), dim3(NTHREADS), LDS_BYTES, stream, a);
    const hipError_t le = hipPeekAtLastError();
    if (le != hipSuccess) fprintf(stderr, "kernel_launch: launch failed: %s (grid %d)\n", hipGetErrorString(le), grid);
#endif
}
```

```cpp
#include <hip/hip_runtime.h>
#include <cstdint>
#include <cstdio>

namespace cfg {
constexpr int D = 1024, B = 8, S = 4096, T = B * S;
constexpr int CW = 512, GW = 512, NH = 8, HD = 64, CHUNK = 128, INC = 2560;
constexpr int ML = 256, XH = 4, XD = 256;
constexpr int NG = 4, EPG = 8, NE = 32, DE = 512;
constexpr float EPS = 1e-6f;
}
constexpr size_t MiB = 1u << 20;
using namespace cfg;

#define LAS __attribute__((address_space(3)))
#define GAS __attribute__((address_space(1)))
typedef unsigned short bf16_t;
typedef short bf16x8 __attribute__((ext_vector_type(8)));
typedef short s16x4 __attribute__((ext_vector_type(4)));
typedef float f32x4 __attribute__((ext_vector_type(4)));
typedef float f32x2 __attribute__((ext_vector_type(2)));
typedef unsigned u32x4 __attribute__((ext_vector_type(4)));
typedef unsigned u32x2 __attribute__((ext_vector_type(2)));

constexpr int NWAVES = 8, NTHREADS = 512;
constexpr int S_TILES = cfg::S / 256;
constexpr int LDS_BYTES = 147456;
constexpr int LDS_STAGE = 131072;
constexpr int LDS_EXCH = 131072;
constexpr int LDS_MISC = LDS_BYTES - 256;

constexpr size_t WS_CTL = 0;
constexpr size_t WS_WIN_T = 1 * MiB;
constexpr size_t WS_WOUT_T = 6 * MiB;
constexpr size_t WS_WQ_NAT = 8 * MiB;
constexpr size_t WS_WO_T = 10 * MiB;
constexpr size_t WS_WKV_T = 12 * MiB;
constexpr size_t WS_WS_BF = 16 * MiB;
constexpr size_t WS_MEMN = 17 * MiB;
constexpr size_t WS_KV = 21 * MiB;
constexpr size_t WS_WQK_T = 29 * MiB;
constexpr size_t WS_VW_T = 45 * MiB;
constexpr size_t WS_WGU_T = 61 * MiB;
constexpr size_t WS_WD_T = 125 * MiB;
constexpr size_t WS_WR = 157 * MiB;
constexpr size_t WS_SSQ1 = 158 * MiB;
constexpr size_t WS_ROUTE = 160 * MiB;
constexpr size_t WS_ACT0 = 164 * MiB;
constexpr size_t WS_ACT1 = 228 * MiB;
constexpr size_t WS_GB = WS_ACT1, WS_Z = WS_ACT1 + 32 * MiB, WS_UG = WS_ACT1 + 64 * MiB, WS_VG = WS_ACT1 + 96 * MiB;
constexpr size_t WS_X2B = WS_ACT1 + 64 * MiB;
constexpr size_t WS_HID = WS_ACT0;
constexpr size_t WS_YSLOT = 356 * MiB;
constexpr size_t RT_TOK_E = WS_ROUTE, RT_TOK_G = WS_ROUTE + 256 * 1024, RT_RS2 = WS_ROUTE + 512 * 1024, RT_TOK_R = WS_ROUTE + 640 * 1024, RT_HIST = WS_ROUTE + 896 * 1024,
                 RT_SLOT_OF = WS_ROUTE + 1024 * 1024, RT_GATE_SLOT = WS_ROUTE + 1536 * 1024, RT_TILE_E = WS_ROUTE + 2048 * 1024,
                 RT_TOK_OF_SLOT = WS_ROUTE + 2304 * 1024, RT_RS_SLOT = WS_ROUTE + 2816 * 1024;
constexpr int MAX_TILES = 288;
constexpr size_t WS_HB = WS_ACT0, WS_Y = WS_ACT0, WS_P = WS_ACT0, WS_X1B = WS_ACT1;

__device__ __forceinline__ unsigned f2bf(float f) { unsigned u = __builtin_bit_cast(unsigned, f); return (u + 0x7fffu + ((u >> 16) & 1u)) >> 16; }
__device__ __forceinline__ unsigned pk2(float lo, float hi) { unsigned r; asm("v_cvt_pk_bf16_f32 %0, %1, %2" : "=v"(r) : "v"(lo), "v"(hi)); return r; }
__device__ __forceinline__ unsigned cvt_pk_bf16(float lo, float hi) { unsigned r; asm("v_cvt_pk_bf16_f32 %0, %1, %2" : "=v"(r) : "v"(lo), "v"(hi)); return r; }
__device__ __forceinline__ float bf_lo(unsigned w) { return __uint_as_float(w << 16); }
__device__ __forceinline__ float bf_hi(unsigned w) { return __uint_as_float(w & 0xffff0000u); }
__device__ __forceinline__ float wave_sum(float v) {
#pragma unroll
    for (int o = 1; o < 64; o <<= 1) v += __shfl_xor(v, o);
    return v;
}
__device__ __forceinline__ float gelu_fast(float x) {
    const float t = x * (1.0f + 0.044715f * x * x) * 2.302208198f;
    return x * __builtin_amdgcn_rcpf(1.0f + __builtin_amdgcn_exp2f(-t));
}
__device__ __forceinline__ int lane_id_fresh() { int l; asm volatile("v_mbcnt_lo_u32_b32 %0, -1, 0\n\tv_mbcnt_hi_u32_b32 %0, -1, %0" : "=v"(l)); return l; }
#define LDS_WAIT() asm volatile("s_waitcnt lgkmcnt(0)" ::: "memory")
#define VM_WAIT() asm volatile("s_waitcnt vmcnt(0)" ::: "memory")

namespace pg8 {
constexpr int BM = 256, BK = 64, HALF = 128, HTB = HALF * BK * 2, STAGE_BYTES = 8 * HTB, NXCD = 8, WGM = 8;
__host__ __device__ __forceinline__ int lds_byte(int r, int c) { const int st = (r >> 4) * 2 + (c >> 5), rr = r & 15, cc = c & 31, ob = rr * 64 + cc * 2; return st * 1024 + (ob ^ (((ob >> 9) & 1) << 5)); }
__host__ __device__ __forceinline__ void stage_rc(int b, int& R, int& C) { const int st = b / 1024, sb = b % 1024, swz = sb ^ (((sb >> 9) & 1) << 5); R = (st >> 1) * 16 + swz / 64; C = (st & 1) * 32 + (swz % 64) / 2; }
__host__ __device__ __forceinline__ int perm32(int rho) { const int n = rho >> 4, i = rho & 15; return 8 * (i >> 2) + 4 * n + (i & 3); }

__device__ __forceinline__ const char* uni(const char* p) { const unsigned long long v = (unsigned long long)p;
    const unsigned lo = __builtin_amdgcn_readfirstlane((unsigned)v), hi = __builtin_amdgcn_readfirstlane((unsigned)(v >> 32)); return (const char*)(((unsigned long long)hi << 32) | lo); }
struct Unit { int pm, pn, aux; const char* a; const char* b; };

typedef f32x4 Acc[2][2][4][2];

template <int lda, int ldb, int K, bool GATHER = false, class Epi, class Sched>
__device__ __forceinline__ void gemm_phase(LAS unsigned char* lds, const int wid, const Sched& S, const Epi& E, const int* gidx = nullptr) {
    const int lane = lane_id_fresh(), tid = wid * 64 + lane, wr = wid >> 2, wc = wid & 3, fr = lane & 15, fq = lane >> 4;
    constexpr int nt = K / BK;
    unsigned voffA, voffB;
    { int R, C; stage_rc(tid * 16, R, C); const int Rb = (R & ~31) + perm32(R & 31); voffA = (unsigned)(R * lda + C) * 2u; voffB = (unsigned)(Rb * ldb + C) * 2u; }
    constexpr size_t pstepA = (size_t)64 * lda * 2, pstepB = (size_t)64 * ldb * 2;
    constexpr size_t kstep = (size_t)(BK * 2);
    constexpr size_t hstepA = (size_t)HALF * lda * 2, hstepB = (size_t)HALF * ldb * 2;
    const unsigned ldsw = (unsigned)wid * 1024u;
    const int aoff = lds_byte(wr * 64 + fr, fq * 8), boff = lds_byte(wc * 32 + fr, fq * 8);
#define PG8_SA(b, h) (((b) * 2 + (h)) * HTB)
#define PG8_SB(b, h) ((4 + (b) * 2 + (h)) * HTB)
#define PG8_STAGE(bufoff, gbase, X) do { _Pragma("unroll") for (int _i = 0; _i < 2; ++_i) \
        __builtin_amdgcn_global_load_lds((const unsigned*)(uni((const char*)(gbase) + (size_t)_i * pstep##X) + voff##X), (LAS unsigned*)(lds + (bufoff) + ldsw + _i * 8192), 16, 0, 0); } while (0)
#define PG8_STAGE_A(bufoff, kp, h, OFF) do { _Pragma("unroll") for (int _i = 0; _i < 2; ++_i) { \
        if constexpr (GATHER) __builtin_amdgcn_global_load_lds((const unsigned*)(uni((const char*)(kp)) + OFF[h][_i]), (LAS unsigned*)(lds + (bufoff) + ldsw + _i * 8192), 16, 0, 0); \
        else __builtin_amdgcn_global_load_lds((const unsigned*)(uni((const char*)(kp) + (size_t)(h) * hstepA + (size_t)_i * pstepA) + voffA), (LAS unsigned*)(lds + (bufoff) + ldsw + _i * 8192), 16, 0, 0); } } while (0)
#define PG8_LDA(dst, b, h) do { _Pragma("unroll") for (int m = 0; m < 4; ++m) _Pragma("unroll") for (int k = 0; k < 2; ++k) dst[m][k] = *(const LAS bf16x8*)(lds + PG8_SA(b, h) + aoff + m * 2048 + k * 1024); } while (0)
#define PG8_LDB(dst, b, h) do { _Pragma("unroll") for (int n = 0; n < 2; ++n) _Pragma("unroll") for (int k = 0; k < 2; ++k) dst[n][k] = *(const LAS bf16x8*)(lds + PG8_SB(b, h) + boff + n * 2048 + k * 1024); } while (0)
#define PG8_MMA(ai, bj, At, Bt) do { __builtin_amdgcn_s_setprio(1); _Pragma("unroll") for (int m = 0; m < 4; ++m) _Pragma("unroll") for (int n = 0; n < 2; ++n) _Pragma("unroll") for (int k = 0; k < 2; ++k) \
        acc[ai][bj][m][n] = __builtin_amdgcn_mfma_f32_16x16x32_bf16(Bt[n][k], At[m][k], acc[ai][bj][m][n], 0, 0, 0); __builtin_amdgcn_s_setprio(0); } while (0)
#define PG8_WAIT_V(n) asm volatile("s_waitcnt vmcnt(" #n ")" ::: "memory")
#define PG8_WAIT_L(n) asm volatile("s_waitcnt lgkmcnt(" #n ")" ::: "memory")
#define PG8_BAR __builtin_amdgcn_s_barrier()
#define PG8_SCHED __builtin_amdgcn_sched_barrier(0)
    Unit cur, nxt; int ui = 0;
    if (!S.next(0, cur)) return;
    Acc acc;
#pragma unroll
    for (int a = 0; a < 2; ++a)
#pragma unroll
        for (int b = 0; b < 2; ++b)
#pragma unroll
            for (int m = 0; m < 4; ++m)
#pragma unroll
                for (int n = 0; n < 2; ++n) acc[a][b][m][n] = (f32x4){0.f, 0.f, 0.f, 0.f};
    bf16x8 At[4][2], B0[2][2], B1[2][2];
    const char* cA = cur.a; const char* cB = cur.b;
    unsigned go[2][2], gn[2][2];
    LAS const unsigned* lidx = (LAS const unsigned*)(lds + STAGE_BYTES);
    if constexpr (GATHER) {
        { Unit uu; for (int i = 0; S.next(i, uu); ++i) if (tid < 256) ((LAS unsigned*)lidx)[i * 256 + tid] = (unsigned)gidx[uu.pm * 256 + tid] * (unsigned)(lda * 2); }
        asm volatile("s_waitcnt vmcnt(0) lgkmcnt(0)" ::: "memory"); PG8_BAR; asm volatile("" ::: "memory");
        int R, C; stage_rc(tid * 16, R, C);
#pragma unroll
        for (int h = 0; h < 2; ++h)
#pragma unroll
            for (int i = 0; i < 2; ++i) { go[h][i] = lidx[h * 128 + i * 64 + R] + (unsigned)(C * 2); gn[h][i] = go[h][i]; }
    }
    if constexpr (Epi::ROWTAB) {
        { Unit uu; for (int i = 0; S.next(i, uu); ++i) if (tid < 256) ((LAS float*)(lds + STAGE_BYTES + 8192))[i * 256 + tid] = E.row_value(uu.pm * 256 + tid); }
        asm volatile("s_waitcnt vmcnt(0) lgkmcnt(0)" ::: "memory"); PG8_BAR; asm volatile("" ::: "memory");
    }
    PG8_STAGE(PG8_SB(0, 0), cB, B); PG8_STAGE(PG8_SB(0, 1), cB + hstepB, B); PG8_STAGE_A(PG8_SA(0, 0), cA, 0, go); PG8_STAGE_A(PG8_SA(0, 1), cA, 1, go);
    if (wr == 1) PG8_BAR;
    PG8_WAIT_V(2); PG8_BAR;
    PG8_STAGE(PG8_SB(1, 0), cB + kstep, B); PG8_STAGE_A(PG8_SA(1, 0), cA + kstep, 0, go); PG8_STAGE(PG8_SB(1, 1), cB + hstepB + kstep, B);
    PG8_WAIT_V(6); PG8_BAR;
    for (;;) {
        const bool has_next = S.next(ui + 1, nxt);
        const char* nA = has_next ? nxt.a : cA; const char* nB = has_next ? nxt.b : cB;
        for (int t = 0; t < nt; t += 2) {
            const bool last = (t == nt - 2);
            const char* a1 = cA + (size_t)(t + 1) * kstep;
            const char* a2 = last ? nA : cA + (size_t)(t + 2) * kstep; const char* b2 = last ? nB : cB + (size_t)(t + 2) * kstep;
            const char* a3 = a2 + kstep; const char* b3 = b2 + kstep;
            if constexpr (GATHER) { if (last && has_next) { int R, C; stage_rc(tid * 16, R, C);
#pragma unroll
                for (int h = 0; h < 2; ++h)
#pragma unroll
                    for (int i = 0; i < 2; ++i) gn[h][i] = lidx[(ui + 1) * 256 + h * 128 + i * 64 + R] + (unsigned)(C * 2); } }
            unsigned gx[2][2];
#pragma unroll
            for (int h = 0; h < 2; ++h)
#pragma unroll
                for (int i = 0; i < 2; ++i) gx[h][i] = GATHER ? (last ? gn[h][i] : go[h][i]) : 0u;
            PG8_LDB(B0, 0, 0); PG8_LDB(B1, 0, 1); PG8_SCHED; PG8_LDA(At, 0, 0); PG8_STAGE_A(PG8_SA(1, 1), a1, 1, go);
            PG8_WAIT_V(8); PG8_WAIT_L(0); PG8_BAR; PG8_MMA(0, 0, At, B0); PG8_MMA(0, 1, At, B1); PG8_BAR; PG8_SCHED;
            PG8_LDA(At, 0, 1); PG8_STAGE(PG8_SB(0, 0), b2, B); PG8_STAGE(PG8_SB(0, 1), b2 + hstepB, B); PG8_STAGE_A(PG8_SA(0, 0), a2, 0, gx);
            PG8_WAIT_V(8); PG8_WAIT_L(0); PG8_BAR; PG8_MMA(1, 0, At, B0); PG8_MMA(1, 1, At, B1); PG8_BAR; PG8_SCHED;
            PG8_LDB(B0, 1, 0); PG8_LDB(B1, 1, 1); PG8_SCHED; PG8_LDA(At, 1, 0); PG8_STAGE_A(PG8_SA(0, 1), a2, 1, gx);
            PG8_WAIT_V(8); PG8_WAIT_L(0); PG8_BAR; PG8_MMA(0, 0, At, B0); PG8_MMA(0, 1, At, B1); PG8_BAR; PG8_SCHED;
            PG8_LDA(At, 1, 1); PG8_STAGE(PG8_SB(1, 0), b3, B); PG8_STAGE(PG8_SB(1, 1), b3 + hstepB, B); PG8_STAGE_A(PG8_SA(1, 0), a3, 0, gx);
            PG8_WAIT_V(8); PG8_WAIT_L(0); PG8_BAR; PG8_MMA(1, 0, At, B0); PG8_MMA(1, 1, At, B1); PG8_BAR; PG8_SCHED;
            if constexpr (GATHER) { if (last) {
#pragma unroll
                for (int h = 0; h < 2; ++h)
#pragma unroll
                    for (int i = 0; i < 2; ++i) go[h][i] = gn[h][i]; } }
        }
        if (wr == 0) PG8_BAR;
        { const int le = lane_id_fresh();
          E(acc, cur, wr, wc, le & 15, le >> 4, lds + STAGE_BYTES, wid, le, ui); }
        if (!has_next) break;
#pragma unroll
        for (int a = 0; a < 2; ++a)
#pragma unroll
            for (int b = 0; b < 2; ++b)
#pragma unroll
                for (int m = 0; m < 4; ++m)
#pragma unroll
                    for (int n = 0; n < 2; ++n) acc[a][b][m][n] = (f32x4){0.f, 0.f, 0.f, 0.f};
        cur = nxt; cA = nA; cB = nB; ++ui;
        if (wr == 1) PG8_BAR;
    }
    PG8_WAIT_V(0);
    PG8_BAR;
#undef PG8_SA
#undef PG8_SB
#undef PG8_STAGE
#undef PG8_STAGE_A
#undef PG8_LDA
#undef PG8_LDB
#undef PG8_MMA
#undef PG8_WAIT_V
#undef PG8_WAIT_L
#undef PG8_BAR
#undef PG8_SCHED
}

struct DenseOrder {
    int nM, nN, nwg, G, c; const char* A; const char* Bt; size_t tA, tB; int bdiv; size_t bstride;
    __device__ __forceinline__ void init(int M, int N, int G_, int c_, const void* A_, int lda, const void* Bt_, int ldb, int bdiv_ = 0, size_t bstride_ = 0) {
        nM = M / BM; nN = N / BM; nwg = nM * nN; G = G_; c = c_; A = (const char*)A_; Bt = (const char*)Bt_; tA = (size_t)BM * lda * 2; tB = (size_t)BM * ldb * 2; bdiv = bdiv_; bstride = bstride_; }
    __device__ __forceinline__ bool next(int i, Unit& u) const {
        const long L = (long)i * G + c; if (L >= nwg) return false;
        int wgid = (int)L; { const int q = nwg / NXCD, r = nwg % NXCD, xcd = wgid % NXCD, off = wgid / NXCD; wgid = (xcd < r ? xcd * (q + 1) : r * (q + 1) + (xcd - r) * q) + off; }
        const int nig = WGM * nN, gid = wgid / nig, fm = gid * WGM, gsz = (nM - fm) < WGM ? (nM - fm) : WGM;
        u.pm = fm + ((wgid % nig) % gsz); u.pn = (wgid % nig) / gsz; u.aux = 0;
        u.a = A + (size_t)u.pm * tA; u.b = Bt + (size_t)u.pn * tB + (bdiv ? (size_t)(u.pm / bdiv) * bstride : 0);
        return true;
    }
};
}

using pg8::Acc; using pg8::Unit;
#define EPI_ARGS Acc& acc, const Unit& u, int wr, int wc, int fr, int fq, LAS unsigned char* ldsx, int wid, int lane, int ui
struct EpiBf16 {
    static constexpr bool ROWTAB = false;
    bf16_t* O; int ldc;
    __device__ __forceinline__ void operator()(EPI_ARGS) const {
        bf16_t* base = O + (size_t)(u.pm * 256 + wr * 64 + fr) * ldc + u.pn * 256 + wc * 32 + 8 * fq;
#pragma unroll
        for (int ai = 0; ai < 2; ++ai)
#pragma unroll
            for (int m = 0; m < 4; ++m)
#pragma unroll
                for (int bj = 0; bj < 2; ++bj) { const f32x4 v0 = acc[ai][bj][m][0], v1 = acc[ai][bj][m][1]; u32x4 w;
                    w.x = cvt_pk_bf16(v0[0], v0[1]); w.y = cvt_pk_bf16(v0[2], v0[3]); w.z = cvt_pk_bf16(v1[0], v1[1]); w.w = cvt_pk_bf16(v1[2], v1[3]);
                    *(u32x4*)(base + (size_t)(ai * 128 + m * 16) * ldc + bj * 128) = w; }
    }
};
struct EpiBf16Aux {
    static constexpr bool ROWTAB = false;
    bf16_t* O; int ldc;
    __device__ __forceinline__ void operator()(EPI_ARGS) const {
        bf16_t* base = O + (size_t)(unsigned)u.aux + (size_t)(wr * 64 + fr) * ldc + wc * 32 + 8 * fq;
#pragma unroll
        for (int ai = 0; ai < 2; ++ai)
#pragma unroll
            for (int m = 0; m < 4; ++m)
#pragma unroll
                for (int bj = 0; bj < 2; ++bj) { const f32x4 v0 = acc[ai][bj][m][0], v1 = acc[ai][bj][m][1]; u32x4 w;
                    w.x = cvt_pk_bf16(v0[0], v0[1]); w.y = cvt_pk_bf16(v0[2], v0[3]); w.z = cvt_pk_bf16(v1[0], v1[1]); w.w = cvt_pk_bf16(v1[2], v1[3]);
                    *(u32x4*)(base + (size_t)(ai * 128 + m * 16) * ldc + bj * 128) = w; }
    }
};
struct EpiInProj {
    static constexpr bool ROWTAB = false;
    bf16_t *GB, *Z, *UG, *VG;
    __device__ __forceinline__ void operator()(EPI_ARGS) const {
        const int pn = u.pn; const size_t row0 = (size_t)(u.pm * 256 + wr * 64 + fr); const int cl = wc * 32 + 8 * fq;
        if (pn >= 2 && pn < 6) {
            bf16_t* base = Z + row0 * 512 + (pn - 2) * 128 + cl;
#pragma unroll
            for (int ai = 0; ai < 2; ++ai)
#pragma unroll
                for (int m = 0; m < 4; ++m) { const f32x4 z0 = acc[ai][0][m][0] * acc[ai][1][m][0], z1 = acc[ai][0][m][1] * acc[ai][1][m][1]; u32x4 w;
                    w.x = cvt_pk_bf16(z0[0], z0[1]); w.y = cvt_pk_bf16(z0[2], z0[3]); w.z = cvt_pk_bf16(z1[0], z1[1]); w.w = cvt_pk_bf16(z1[2], z1[3]);
                    *(u32x4*)(base + (size_t)(ai * 128 + m * 16) * 512) = w; }
        } else {
            const bool act = pn >= 6;
            const int sel = pn < 2 ? 0 : (pn < 8 ? 2 : 3), ct = pn < 2 ? pn : (pn < 8 ? pn - 6 : pn - 8);
            bf16_t* base = GB + (size_t)sel * (16u << 20) + row0 * 512 + ct * 256 + cl;
#pragma unroll
            for (int ai = 0; ai < 2; ++ai)
#pragma unroll
                for (int m = 0; m < 4; ++m)
#pragma unroll
                    for (int bj = 0; bj < 2; ++bj) { f32x4 v0 = acc[ai][bj][m][0], v1 = acc[ai][bj][m][1];
                        if (act) {
#pragma unroll
                            for (int i = 0; i < 4; ++i) { v0[i] = gelu_fast(v0[i]); v1[i] = gelu_fast(v1[i]); } }
                        u32x4 w; w.x = cvt_pk_bf16(v0[0], v0[1]); w.y = cvt_pk_bf16(v0[2], v0[3]); w.z = cvt_pk_bf16(v1[0], v1[1]); w.w = cvt_pk_bf16(v1[2], v1[3]);
                        *(u32x4*)(base + (size_t)(ai * 128 + m * 16) * 512 + bj * 128) = w; }
        }
    }
};
struct EpiResidA {
    static constexpr bool ROWTAB = false;
    const float* R; bf16_t* XB; float* SSQ;
    __device__ __forceinline__ void operator()(EPI_ARGS) const {
        const size_t row0 = (size_t)(u.pm * 256 + wr * 64 + fr); const int col0 = u.pn * 256 + wc * 32 + 8 * fq;
#pragma unroll
        for (int ai = 0; ai < 2; ++ai)
#pragma unroll
            for (int m = 0; m < 4; ++m) { const size_t off = (row0 + ai * 128 + m * 16) * 1024 + col0; float sq = 0.f;
#pragma unroll
                for (int bj = 0; bj < 2; ++bj) { const f32x4 r0 = __builtin_nontemporal_load((const f32x4*)(R + off + bj * 128)), r1 = __builtin_nontemporal_load((const f32x4*)(R + off + bj * 128 + 4));
                    const f32x4 v0 = r0 + acc[ai][bj][m][0], v1 = r1 + acc[ai][bj][m][1];
                    u32x4 w; w.x = cvt_pk_bf16(v0[0], v0[1]); w.y = cvt_pk_bf16(v0[2], v0[3]); w.z = cvt_pk_bf16(v1[0], v1[1]); w.w = cvt_pk_bf16(v1[2], v1[3]); *(u32x4*)(XB + off + bj * 128) = w;
                    sq += (v0[0] * v0[0] + v0[1] * v0[1]) + (v0[2] * v0[2] + v0[3] * v0[3]) + (v1[0] * v1[0] + v1[1] * v1[1]) + (v1[2] * v1[2] + v1[3] * v1[3]); }
                sq += __shfl_xor(sq, 16); sq += __shfl_xor(sq, 32); if (fq == 0) SSQ[(row0 + ai * 128 + m * 16) * 16 + u.pn * 4 + wc] = sq;
                if (m & 1) asm volatile("" ::: "memory"); }
    }
};
struct EpiResidB {
    static constexpr bool ROWTAB = false;
    const bf16_t* RB; bf16_t* XB;
    __device__ __forceinline__ void operator()(EPI_ARGS) const {
        const size_t row0 = (size_t)(u.pm * 256 + wr * 64 + fr); const int col0 = u.pn * 256 + wc * 32 + 8 * fq;
#pragma unroll
        for (int ai = 0; ai < 2; ++ai)
#pragma unroll
            for (int m = 0; m < 4; ++m) { const size_t off = (row0 + ai * 128 + m * 16) * 1024 + col0;
#pragma unroll
                for (int bj = 0; bj < 2; ++bj) { const u32x4 r = __builtin_nontemporal_load((const u32x4*)(RB + off + bj * 128));
                    const f32x4 v0 = (f32x4){bf_lo(r.x), bf_hi(r.x), bf_lo(r.y), bf_hi(r.y)} + acc[ai][bj][m][0], v1 = (f32x4){bf_lo(r.z), bf_hi(r.z), bf_lo(r.w), bf_hi(r.w)} + acc[ai][bj][m][1];
                    u32x4 w; w.x = cvt_pk_bf16(v0[0], v0[1]); w.y = cvt_pk_bf16(v0[2], v0[3]); w.z = cvt_pk_bf16(v1[0], v1[1]); w.w = cvt_pk_bf16(v1[2], v1[3]); *(u32x4*)(XB + off + bj * 128) = w; }
                if (m & 1) asm volatile("" ::: "memory"); }
    }
};
struct EpiSoftmax {
    static constexpr bool ROWTAB = true;
    const float* SSQ; bf16_t* P;
    __device__ __forceinline__ float row_value(int row) const {
        const f32x4* q = (const f32x4*)(SSQ + (size_t)row * 16); const f32x4 q0 = q[0], q1 = q[1], q2 = q[2], q3 = q[3];
        const float ss = ((q0[0] + q0[1]) + (q0[2] + q0[3])) + ((q1[0] + q1[1]) + (q1[2] + q1[3])) + ((q2[0] + q2[1]) + (q2[2] + q2[3])) + ((q3[0] + q3[1]) + (q3[2] + q3[3]));
        return rsqrtf(ss * (1.f / 1024.f) + EPS); }
    __device__ __forceinline__ void operator()(EPI_ARGS) const {
        const size_t row0 = (size_t)(u.pm * 256 + wr * 64 + fr);
        LAS f32x2* ex = (LAS f32x2*)ldsx;
        float mw[2][4], rsv[2][4];
#pragma unroll
        for (int ai = 0; ai < 2; ++ai)
#pragma unroll
            for (int m = 0; m < 4; ++m) rsv[ai][m] = ((const LAS float*)(ldsx + 8192))[ui * 256 + ai * 128 + wr * 64 + m * 16 + fr];
#pragma unroll
        for (int ai = 0; ai < 2; ++ai)
#pragma unroll
            for (int m = 0; m < 4; ++m) {
                const float rs = rsv[ai][m];
                float mx = -3.0e38f;
#pragma unroll
                for (int bj = 0; bj < 2; ++bj)
#pragma unroll
                    for (int n = 0; n < 2; ++n) { f32x4 v = acc[ai][bj][m][n] * rs; acc[ai][bj][m][n] = v; mx = fmaxf(fmaxf(mx, fmaxf(v[0], v[1])), fmaxf(v[2], v[3])); }
                mx = fmaxf(mx, __shfl_xor(mx, 16)); mx = fmaxf(mx, __shfl_xor(mx, 32));
                float sum = 0.f;
#pragma unroll
                for (int bj = 0; bj < 2; ++bj)
#pragma unroll
                    for (int n = 0; n < 2; ++n) { f32x4 v = acc[ai][bj][m][n];
#pragma unroll
                        for (int i = 0; i < 4; ++i) v[i] = __builtin_amdgcn_exp2f(v[i] - mx);
                        acc[ai][bj][m][n] = v; sum += (v[0] + v[1]) + (v[2] + v[3]); }
                sum += __shfl_xor(sum, 16); sum += __shfl_xor(sum, 32);
                mw[ai][m] = mx;
                if (fq == 0) ex[(ai * 128 + wr * 64 + m * 16 + fr) * 4 + wc] = (f32x2){mx, sum};
            }
        asm volatile("s_waitcnt lgkmcnt(0)" ::: "memory"); __builtin_amdgcn_s_barrier(); asm volatile("" ::: "memory");
        bf16_t* base = P + row0 * 1024 + u.pn * 256 + wc * 32 + 8 * fq;
#pragma unroll
        for (int ai = 0; ai < 2; ++ai)
#pragma unroll
            for (int m = 0; m < 4; ++m) {
                const LAS f32x2* e4 = ex + (ai * 128 + wr * 64 + m * 16 + fr) * 4;
                const f32x2 e0 = e4[0], e1 = e4[1], e2 = e4[2], e3 = e4[3];
                const float M = fmaxf(fmaxf(e0.x, e1.x), fmaxf(e2.x, e3.x));
                const float L = e0.y * __builtin_amdgcn_exp2f(e0.x - M) + e1.y * __builtin_amdgcn_exp2f(e1.x - M) + e2.y * __builtin_amdgcn_exp2f(e2.x - M) + e3.y * __builtin_amdgcn_exp2f(e3.x - M);
                const float f = __builtin_amdgcn_exp2f(mw[ai][m] - M) / L;
#pragma unroll
                for (int bj = 0; bj < 2; ++bj) { const f32x4 v0 = acc[ai][bj][m][0] * f, v1 = acc[ai][bj][m][1] * f; u32x4 w;
                    w.x = cvt_pk_bf16(v0[0], v0[1]); w.y = cvt_pk_bf16(v0[2], v0[3]); w.z = cvt_pk_bf16(v1[0], v1[1]); w.w = cvt_pk_bf16(v1[2], v1[3]);
                    *(u32x4*)(base + (size_t)(ai * 128 + m * 16) * 1024 + bj * 128) = w; }
            }
    }
};
struct WqkOrder {
    int G, c; const char* KV; const char* WQ;
    __device__ __forceinline__ bool next(int i, Unit& u) const {
        const int L = i * G + c; if (L >= 128) return false;
        const int b = L >> 4, h = (L >> 2) & 3, pn = L & 3;
        u.pm = 0; u.pn = pn; u.a = KV + ((size_t)(b * 256) * 2048 + h * 256) * 2; u.b = WQ + ((size_t)(pn * 256) * 1024 + h * 256) * 2;
        u.aux = b * (1024 * 1024) + (h * 256) * 1024 + pn * 256; return true; }
};
struct VwOrder {
    int G, c; const char* KV; const char* WO;
    __device__ __forceinline__ bool next(int i, Unit& u) const {
        const int L = i * G + c; if (L >= 128) return false;
        const int b = L >> 4, h = (L >> 2) & 3, pm = L & 3;
        u.pm = pm; u.pn = 0; u.a = WO + ((size_t)(pm * 256) * 1024 + h * 256) * 2; u.b = KV + ((size_t)(b * 256) * 2048 + 1024 + h * 256) * 2;
        u.aux = b * (1024 * 1024) + (pm * 256) * 1024 + h * 256; return true; }
};

struct EpiSwiGLU {
    static constexpr bool ROWTAB = true;
    bf16_t* H; const float* rs_slot;
    __device__ __forceinline__ float row_value(int row) const { return rs_slot[row]; }
    __device__ __forceinline__ void operator()(EPI_ARGS) const {
        const size_t row0 = (size_t)(u.pm * 256 + wr * 64 + fr);
        bf16_t* base = H + row0 * 512 + u.pn * 128 + wc * 32 + 8 * fq;
        float rs8[2][4];
#pragma unroll
        for (int ai = 0; ai < 2; ++ai)
#pragma unroll
            for (int m = 0; m < 4; ++m) rs8[ai][m] = ((const LAS float*)(ldsx + 8192))[ui * 256 + ai * 128 + wr * 64 + m * 16 + fr];
#pragma unroll
        for (int ai = 0; ai < 2; ++ai)
#pragma unroll
            for (int m = 0; m < 4; ++m) { const float rs = rs8[ai][m]; f32x4 h0, h1;
#pragma unroll
                for (int i = 0; i < 4; ++i) { const float g0 = acc[ai][0][m][0][i] * rs, g1 = acc[ai][0][m][1][i] * rs;
                    h0[i] = g0 * __builtin_amdgcn_rcpf(1.0f + __builtin_amdgcn_exp2f(-1.4426950408889634f * g0)) * (acc[ai][1][m][0][i] * rs);
                    h1[i] = g1 * __builtin_amdgcn_rcpf(1.0f + __builtin_amdgcn_exp2f(-1.4426950408889634f * g1)) * (acc[ai][1][m][1][i] * rs); }
                u32x4 w; w.x = cvt_pk_bf16(h0[0], h0[1]); w.y = cvt_pk_bf16(h0[2], h0[3]); w.z = cvt_pk_bf16(h1[0], h1[1]); w.w = cvt_pk_bf16(h1[2], h1[3]);
                *(u32x4*)(base + (size_t)(ai * 128 + m * 16) * 512) = w; }
    }
};
struct EpiDown {
    static constexpr bool ROWTAB = true;
    bf16_t* Y; const float* gate;
    __device__ __forceinline__ float row_value(int row) const { return gate[row]; }
    __device__ __forceinline__ void operator()(EPI_ARGS) const {
        const size_t row0 = (size_t)(u.pm * 256 + wr * 64 + fr);
        bf16_t* base = Y + row0 * 1024 + u.pn * 256 + wc * 32 + 8 * fq;
        float g8[2][4];
#pragma unroll
        for (int ai = 0; ai < 2; ++ai)
#pragma unroll
            for (int m = 0; m < 4; ++m) g8[ai][m] = ((const LAS float*)(ldsx + 8192))[ui * 256 + ai * 128 + wr * 64 + m * 16 + fr];
#pragma unroll
        for (int ai = 0; ai < 2; ++ai)
#pragma unroll
            for (int m = 0; m < 4; ++m) { const float g = g8[ai][m];
#pragma unroll
                for (int bj = 0; bj < 2; ++bj) { const f32x4 v0 = acc[ai][bj][m][0] * g, v1 = acc[ai][bj][m][1] * g; u32x4 w;
                    w.x = cvt_pk_bf16(v0[0], v0[1]); w.y = cvt_pk_bf16(v0[2], v0[3]); w.z = cvt_pk_bf16(v1[0], v1[1]); w.w = cvt_pk_bf16(v1[2], v1[3]);
                    *(u32x4*)(base + (size_t)(ai * 128 + m * 16) * 1024 + bj * 128) = w; } }
    }
};
struct GroupedOrder {
    int G, c, nunits; const int* tile_e; const char* A; const char* W; size_t tA, wE, tB;
    __device__ __forceinline__ void init(int G_, int c_, const int* tbl, const void* A_, int lda, const void* W_, int ldb, size_t expert_bytes, bool gather = false) {
        G = G_; c = c_; tile_e = tbl + 16; nunits = 4 * __builtin_amdgcn_readfirstlane(__hip_atomic_load(tbl, __ATOMIC_RELAXED, __HIP_MEMORY_SCOPE_AGENT)); A = (const char*)A_; W = (const char*)W_; tA = gather ? 0 : (size_t)256 * lda * 2; tB = (size_t)256 * ldb * 2; wE = expert_bytes; }
    __device__ __forceinline__ bool next(int i, Unit& u) const {
        const int L = i * G + c; if (L >= nunits) return false;
        int wgid = L; { const int q = nunits / 8, r = nunits % 8, xcd = wgid % 8, off = wgid / 8; wgid = (xcd < r ? xcd * (q + 1) : r * (q + 1) + (xcd - r) * q) + off; }
        const int tile = wgid >> 2, pn = wgid & 3, e = __builtin_amdgcn_readfirstlane(__hip_atomic_load(tile_e + tile, __ATOMIC_RELAXED, __HIP_MEMORY_SCOPE_AGENT));
        u.pm = tile; u.pn = pn; u.aux = e; u.a = A + (size_t)tile * tA; u.b = W + (size_t)e * wE + (size_t)pn * tB; return true; }
};

struct Args {
    const float* in[26]; float* out; unsigned char* ws; int ph_lo, ph_hi;
};
struct Frame {
    LAS unsigned char* lds; int wave, vcu, G; unsigned char* ws; float* out;
};
#define IN_X 0
#define IN_MEM 1
#define IN_G_MIX 2
#define IN_W_IN 3
#define IN_CONV_W 4
#define IN_G_V 5
#define IN_W_S 6
#define IN_B_S 7
#define IN_G_OUT_CONV 8
#define IN_G_OUT_GMLP 9
#define IN_W_OUT 10
#define IN_G_XATTN 11
#define IN_G_MEM 12
#define IN_W_Q 13
#define IN_W_K 14
#define IN_W_V 15
#define IN_W_O 16
#define IN_G_FFN 17
#define IN_W_GRP 18
#define IN_B_GRP 19
#define IN_W_RT 20
#define IN_B_RT 21
#define IN_W_GATE 22
#define IN_W_UP 23
#define IN_W_DOWN 24
#define IN_G_FINAL 25

struct TrItem { const float* src; bf16_t* dst; const float* gk; int ldw, K; };
__device__ __forceinline__ void tr_load(const TrItem& t, float (&v)[32], int lane) {
    const float* p = t.src + (size_t)(lane >> 5) * t.ldw + (lane & 31);
#pragma unroll
    for (int i = 0; i < 32; ++i) v[i] = __builtin_nontemporal_load(p + (size_t)(2 * i) * t.ldw);
}
__device__ __forceinline__ void tr_finish(const TrItem& t, const float (&v)[32], LAS float* scr, int lane) {
    float g8[8];
    if (t.gk) { const f32x4 ga = *(const f32x4*)(t.gk + 8 * (lane & 7)), gb = *(const f32x4*)(t.gk + 8 * (lane & 7) + 4); g8[0] = ga[0]; g8[1] = ga[1]; g8[2] = ga[2]; g8[3] = ga[3]; g8[4] = gb[0]; g8[5] = gb[1]; g8[6] = gb[2]; g8[7] = gb[3]; }
    else {
#pragma unroll
        for (int j = 0; j < 8; ++j) g8[j] = 1.f; }
#pragma unroll
    for (int i = 0; i < 32; ++i) scr[(2 * i + (lane >> 5)) * 33 + (lane & 31)] = v[i];
    LDS_WAIT(); asm volatile("" ::: "memory");
    const int c = lane & 7;
#pragma unroll
    for (int j = 0; j < 4; ++j) { const int n = (lane >> 3) + 8 * j; const LAS float* s = scr + (8 * c) * 33 + n;
        u32x4 o; o.x = pk2(s[0 * 33] * g8[0], s[1 * 33] * g8[1]); o.y = pk2(s[2 * 33] * g8[2], s[3 * 33] * g8[3]); o.z = pk2(s[4 * 33] * g8[4], s[5 * 33] * g8[5]); o.w = pk2(s[6 * 33] * g8[6], s[7 * 33] * g8[7]);
        *(u32x4*)(t.dst + (size_t)n * t.K + 8 * c) = o; }
    LDS_WAIT(); asm volatile("" ::: "memory");
}
__device__ __forceinline__ TrItem tr_make(const float* W, int ldw, int K, bf16_t* WT, int dst_row0, int src_col0, int k0, const float* gk = nullptr) {
    TrItem t; t.src = W + (size_t)k0 * ldw + src_col0; t.dst = WT + (size_t)dst_row0 * K + k0; t.gk = gk ? gk + k0 : nullptr; t.ldw = ldw; t.K = K; return t; }
__device__ __forceinline__ int in_map(int n0) {
    if (n0 < 512 || n0 >= 1536) return n0;
    const int j = (n0 - 512) >> 8, r = (n0 - 512) & 255;
    return r < 128 ? 512 + 128 * j + r : 1024 + 128 * j + (r - 128);
}
__device__ __forceinline__ void norm_row_bf16(const float* xrow, const float* g, bf16_t* orow, int lane) {
    const f32x4* xr = (const f32x4*)xrow + lane; const f32x4* gr = (const f32x4*)g + lane;
    f32x4 v[4]; float s = 0.f;
#pragma unroll
    for (int j = 0; j < 4; ++j) { v[j] = xr[64 * j]; s += (v[j].x * v[j].x + v[j].y * v[j].y) + (v[j].z * v[j].z + v[j].w * v[j].w); }
    const float rs = rsqrtf(wave_sum(s) * (1.f / 1024.f) + EPS);
    u32x2* o8 = (u32x2*)orow + lane;
#pragma unroll
    for (int j = 0; j < 4; ++j) { const f32x4 gg = gr[64 * j]; u32x2 w; w.x = pk2(v[j].x * rs * gg.x, v[j].y * rs * gg.y); w.y = pk2(v[j].z * rs * gg.z, v[j].w * rs * gg.w); o8[64 * j] = w; }
}
__device__ __forceinline__ void norm_rows4_bf16(const float* X, const float* g, bf16_t* O, int m, int stride, int M, int lane) {
    f32x4 v[4][4]; float s[4]; const f32x4* gr = (const f32x4*)g + lane;
#pragma unroll
    for (int r = 0; r < 4; ++r) { const int mr = (m + r * stride < M) ? m + r * stride : m; const f32x4* xr = (const f32x4*)(X + (size_t)mr * 1024) + lane;
#pragma unroll
        for (int j = 0; j < 4; ++j) v[r][j] = __builtin_nontemporal_load(xr + 64 * j); }
#pragma unroll
    for (int r = 0; r < 4; ++r) { s[r] = 0.f;
#pragma unroll
        for (int j = 0; j < 4; ++j) s[r] += (v[r][j].x * v[r][j].x + v[r][j].y * v[r][j].y) + (v[r][j].z * v[r][j].z + v[r][j].w * v[r][j].w); }
#pragma unroll
    for (int r = 0; r < 4; ++r) { if (m + r * stride >= M) break; const float rs = rsqrtf(wave_sum(s[r]) * (1.f / 1024.f) + EPS); u32x2* o8 = (u32x2*)(O + (size_t)(m + r * stride) * 1024) + lane;
#pragma unroll
        for (int j = 0; j < 4; ++j) { const f32x4 gg = gr[64 * j]; u32x2 w; w.x = pk2(v[r][j].x * rs * gg.x, v[r][j].y * rs * gg.y); w.y = pk2(v[r][j].z * rs * gg.z, v[r][j].w * rs * gg.w); o8[64 * j] = w; } }
}
constexpr int PRO_I_IN = 16 * 80, PRO_I_SQ = 16 * 32, PRO_I_G = 16 * 16, PRO_I_D = 8 * 32, PRO_NITEMS = PRO_I_IN + 4 * PRO_I_SQ + NE * (2 * PRO_I_G + PRO_I_D);
__device__ __forceinline__ TrItem pro_item(const Args& a, unsigned char* ws, int it) {
    int r = it;
    if (r < PRO_I_IN) { const int kb = r / 80, nb = r % 80; return tr_make(a.in[IN_W_IN], INC, D, (bf16_t*)(ws + WS_WIN_T), 32 * nb, in_map(32 * nb), 64 * kb); } r -= PRO_I_IN;
    if (r < 4 * PRO_I_SQ) { const int q = r / PRO_I_SQ; r -= q * PRO_I_SQ; const int kb = r / 32, nb = r % 32;
        const float* W = a.in[q == 0 ? IN_W_OUT : (q == 1 ? IN_W_O : (q == 2 ? IN_W_K : IN_W_V))];
        bf16_t* WT = (bf16_t*)(ws + (q == 0 ? WS_WOUT_T : (q == 1 ? WS_WO_T : WS_WKV_T)));
        return tr_make(W, D, D, WT, (q == 3 ? 1024 : 0) + 32 * nb, 32 * nb, 64 * kb); }
    r -= 4 * PRO_I_SQ;
    const int e = r / (2 * PRO_I_G + PRO_I_D); r -= e * (2 * PRO_I_G + PRO_I_D);
    if (r < 2 * PRO_I_G) { const int up = r >= PRO_I_G; if (up) r -= PRO_I_G; const int kb = r / 16, nb = r % 16, n0 = 32 * nb;
        const int dst = 256 * (n0 >> 7) + (up ? 128 : 0) + (n0 & 127);
        return tr_make(a.in[up ? IN_W_UP : IN_W_GATE] + (size_t)e * D * DE, DE, D, (bf16_t*)(ws + WS_WGU_T) + (size_t)e * 1024 * 1024, dst, n0, 64 * kb, a.in[IN_G_FFN]); }
    r -= 2 * PRO_I_G;
    const int kb = r / 32, nb = r % 32;
    return tr_make(a.in[IN_W_DOWN] + (size_t)e * DE * D, D, DE, (bf16_t*)(ws + WS_WD_T) + (size_t)e * 1024 * 512, 32 * nb, 32 * nb, 64 * kb);
}
__device__ __forceinline__ void p0_prologue(const Frame& F, const Args& a) {
    LAS float* scr = (LAS float*)(F.lds + F.wave * 16384);
    const int lane = lane_id_fresh(), tid = F.wave * 64 + lane;
    unsigned char* ws = F.ws;
    const int gw = F.vcu * NWAVES + F.wave, NGW = F.G * NWAVES;
    {
        float va[32], vb[32]; TrItem ta, tb;
        int it = gw;
        if (it < PRO_NITEMS) { ta = pro_item(a, ws, it); tr_load(ta, va, lane); }
        while (it < PRO_NITEMS) {
            const int i1 = it + NGW; const bool h1 = i1 < PRO_NITEMS;
            if (h1) { tb = pro_item(a, ws, i1); tr_load(tb, vb, lane); }
            tr_finish(ta, va, scr, lane);
            if (!h1) break;
            const int i2 = i1 + NGW; const bool h2 = i2 < PRO_NITEMS;
            if (h2) { ta = pro_item(a, ws, i2); tr_load(ta, va, lane); }
            tr_finish(tb, vb, scr, lane);
            it = i2;
        }
    }
    for (int m = gw; m < T; m += 4 * NGW) norm_rows4_bf16(a.in[IN_X], a.in[IN_G_MIX], (bf16_t*)(ws + WS_HB), m, NGW, T, lane);
    for (int m = gw; m < B * ML; m += NGW) norm_row_bf16(a.in[IN_MEM] + (size_t)m * D, a.in[IN_G_MEM], (bf16_t*)(ws + WS_MEMN) + (size_t)m * D, lane);
    const int gt = F.vcu * NTHREADS + tid, NGT = F.G * NTHREADS;
    { const float* wq = a.in[IN_W_Q]; const float* gx = a.in[IN_G_XATTN]; bf16_t* o = (bf16_t*)(ws + WS_WQ_NAT);
      for (int i = gt; i < D * D / 2; i += NGT) { const int k = (2 * i) >> 10; const float sc = gx[k] * (1.4426950408889634f * 0.0625f); const f32x2 v = *(const f32x2*)(wq + 2 * i); *(unsigned*)(o + 2 * i) = pk2(v.x * sc, v.y * sc); } }
    { const float* w = a.in[IN_W_S]; bf16_t* o = (bf16_t*)(ws + WS_WS_BF);
      for (int i = gt; i < NH * CHUNK * CHUNK; i += NGT) { const int s = i & 127, t = (i >> 7) & 127; o[i] = (bf16_t)f2bf(s <= t ? w[i] : 0.f); } }
    { const float* wg = a.in[IN_W_GRP]; const float* wr = a.in[IN_W_RT]; const float* gf = a.in[IN_G_FFN]; bf16_t* o = (bf16_t*)(ws + WS_WR);
      for (int i = gt; i < 48 * 1024; i += NGT) { const int n = i >> 10, k = i & 1023; float v = 0.f;
          if (n < 4) v = wg[(size_t)k * NG + n] * gf[k]; else if (n < 36) v = wr[(size_t)k * NE + (n - 4)] * gf[k];
          const unsigned hi = f2bf(v); const float lo = v - __uint_as_float(hi << 16); o[i] = (bf16_t)hi; o[48 * 1024 + i] = (bf16_t)f2bf(lo); } }
}

__device__ __forceinline__ void unpack8(const u32x4 w, float (&f)[8]) { f[0] = bf_lo(w.x); f[1] = bf_hi(w.x); f[2] = bf_lo(w.y); f[3] = bf_hi(w.y); f[4] = bf_lo(w.z); f[5] = bf_hi(w.z); f[6] = bf_lo(w.w); f[7] = bf_hi(w.w); }
constexpr int VT_PITCH = 136, VT_HEAD = 128 * VT_PITCH, MIX_EXCH = 8 * VT_HEAD;
__device__ __forceinline__ void mixer_unit(const Frame& F, const Args& a, int ch) {
    const int t0 = ch * 128, w = F.wave, l = lane_id_fresh();
    unsigned char* ws = F.ws;
    const bf16_t* GBp = (const bf16_t*)(ws + WS_GB); const bf16_t* Zp = (const bf16_t*)(ws + WS_Z); const bf16_t* UGp = (const bf16_t*)(ws + WS_UG); const bf16_t* VGp = (const bf16_t*)(ws + WS_VG);
    bf16_t* Y = (bf16_t*)(ws + WS_Y);
    __syncthreads();
    const int h = w;
    u32x4 vraw[16], uraw[16];
    {
        const int c = 8 * l;
        const int r0 = 16 * w, pos0 = (t0 & (S - 1)) + r0; const unsigned coff = (unsigned)(c * 2);
        u32x4 gbr[4], zr[4], zh1, zh2;
#pragma unroll
        for (int r = 0; r < 4; ++r) { const size_t t = (size_t)(t0 + r0 + r); gbr[r] = __builtin_nontemporal_load((const u32x4*)(pg8::uni((const char*)(GBp + t * 512)) + coff)); zr[r] = __builtin_nontemporal_load((const u32x4*)(pg8::uni((const char*)(Zp + t * 512)) + coff)); }
        if (pos0 >= 2) { zh1 = *(const u32x4*)(Zp + (size_t)(t0 + r0 - 1) * 512 + c); zh2 = *(const u32x4*)(Zp + (size_t)(t0 + r0 - 2) * 512 + c); } else { zh1 = (u32x4){0u, 0u, 0u, 0u}; zh2 = zh1; }
        asm volatile("" ::: "memory");
        { const unsigned voff = (unsigned)((((l >> 3) * 512) + 8 * (l & 7)) * 2);
#pragma unroll
          for (int it = 0; it < 16; ++it) vraw[it] = __builtin_nontemporal_load((const u32x4*)(pg8::uni((const char*)(VGp + (size_t)(t0 + 8 * it) * 512 + h * 64)) + voff));
 }
        asm volatile("" ::: "memory");
        float w0[8], w1[8], w2[8], ga[8], zp1[8], zp2[8];
        const float* cw = a.in[IN_CONV_W]; const float* gc = a.in[IN_G_OUT_CONV];
#pragma unroll
        for (int j = 0; j < 8; ++j) { w0[j] = cw[c + j]; w1[j] = cw[CW + c + j]; w2[j] = cw[2 * CW + c + j]; ga[j] = gc[c + j]; }
        unpack8(zh1, zp1); unpack8(zh2, zp2);
#pragma unroll 1
        for (int bt = 0; bt < 4; ++bt) {
            if (bt >= 1) {
#pragma unroll
                for (int r = 0; r < 4; ++r) { const size_t t = (size_t)(t0 + r0 + 4 * bt + r); gbr[r] = __builtin_nontemporal_load((const u32x4*)(pg8::uni((const char*)(GBp + t * 512)) + coff)); zr[r] = __builtin_nontemporal_load((const u32x4*)(pg8::uni((const char*)(Zp + t * 512)) + coff)); } }
#pragma unroll
            for (int r = 0; r < 4; ++r) {
                const size_t t = (size_t)(t0 + r0 + 4 * bt + r);
                float gb[8], z[8], ya[8]; unpack8(gbr[r], gb); unpack8(zr[r], z);
                float sq = 0.f;
#pragma unroll
                for (int j = 0; j < 8; ++j) { ya[j] = gb[j] * (w2[j] * z[j] + w1[j] * zp1[j] + w0[j] * zp2[j]); sq += ya[j] * ya[j]; zp2[j] = zp1[j]; zp1[j] = z[j]; }
                const float rs = rsqrtf(wave_sum(sq) * (1.f / 512.f) + EPS);
                u32x4 o; o.x = pk2(ya[0] * rs * ga[0], ya[1] * rs * ga[1]); o.y = pk2(ya[2] * rs * ga[2], ya[3] * rs * ga[3]); o.z = pk2(ya[4] * rs * ga[4], ya[5] * rs * ga[5]); o.w = pk2(ya[6] * rs * ga[6], ya[7] * rs * ga[7]);
                *(u32x4*)(const_cast<char*>(pg8::uni((const char*)(Y + t * 1024))) + coff) = o;
            }
            asm volatile("" ::: "memory");
        }
    }
    asm volatile("" ::: "memory");
    { const unsigned voff = (unsigned)((((l >> 3) * 512) + 8 * (l & 7)) * 2);
#pragma unroll
      for (int it = 0; it < 16; ++it) uraw[it] = __builtin_nontemporal_load((const u32x4*)(pg8::uni((const char*)(UGp + (size_t)(t0 + 8 * it) * 512 + h * 64)) + voff)); }
    LAS unsigned char* vt = F.lds + h * VT_HEAD;
    {
        const int d8 = 8 * (l & 7); float gv[8];
#pragma unroll
        for (int j = 0; j < 8; ++j) gv[j] = a.in[IN_G_V][h * 64 + d8 + j];
#pragma unroll
        for (int it = 0; it < 16; ++it) { const int s = 8 * it + (l >> 3); float v[8]; unpack8(vraw[it], v);
            float sq = 0.f;
#pragma unroll
            for (int j = 0; j < 8; ++j) sq += v[j] * v[j];
            sq += __shfl_xor(sq, 1); sq += __shfl_xor(sq, 2); sq += __shfl_xor(sq, 4);
            const float rs = rsqrtf(sq * (1.f / 64.f) + EPS);
            u32x2 lo, hi; lo.x = pk2(v[0] * rs * gv[0], v[1] * rs * gv[1]); lo.y = pk2(v[2] * rs * gv[2], v[3] * rs * gv[3]); hi.x = pk2(v[4] * rs * gv[4], v[5] * rs * gv[5]); hi.y = pk2(v[6] * rs * gv[6], v[7] * rs * gv[7]);
            *(LAS u32x2*)(vt + s * VT_PITCH + d8 * 2) = lo; *(LAS u32x2*)(vt + s * VT_PITCH + d8 * 2 + 8) = hi; }
    }
    __syncthreads();
    const int fr = l & 15, fq = l >> 4, trq = (l & 15) >> 2, trp = l & 3;
    const bf16_t* wsb = (const bf16_t*)(ws + WS_WS_BF) + (size_t)h * CHUNK * CHUNK;
    const unsigned wloff = (unsigned)(fr * CHUNK + 8 * fq);
    const float* bsp = a.in[IN_B_S] + h * CHUNK;
#pragma unroll 1
    for (int half = 0; half < 2; ++half) {
        f32x4 acc[8][2];
#pragma unroll
        for (int m = 0; m < 8; ++m)
#pragma unroll
            for (int n = 0; n < 2; ++n) acc[m][n] = (f32x4){0.f, 0.f, 0.f, 0.f};
#pragma unroll
        for (int ks = 0; ks < 4; ++ks) {
            unsigned wl = wloff; asm volatile("" : "+v"(wl));
            bf16x8 af[2];
#pragma unroll
            for (int n = 0; n < 2; ++n) { const int dc = 32 * half + 16 * n + 4 * trp;
                const s16x4 lo = __builtin_bit_cast(s16x4, __builtin_amdgcn_ds_read_tr16_b64_v4i16((LAS s16x4*)(vt + (32 * ks + 8 * fq + trq) * VT_PITCH + dc * 2)));
                const s16x4 hi = __builtin_bit_cast(s16x4, __builtin_amdgcn_ds_read_tr16_b64_v4i16((LAS s16x4*)(vt + (32 * ks + 8 * fq + 4 + trq) * VT_PITCH + dc * 2)));
                af[n] = (bf16x8){lo[0], lo[1], lo[2], lo[3], hi[0], hi[1], hi[2], hi[3]}; }
#pragma unroll
            for (int m = 2 * ks; m < 8; ++m) {
                const bf16x8 bfr = *(const bf16x8*)(wsb + (16 * m * CHUNK + 32 * ks) + wl);
#pragma unroll
                for (int n = 0; n < 2; ++n) acc[m][n] = __builtin_amdgcn_mfma_f32_16x16x32_bf16(af[n], bfr, acc[m][n], 0, 0, 0);
            }
        }
#pragma unroll
        for (int m = 0; m < 8; ++m) { const float bs = bsp[16 * m + fr];
#pragma unroll
            for (int n = 0; n < 2; ++n) { const int dc = 32 * half + 16 * n + 4 * fq;
                u32x2 o; o.x = pk2(acc[m][n][0] + bs, acc[m][n][1] + bs); o.y = pk2(acc[m][n][2] + bs, acc[m][n][3] + bs);
                *(LAS u32x2*)(vt + (16 * m + fr) * VT_PITCH + dc * 2) = o; } }
    }
    asm volatile("s_waitcnt lgkmcnt(0)" ::: "memory");
    LAS float* exch = (LAS float*)(F.lds + MIX_EXCH);
    {
        const int d8 = 8 * (l & 7);
#pragma unroll
        for (int it = 0; it < 16; ++it) { const int sidx = 8 * it + (l >> 3);
            const u32x2 lo = *(const LAS u32x2*)(vt + sidx * VT_PITCH + d8 * 2), hi = *(const LAS u32x2*)(vt + sidx * VT_PITCH + d8 * 2 + 8);
            float uf[8]; unpack8(uraw[it], uf);
            const float y0 = uf[0] * bf_lo(lo.x), y1 = uf[1] * bf_hi(lo.x), y2 = uf[2] * bf_lo(lo.y), y3 = uf[3] * bf_hi(lo.y), y4 = uf[4] * bf_lo(hi.x), y5 = uf[5] * bf_hi(hi.x), y6 = uf[6] * bf_lo(hi.y), y7 = uf[7] * bf_hi(hi.y);
            float sq = ((y0 * y0 + y1 * y1) + (y2 * y2 + y3 * y3)) + ((y4 * y4 + y5 * y5) + (y6 * y6 + y7 * y7));
            sq += __shfl_xor(sq, 1); sq += __shfl_xor(sq, 2); sq += __shfl_xor(sq, 4);
            if ((l & 7) == 0) exch[h * CHUNK + sidx] = sq;
            uraw[it] = (u32x4){pk2(y0, y1), pk2(y2, y3), pk2(y4, y5), pk2(y6, y7)}; }
    }
    __syncthreads();
    {
        const int d8 = 8 * (l & 7); float gg[8];
#pragma unroll
        for (int j = 0; j < 8; ++j) gg[j] = a.in[IN_G_OUT_GMLP][h * 64 + d8 + j];
#pragma unroll
        for (int it = 0; it < 16; ++it) { const int sidx = 8 * it + (l >> 3); float tot = 0.f;
#pragma unroll
            for (int hh = 0; hh < 8; ++hh) tot += exch[hh * CHUNK + sidx];
            const float rs = rsqrtf(tot * (1.f / 512.f) + EPS);
            float yf[8]; unpack8(uraw[it], yf);
            u32x4 o; o.x = pk2(yf[0] * rs * gg[0], yf[1] * rs * gg[1]); o.y = pk2(yf[2] * rs * gg[2], yf[3] * rs * gg[3]); o.z = pk2(yf[4] * rs * gg[4], yf[5] * rs * gg[5]); o.w = pk2(yf[6] * rs * gg[6], yf[7] * rs * gg[7]);
            *(u32x4*)(Y + (size_t)(t0 + sidx) * 1024 + 512 + h * 64 + d8) = o; }
    }
}

constexpr int RT_XS_PITCH = 272;
constexpr int RT_XS_WAVE = 16 * RT_XS_PITCH;
constexpr int RT_SLAB_OFF = 8 * RT_XS_WAVE;
constexpr int RT_LG_OFF = RT_SLAB_OFF + 2 * 24576;
__device__ __forceinline__ void router_block(const Frame& F, const Args& a, int blk) {
    const int l = lane_id_fresh(), w = F.wave, fr = l & 15, fq = l >> 4, tid = w * 64 + l;
    unsigned char* ws = F.ws;
    LAS unsigned char* xs = F.lds + w * RT_XS_WAVE;
    LAS float* slab = (LAS float*)(F.lds + RT_SLAB_OFF);
    LAS float* lg = (LAS float*)(F.lds + RT_LG_OFF);
    LAS float* biasl = lg + 128 * 48;
    LAS int* histl = (LAS int*)(biasl + 64);
    __syncthreads();
    if (tid < 32) histl[tid] = 0;
    if (tid >= 64 && tid < 64 + 36) { const int n = tid - 64; biasl[n] = n < 4 ? a.in[IN_B_GRP][n] : a.in[IN_B_RT][n - 4]; }
    bf16x8 bh[4][3], bl[4][3];
    { const bf16_t* wh = (const bf16_t*)(ws + WS_WR) + (size_t)fr * 1024 + 128 * w + 8 * fq; const bf16_t* wl = wh + 48 * 1024;
#pragma unroll
      for (int ks = 0; ks < 4; ++ks)
#pragma unroll
          for (int nt = 0; nt < 3; ++nt) { bh[ks][nt] = *(const bf16x8*)(wh + (size_t)nt * 16 * 1024 + 32 * ks); bl[ks][nt] = *(const bf16x8*)(wl + (size_t)nt * 16 * 1024 + 32 * ks); } }
    const bf16_t* xg = (const bf16_t*)(ws + WS_X2B) + (size_t)(blk * 128 + fq) * D + 128 * w + 8 * fr;
    u32x4 bufA[4], bufB[4];
#define RT_LOAD(buf, tg) do { _Pragma("unroll") for (int j = 0; j < 4; ++j) buf[j] = *(const u32x4*)(xg + (size_t)(16 * (tg) + 4 * j) * D); } while (0)
#define RT_GROUP(buf, tg) do { \
        float sq[4]; \
        _Pragma("unroll") for (int j = 0; j < 4; ++j) { const u32x4 v = buf[j]; float f[8]; unpack8(v, f); \
            sq[j] = ((f[0] * f[0] + f[1] * f[1]) + (f[2] * f[2] + f[3] * f[3])) + ((f[4] * f[4] + f[5] * f[5]) + (f[6] * f[6] + f[7] * f[7])); \
            *(LAS u32x4*)(xs + (4 * j + fq) * RT_XS_PITCH + 16 * fr) = v; } \
        asm volatile("s_waitcnt lgkmcnt(0)" ::: "memory"); \
        f32x4 acc[3] = {(f32x4){0.f, 0.f, 0.f, 0.f}, (f32x4){0.f, 0.f, 0.f, 0.f}, (f32x4){0.f, 0.f, 0.f, 0.f}}; \
        _Pragma("unroll") for (int ks = 0; ks < 4; ++ks) { \
            const bf16x8 ah = *(const LAS bf16x8*)(xs + fr * RT_XS_PITCH + (32 * ks + 8 * fq) * 2); \
            _Pragma("unroll") for (int nt = 0; nt < 3; ++nt) { \
                acc[nt] = __builtin_amdgcn_mfma_f32_16x16x32_bf16(ah, bh[ks][nt], acc[nt], 0, 0, 0); \
                acc[nt] = __builtin_amdgcn_mfma_f32_16x16x32_bf16(ah, bl[ks][nt], acc[nt], 0, 0, 0); } } \
        LAS float* sl = slab + ((tg) & 1) * 6144 + w * 768;                    \
        _Pragma("unroll") for (int nt = 0; nt < 3; ++nt) { if (nt < 2 || fr < 4) { _Pragma("unroll") for (int r = 0; r < 4; ++r) sl[(4 * fq + r) * 48 + 16 * nt + fr] = acc[nt][r]; } } \
        _Pragma("unroll") for (int j = 0; j < 4; ++j) { float v = sq[j]; \
            _Pragma("unroll") for (int o = 1; o < 16; o <<= 1) v += __shfl_xor(v, o); \
            if (fr == 0) sl[(4 * j + fq) * 48 + 36] = v; } \
        asm volatile("s_waitcnt lgkmcnt(0)" ::: "memory"); __builtin_amdgcn_s_barrier(); asm volatile("" ::: "memory"); \
        for (int o = tid; o < 16 * 37; o += NTHREADS) { const int tk = o / 37, c = o - tk * 37; const LAS float* sp = slab + ((tg) & 1) * 6144 + tk * 48 + c; \
            float s8 = 0.f; _Pragma("unroll") for (int ww = 0; ww < 8; ++ww) s8 += sp[ww * 768]; lg[(16 * (tg) + tk) * 48 + c] = s8; } \
    } while (0)
    RT_LOAD(bufA, 0);
#pragma unroll 1
    for (int tg = 0; tg < 8; tg += 2) {
        RT_LOAD(bufB, tg + 1);
        RT_GROUP(bufA, tg);
        if (tg + 2 < 8) RT_LOAD(bufA, tg + 2);
        RT_GROUP(bufB, tg + 1);
    }
#undef RT_LOAD
#undef RT_GROUP
    __syncthreads();
    if (tid < 128) {
        const int tl = tid, t = blk * 128 + tl; const LAS float* L = lg + tl * 48; const float rs = rsqrtf(L[36] * (1.f / 1024.f) + EPS);
        float g4[4];
#pragma unroll
        for (int i = 0; i < 4; ++i) g4[i] = L[i] * rs + biasl[i];
        int g = 0; float mx = g4[0];
#pragma unroll
        for (int i = 1; i < 4; ++i) if (g4[i] > mx) { mx = g4[i]; g = i; }
        float den = 0.f;
#pragma unroll
        for (int i = 0; i < 4; ++i) den += __expf(g4[i] - mx);
        const float gp = 1.f / den;
        float e8[8];
#pragma unroll
        for (int i = 0; i < 8; ++i) e8[i] = L[4 + g * 8 + i] * rs + biasl[4 + g * 8 + i];
        int i0 = 0; float v0 = e8[0];
#pragma unroll
        for (int i = 1; i < 8; ++i) if (e8[i] > v0) { v0 = e8[i]; i0 = i; }
        int i1 = -1; float v1 = -3.0e38f;
#pragma unroll
        for (int i = 0; i < 8; ++i) if (i != i0 && e8[i] > v1) { v1 = e8[i]; i1 = i; }
        const float ex = __expf(v1 - v0);
        const float g0 = gp / (1.f + ex), g1 = gp * ex / (1.f + ex);
        const int ex0 = g * 8 + i0, ex1 = g * 8 + i1;
        const int r0 = __hip_atomic_fetch_add((int*)(histl + ex0), 1, __ATOMIC_RELAXED, __HIP_MEMORY_SCOPE_WORKGROUP), r1 = __hip_atomic_fetch_add((int*)(histl + ex1), 1, __ATOMIC_RELAXED, __HIP_MEMORY_SCOPE_WORKGROUP);
        *(int2*)((int*)(ws + RT_TOK_E) + 2 * t) = make_int2(ex0, ex1); *(float2*)((float*)(ws + RT_TOK_G) + 2 * t) = make_float2(g0, g1);
        *(int2*)((int*)(ws + RT_TOK_R) + 2 * t) = make_int2(r0, r1); ((float*)(ws + RT_RS2))[t] = rs;
    }
    __syncthreads();
    if (tid < 32) ((int*)(ws + RT_HIST))[blk * 32 + tid] = histl[tid];
}
__device__ __forceinline__ void assign_block(const Frame& F, const Args& a, int blk) {
    const int l = lane_id_fresh(), w = F.wave, tid = w * 64 + l;
    unsigned char* ws = F.ws;
    LAS int* ptot = (LAS int*)F.lds;
    LAS int* ppre = ptot + 512;
    LAS int* base = ppre + 512;
    LAS int* ebase = base + 32;
    __syncthreads();
    { const int e = tid & 31, part = tid >> 5; const int* H = (const int*)(ws + RT_HIST); int st = 0, sp = 0; int hv[16];
#pragma unroll
      for (int i = 0; i < 16; ++i) hv[i] = H[(part * 16 + i) * 32 + e];
#pragma unroll
      for (int i = 0; i < 16; ++i) { st += hv[i]; sp += (part * 16 + i < blk) ? hv[i] : 0; }
      ptot[part * 32 + e] = st; ppre[part * 32 + e] = sp; }
    __syncthreads();
    if (tid < 32) { int st = 0, sp = 0; for (int p = 0; p < 16; ++p) { st += ptot[p * 32 + tid]; sp += ppre[p * 32 + tid]; } ptot[tid] = st; ppre[tid] = sp; }
    __syncthreads();
    if (tid == 0) { int run = 0;
        for (int e = 0; e < 32; ++e) { base[e] = run * 256 + ppre[e]; ebase[e] = run * 256 + ptot[e]; ebase[64 + e] = run; run += (ptot[e] + 255) >> 8; ebase[32 + e] = run * 256; }
        if (blk == 0) ((int*)(ws + RT_TILE_E))[0] = run; }
    __syncthreads();
    if (blk == 0 && tid < 32) { int* te = (int*)(ws + RT_TILE_E); const int r0 = ebase[64 + tid], nt = (ebase[32 + tid] >> 8) - r0; for (int i = 0; i < nt; ++i) te[16 + r0 + i] = tid; }
    int* tos = (int*)(ws + RT_TOK_OF_SLOT); float* rss = (float*)(ws + RT_RS_SLOT); float* gts = (float*)(ws + RT_GATE_SLOT);
    if (tid < 256) { const int t = blk * 128 + (tid >> 1), k = tid & 1;
        const int e = ((const int*)(ws + RT_TOK_E))[2 * t + k], r = ((const int*)(ws + RT_TOK_R))[2 * t + k];
        const int slot = base[e] + r;
        ((int*)(ws + RT_SLOT_OF))[2 * t + k] = slot; tos[slot] = t; rss[slot] = ((const float*)(ws + RT_RS2))[t]; gts[slot] = ((const float*)(ws + RT_TOK_G))[2 * t + k]; }
    if (blk < 32) {
        for (int sl = ebase[blk] + tid; sl < ebase[32 + blk]; sl += NTHREADS) { tos[sl] = 0; rss[sl] = 0.f; gts[sl] = 0.f; } }
}
__device__ __forceinline__ void combine_rows(const Frame& F, const Args& a, float* outp) {
    const int l = lane_id_fresh();
    unsigned char* ws = F.ws;
    const int gw = F.vcu * NWAVES + F.wave, NGW = F.G * NWAVES;
    const f32x4* gfin = (const f32x4*)a.in[IN_G_FINAL] + l;
    f32x4 gf4[4];
#pragma unroll
    for (int j = 0; j < 4; ++j) gf4[j] = gfin[64 * j];
    const int* slot_of = (const int*)(ws + RT_SLOT_OF); const bf16_t* Y = (const bf16_t*)(ws + WS_YSLOT); const bf16_t* XB = (const bf16_t*)(ws + WS_X2B);
    for (int t = gw; t < T; t += 2 * NGW) {
        const int tb = t + NGW; const bool hb = tb < T; const int t2 = hb ? tb : t;
        const int2 sa = *(const int2*)(slot_of + 2 * t), sb = *(const int2*)(slot_of + 2 * t2);
        const u32x2* xa = (const u32x2*)(XB + (size_t)t * D) + l; const u32x2* xb = (const u32x2*)(XB + (size_t)t2 * D) + l;
        const u32x2* ya0 = (const u32x2*)(Y + (size_t)sa.x * D) + l; const u32x2* ya1 = (const u32x2*)(Y + (size_t)sa.y * D) + l;
        const u32x2* yb0 = (const u32x2*)(Y + (size_t)sb.x * D) + l; const u32x2* yb1 = (const u32x2*)(Y + (size_t)sb.y * D) + l;
        f32x4 va[4], vb[4]; u32x2 ra[4], pa[4], qa[4], rb[4], pb[4], qb[4];
#pragma unroll
        for (int j = 0; j < 4; ++j) { ra[j] = __builtin_nontemporal_load(xa + 64 * j); pa[j] = __builtin_nontemporal_load(ya0 + 64 * j); qa[j] = __builtin_nontemporal_load(ya1 + 64 * j); rb[j] = __builtin_nontemporal_load(xb + 64 * j); pb[j] = __builtin_nontemporal_load(yb0 + 64 * j); qb[j] = __builtin_nontemporal_load(yb1 + 64 * j); }
        float sqa = 0.f, sqb = 0.f;
#pragma unroll
        for (int j = 0; j < 4; ++j) {
            va[j].x = bf_lo(ra[j].x) + bf_lo(pa[j].x) + bf_lo(qa[j].x); va[j].y = bf_hi(ra[j].x) + bf_hi(pa[j].x) + bf_hi(qa[j].x); va[j].z = bf_lo(ra[j].y) + bf_lo(pa[j].y) + bf_lo(qa[j].y); va[j].w = bf_hi(ra[j].y) + bf_hi(pa[j].y) + bf_hi(qa[j].y);
            vb[j].x = bf_lo(rb[j].x) + bf_lo(pb[j].x) + bf_lo(qb[j].x); vb[j].y = bf_hi(rb[j].x) + bf_hi(pb[j].x) + bf_hi(qb[j].x); vb[j].z = bf_lo(rb[j].y) + bf_lo(pb[j].y) + bf_lo(qb[j].y); vb[j].w = bf_hi(rb[j].y) + bf_hi(pb[j].y) + bf_hi(qb[j].y);
            sqa += (va[j].x * va[j].x + va[j].y * va[j].y) + (va[j].z * va[j].z + va[j].w * va[j].w); sqb += (vb[j].x * vb[j].x + vb[j].y * vb[j].y) + (vb[j].z * vb[j].z + vb[j].w * vb[j].w); }
        const float rsa = rsqrtf(wave_sum(sqa) * (1.f / 1024.f) + EPS), rsb = rsqrtf(wave_sum(sqb) * (1.f / 1024.f) + EPS);
        f32x4* oa = (f32x4*)(outp + (size_t)t * D) + l; f32x4* ob = (f32x4*)(outp + (size_t)t2 * D) + l;
#pragma unroll
        for (int j = 0; j < 4; ++j) { __builtin_nontemporal_store(va[j] * rsa * gf4[j], oa + 64 * j); if (hb) __builtin_nontemporal_store(vb[j] * rsb * gf4[j], ob + 64 * j); }
    }
}

#define XB_TMO      128
#define XB_XCNT(j)  (256  + 64 * (j))
#define XB_XSUB(j)  (1280 + 64 * (j))
#define XB_XGEN(j)  (2304 + 64 * (j))
#define XB_TOP      3328
#define XB_TOPGEN   3392
#define XCD_BAR_WORDS 3456
#define XB_SPIN_CAP (1u << 20)
__device__ __forceinline__ unsigned xb_ld(unsigned* p)              { return __hip_atomic_load(p, __ATOMIC_RELAXED, __HIP_MEMORY_SCOPE_AGENT); }
__device__ __forceinline__ unsigned xb_add(unsigned* p, unsigned v) { return __hip_atomic_fetch_add(p, v, __ATOMIC_RELAXED, __HIP_MEMORY_SCOPE_AGENT); }
__device__ __forceinline__ unsigned xb_xcc_id() { return (unsigned)__builtin_amdgcn_s_getreg((3 << 11) | 20) & 0xFu; }
#define XB_SPIN(cond, bar) do { unsigned _sp = 0; while (cond) { __builtin_amdgcn_s_sleep(1); \
    if ((++_sp & 255u) == 0u) { if (xb_ld(&(bar)[XB_TMO])) break; if (_sp > XB_SPIN_CAP) { atomicAdd(&(bar)[XB_TMO], 1u); break; } } } } while (0)
struct XcdBarrier { unsigned* bar; unsigned x; volatile LAS unsigned* st; };
__device__ __forceinline__ XcdBarrier xcd_barrier_post(unsigned* bar, volatile LAS unsigned* st) {
    XcdBarrier b; b.bar = bar; b.x = xb_xcc_id(); b.st = st;
    if (threadIdx.x == 0) (void)xb_add(&bar[XB_XCNT(b.x)], 1u);
    return b;
}
__device__ __forceinline__ void xcd_barrier_complete(unsigned* bar, unsigned x, unsigned& nloc, unsigned& nx) {
    const unsigned G = gridDim.x * gridDim.y * gridDim.z;
    unsigned sum, cnt, mine, sp = 0u;
    for (;;) {
        sum = 0u; cnt = 0u; mine = 0u;
#pragma unroll
        for (unsigned j = 0; j < 16; ++j) { const unsigned c = xb_ld(&bar[XB_XCNT(j)]); sum += c; cnt += (c > 0u) ? 1u : 0u; mine = (j == x) ? c : mine; }
        if (sum == G) break;
        __builtin_amdgcn_s_sleep(1);
        if ((++sp & 255u) == 0u) { if (xb_ld(&bar[XB_TMO])) break; if (sp > XB_SPIN_CAP) { atomicAdd(&bar[XB_TMO], 1u); break; } }
    }
    nloc = mine > 0u ? mine : 1u; nx = cnt > 0u ? cnt : 1u;
}
__device__ __forceinline__ void xcd_barrier(const XcdBarrier& b, const int wave) {
    asm volatile("s_waitcnt vmcnt(0)" ::: "memory");
    __syncthreads();
    if (wave == 0 && lane_id_fresh() == 0) {
        unsigned* bar = b.bar;
        __builtin_amdgcn_s_waitcnt(0);
        unsigned nloc = b.st[0], nx = b.st[1];
        if (nloc == 0u) { xcd_barrier_complete(bar, b.x, nloc, nx); b.st[0] = nloc; b.st[1] = nx; }
        const unsigned old = xb_add(&bar[XB_XSUB(b.x)], 1u);
        const unsigned gen = old / nloc;
        if (old + 1u == (gen + 1u) * nloc) {
            __builtin_amdgcn_fence(__ATOMIC_RELEASE, "agent");
            asm volatile("s_waitcnt vmcnt(0)" ::: "memory");
            const unsigned og = xb_add(&bar[XB_TOP], 1u);
            const unsigned tg = og / nx;
            if (og + 1u == (tg + 1u) * nx) xb_add(&bar[XB_TOPGEN], 1u);
            else XB_SPIN(xb_ld(&bar[XB_TOPGEN]) == tg, bar);
            __builtin_amdgcn_fence(__ATOMIC_ACQUIRE, "agent");
            xb_add(&bar[XB_XGEN(b.x)], 1u);
            asm volatile("s_waitcnt vmcnt(0)" ::: "memory");
        } else {
            XB_SPIN(xb_ld(&bar[XB_XGEN(b.x)]) == gen, bar);
            __builtin_amdgcn_fence(__ATOMIC_ACQUIRE, "agent");
            asm volatile("s_waitcnt vmcnt(0)" ::: "memory");
        }
    }
    __syncthreads();
}

__global__ void __launch_bounds__(NTHREADS, 2) mk_fwd(Args args) {
    extern __shared__ __attribute__((aligned(16))) unsigned char lds_raw[];
    Frame F;
    F.lds = (LAS unsigned char*)lds_raw;
    F.wave = __builtin_amdgcn_readfirstlane((int)threadIdx.x >> 6);
    F.G = gridDim.x; { const int bx = blockIdx.x; F.vcu = (F.G % 8 == 0) ? (bx % 8) * (F.G / 8) + bx / 8 : bx; }
    F.ws = args.ws; F.out = args.out;
    unsigned char* ws = args.ws;
    const int lo = args.ph_lo, hi = args.ph_hi;
    if (threadIdx.x < 64) ((LAS unsigned*)(F.lds + LDS_MISC))[threadIdx.x] = 0u;
    __syncthreads();
    XcdBarrier xbar; xbar.bar = (unsigned*)(ws + WS_CTL) + 4096; xbar.x = 0; xbar.st = nullptr;
    if (hi - lo > 1) xbar = xcd_barrier_post((unsigned*)(ws + WS_CTL) + 4096, (volatile LAS unsigned*)(F.lds + LDS_MISC) + 8);
#define IN(k) (lo <= (k) && (k) < hi)
#define SEAM(k) do { if (IN(k) && IN((k) + 1)) xcd_barrier(xbar, F.wave); } while (0)
    if (IN(0)) p0_prologue(F, args);
    SEAM(0);
    if (IN(1)) {
        { pg8::DenseOrder S; S.init(T, INC, F.G, (int)blockIdx.x, ws + WS_HB, D, ws + WS_WIN_T, D);
          EpiInProj E{(bf16_t*)(ws + WS_GB), (bf16_t*)(ws + WS_Z), (bf16_t*)(ws + WS_UG), (bf16_t*)(ws + WS_VG)};
          pg8::gemm_phase<D, D, D>(F.lds, F.wave, S, E); }
        { pg8::DenseOrder S; S.init(B * ML, 2 * D, F.G, (int)blockIdx.x, ws + WS_MEMN, D, ws + WS_WKV_T, D);
          EpiBf16 E{(bf16_t*)(ws + WS_KV), 2 * D};
          pg8::gemm_phase<D, D, D>(F.lds, F.wave, S, E); }
    }
    SEAM(1);
    if (IN(2)) {
        for (int ch = F.vcu; ch < T / CHUNK; ch += F.G) mixer_unit(F, args, ch);
    }
    SEAM(2);
    if (IN(3)) {
        { WqkOrder S{F.G, (int)blockIdx.x, (const char*)(ws + WS_KV), (const char*)(ws + WS_WQ_NAT)}; EpiBf16Aux E{(bf16_t*)(ws + WS_WQK_T), 1024};
          pg8::gemm_phase<2 * D, D, XD>(F.lds, F.wave, S, E); }
        { VwOrder S{F.G, (int)((blockIdx.x + F.G / 2) % F.G), (const char*)(ws + WS_KV), (const char*)(ws + WS_WO_T)}; EpiBf16Aux E{(bf16_t*)(ws + WS_VW_T), 1024};
          pg8::gemm_phase<D, 2 * D, XD>(F.lds, F.wave, S, E); }
        pg8::DenseOrder S; S.init(T, D, F.G, (int)blockIdx.x, ws + WS_Y, D, ws + WS_WOUT_T, D);
        EpiResidA E{args.in[IN_X], (bf16_t*)(ws + WS_X1B), (float*)(ws + WS_SSQ1)};
        pg8::gemm_phase<D, D, D>(F.lds, F.wave, S, E);
    }
    SEAM(3);
    if (IN(4)) {
        pg8::DenseOrder S; S.init(T, D, F.G, (int)blockIdx.x, ws + WS_X1B, D, ws + WS_WQK_T, D, S_TILES, (size_t)D * D * 2);
        EpiSoftmax E{(const float*)(ws + WS_SSQ1), (bf16_t*)(ws + WS_P)};
        pg8::gemm_phase<D, D, D>(F.lds, F.wave, S, E);
    }
    SEAM(4);
    if (IN(5)) {
        pg8::DenseOrder S; S.init(T, D, F.G, (int)blockIdx.x, ws + WS_P, D, ws + WS_VW_T, D, S_TILES, (size_t)D * D * 2);
        EpiResidB E{(const bf16_t*)(ws + WS_X1B), (bf16_t*)(ws + WS_X2B)};
        pg8::gemm_phase<D, D, D>(F.lds, F.wave, S, E);
    }
    SEAM(5);
    if (IN(6)) { for (int blk = F.vcu; blk < T / 128; blk += F.G) router_block(F, args, blk); }
    SEAM(6);
    if (IN(7)) { for (int blk = F.vcu; blk < T / 128; blk += F.G) assign_block(F, args, blk); }
    SEAM(7);
    if (IN(8)) {
        GroupedOrder S; S.init(F.G, (int)blockIdx.x, (const int*)(ws + RT_TILE_E), ws + WS_X2B, D, ws + WS_WGU_T, D, (size_t)1024 * 1024 * 2, true);
        EpiSwiGLU E{(bf16_t*)(ws + WS_HID), (const float*)(ws + RT_RS_SLOT)};
        pg8::gemm_phase<D, D, D, true>(F.lds, F.wave, S, E, (const int*)(ws + RT_TOK_OF_SLOT));
    }
    SEAM(8);
    if (IN(9)) {
        GroupedOrder S; S.init(F.G, (int)blockIdx.x, (const int*)(ws + RT_TILE_E), ws + WS_HID, DE, ws + WS_WD_T, DE, (size_t)1024 * 512 * 2);
        EpiDown E{(bf16_t*)(ws + WS_YSLOT), (const float*)(ws + RT_GATE_SLOT)};
        pg8::gemm_phase<DE, DE, DE>(F.lds, F.wave, S, E);
    }
    SEAM(9);
    if (IN(10)) { combine_rows(F, args, F.out); }
#undef IN
#undef SEAM
}
extern "C" void kernel_launch(void* const* d_in, const int* in_sizes, int n_in, void* d_out, int out_size, void* d_ws, size_t ws_size, hipStream_t stream) {
    if (n_in != 26 || out_size != T * D || ws_size < 500 * MiB) { fprintf(stderr, "kernel_launch: unexpected shapes n_in %d out %d ws %zu\n", n_in, out_size, ws_size); return; }
    float* xres = (float*)d_out;
    static int grid = 0;
    if (grid == 0) {
        int dev = 0, cus = 0, per_cu = 0;
        if (hipGetDevice(&dev) != hipSuccess || hipDeviceGetAttribute(&cus, hipDeviceAttributeMultiprocessorCount, dev) != hipSuccess) { fprintf(stderr, "kernel_launch: device query failed\n"); grid = -1; return; }
        if (hipFuncSetAttribute((const void*)mk_fwd, hipFuncAttributeMaxDynamicSharedMemorySize, LDS_BYTES) != hipSuccess) { fprintf(stderr, "kernel_launch: hipFuncSetAttribute failed\n"); grid = -1; return; }
        if (hipOccupancyMaxActiveBlocksPerMultiprocessor(&per_cu, (const void*)mk_fwd, NTHREADS, LDS_BYTES) != hipSuccess || per_cu < 1) { fprintf(stderr, "kernel_launch: occupancy query says %d blocks per CU\n", per_cu); (void)hipGetLastError(); grid = -1; return; }
        grid = cus;
        if (grid != 256) fprintf(stderr, "kernel_launch: note: %d CUs (built and tuned for 256)\n", grid);
    }
    if (grid < 0) return;
    Args a{};
    for (int i = 0; i < 26; ++i) a.in[i] = (const float*)d_in[i];
    a.out = xres; a.ws = (unsigned char*)d_ws;
    if (hipMemsetAsync((char*)d_ws + WS_CTL + 4096 * 4, 0, XCD_BAR_WORDS * 4, stream) != hipSuccess) { fprintf(stderr, "kernel_launch: memset failed\n"); return; }
#if defined(MK_PER_PHASE)
    for (int ph = 0; ph < 11; ++ph) { a.ph_lo = ph; a.ph_hi = ph + 1; hipLaunchKernelGGL(mk_fwd, dim3(grid), dim3(NTHREADS), LDS_BYTES, stream, a); }
#else
    a.ph_lo = 0; a.ph_hi = 11;
    hipLaunchKernelGGL(mk_fwd, dim3(grid), dim3(NTHREADS), LDS_BYTES, stream, a);
    const hipError_t le = hipPeekAtLastError();
    if (le != hipSuccess) fprintf(stderr, "kernel_launch: launch failed: %s (grid %d)\n", hipGetErrorString(le), grid);
#endif
}
```
